# Optimizing an MI355X kernel written in HIP

```python
import math
import jax, jax.numpy as jnp
from jax import lax
import numpy as np

D_MODEL = 2048
BATCH = 4
SEQ = 2048
DEPTH = 1

CTX_LEN = 256
GRID_W = 64

HEAD_DIM = 128
DA_HEADS = 8
DA_HALF = HEAD_DIM // 2
MLA_HEADS = 8
MLA_NOPE = 128
MLA_ROPE = 64
MLA_V = 128
Q_RANK = 384
KV_RANK = 256
ROPE_DIM = 64
ROPE_BASE = 10000.0
D_FF = 5632
CONV_W = 3
N_MOD = 6
EPS = 1e-6
Q_BLOCK = 128

DA_WIDTH = DA_HEADS * HEAD_DIM
MLA_WIDTH = MLA_HEADS * MLA_V
MIX_WIDTH = DA_WIDTH + MLA_WIDTH
MLA_QK = MLA_NOPE + MLA_ROPE
IN_WIDTH = 3 * DA_WIDTH + Q_RANK + KV_RANK + MLA_ROPE
DA_SCALE = 1.0 / math.sqrt(DA_HALF)
MLA_SCALE = 1.0 / math.sqrt(MLA_QK)

kernel_name = "hybrid_diffattn_mla_convffn_dit_layer"


def _rmsnorm(x, w):
    xf = x.astype(jnp.float32)
    y = xf * lax.rsqrt(jnp.mean(xf * xf, axis=-1, keepdims=True) + EPS)
    return y.astype(x.dtype) * w


def _modulate(h, shift, scale):
    return h * (1.0 + scale) + shift


def _axial_rope_tables(n_tokens):
    rows = n_tokens // GRID_W
    row = jnp.broadcast_to(jnp.arange(rows)[:, None], (rows, GRID_W)).reshape(-1).astype(jnp.float32)
    col = jnp.broadcast_to(jnp.arange(GRID_W)[None, :], (rows, GRID_W)).reshape(-1).astype(jnp.float32)
    nf = ROPE_DIM // 4
    inv = ROPE_BASE ** (-jnp.arange(nf, dtype=jnp.float32) / nf)
    ang_r = row[:, None] * inv
    ang_c = col[:, None] * inv
    return (jnp.cos(ang_r), jnp.sin(ang_r), jnp.cos(ang_c), jnp.sin(ang_c))


def _rot(x, cos, sin):
    cos = cos.astype(x.dtype)
    sin = sin.astype(x.dtype)
    x1, x2 = jnp.split(x, 2, axis=-1)
    return jnp.concatenate([x1 * cos - x2 * sin, x2 * cos + x1 * sin], axis=-1)


def _axial_rope(x, tabs):
    cos_r, sin_r, cos_c, sin_c = tabs
    xr, xc = jnp.split(x, 2, axis=-1)
    return jnp.concatenate([_rot(xr, cos_r, sin_r), _rot(xc, cos_c, sin_c)], axis=-1)


def _mixer_inputs(h, tabs, w_in, q_norm_w, kv_norm_w, w_uq, w_ukv):
    B, T, _ = h.shape
    p = h @ w_in
    o1, o2, o3 = DA_WIDTH, 2 * DA_WIDTH, 3 * DA_WIDTH
    o4 = o3 + Q_RANK
    o5 = o4 + KV_RANK

    def heads(a, n):
        return a.reshape(B, T, n, -1).transpose(0, 2, 1, 3)

    q_da = heads(p[..., :o1], DA_HEADS)
    k_da = heads(p[..., o1:o2], DA_HEADS)
    v_da = heads(p[..., o2:o3], DA_HEADS)
    c_q = _rmsnorm(p[..., o3:o4], q_norm_w)
    c_kv = _rmsnorm(p[..., o4:o5], kv_norm_w)
    k_rope = p[..., o5:][:, None]
    q_mla = heads(c_q @ w_uq, MLA_HEADS)
    kv = heads(c_kv @ w_ukv, MLA_HEADS)
    q_nope, q_rope = q_mla[..., :MLA_NOPE], q_mla[..., MLA_NOPE:]
    k_nope, v_mla = kv[..., :MLA_NOPE], kv[..., MLA_NOPE:]
    if tabs is not None:
        q_da = jnp.concatenate([_axial_rope(q_da[..., :DA_HALF], tabs), _axial_rope(q_da[..., DA_HALF:], tabs)], -1)
        k_da = jnp.concatenate([_axial_rope(k_da[..., :DA_HALF], tabs), _axial_rope(k_da[..., DA_HALF:], tabs)], -1)
        q_rope = _axial_rope(q_rope, tabs)
        k_rope = _axial_rope(k_rope, tabs)
    q_mla = jnp.concatenate([q_nope, q_rope], axis=-1)
    k_mla = jnp.concatenate([k_nope, jnp.broadcast_to(k_rope, (B, MLA_HEADS, T, MLA_ROPE))], axis=-1)
    return q_da, k_da, v_da, q_mla, k_mla, v_mla


def _diff_attend(q, k, v, lam):
    q1, q2 = jnp.split(q, 2, axis=-1)
    k1, k2 = jnp.split(k, 2, axis=-1)
    s1 = jnp.einsum('bhqd,bhkd->bhqk', q1, k1).astype(jnp.float32) * DA_SCALE
    s2 = jnp.einsum('bhqd,bhkd->bhqk', q2, k2).astype(jnp.float32) * DA_SCALE
    w = jax.nn.softmax(s1, axis=-1) - lam * jax.nn.softmax(s2, axis=-1)
    return jnp.einsum('bhqk,bhkd->bhqd', w.astype(v.dtype), v)


def _softmax_attend(q, k, v, scale):
    s = jnp.einsum('bhqd,bhkd->bhqk', q, k).astype(jnp.float32) * scale
    p = jax.nn.softmax(s, axis=-1)
    return jnp.einsum('bhqk,bhkd->bhqd', p.astype(v.dtype), v)


def _sweep(block_fn, q):
    B, H, S, d = q.shape
    nb = S // Q_BLOCK
    qb = q.reshape(B, H, nb, Q_BLOCK, d).transpose(2, 0, 1, 3, 4)
    out = lax.map(block_fn, qb)
    return out.transpose(1, 2, 0, 3, 4).reshape(B, H, S, out.shape[-1])


def _merge_heads(o_da, o_mla, subln_w, lambda_init):
    o_da = _rmsnorm(o_da, subln_w) * (1.0 - lambda_init)
    B, _, T, _ = o_da.shape
    o_da = o_da.transpose(0, 2, 1, 3).reshape(B, T, DA_WIDTH)
    o_mla = o_mla.transpose(0, 2, 1, 3).reshape(B, T, MLA_WIDTH)
    return jnp.concatenate([o_da, o_mla], axis=-1)


def _conv_ffn(h, w_up, conv_w, conv_b, w_down):
    g, u = jnp.split(h @ w_up, 2, axis=-1)
    T = g.shape[1]
    pad = CONV_W // 2
    gp = jnp.pad(g, ((0, 0), (pad, pad), (0, 0)))
    g = sum(gp[:, j:j + T] * conv_w[j] for j in range(CONV_W)) + conv_b
    return (jax.nn.silu(g) * u) @ w_down


def setup_inputs(seed: int = 0) -> dict:
    key = jax.random.key(seed)
    ks = jax.random.split(key, 24)
    f32 = jnp.float32

    def nrm(k, shape, fan_in, gain=1.0):
        return (gain * fan_in ** -0.5) * jax.random.normal(k, shape, f32)

    def gain(k, shape):
        return 1.0 + 0.05 * jax.random.normal(k, shape, f32)

    L = DEPTH
    return {
        "x": jax.random.normal(ks[0], (BATCH, SEQ, D_MODEL), f32),
        "c": jax.random.normal(ks[1], (BATCH, D_MODEL), f32),
        "ctx": jax.random.normal(ks[2], (BATCH, CTX_LEN, D_MODEL), f32),
        "c_ctx": jax.random.normal(ks[3], (D_MODEL,), f32),
        "w_ada": nrm(ks[4], (L, D_MODEL, N_MOD * D_MODEL), D_MODEL, 0.5),
        "b_ada": 0.02 * jax.random.normal(ks[5], (L, N_MOD * D_MODEL), f32),
        "norm1_w": gain(ks[6], (L, D_MODEL)),
        "w_in": nrm(ks[7], (L, D_MODEL, IN_WIDTH), D_MODEL),
        "q_norm_w": gain(ks[8], (L, Q_RANK)),
        "kv_norm_w": gain(ks[9], (L, KV_RANK)),
        "w_uq": nrm(ks[10], (L, Q_RANK, MLA_HEADS * MLA_QK), Q_RANK),
        "w_ukv": nrm(ks[11], (L, KV_RANK, MLA_HEADS * (MLA_NOPE + MLA_V)), KV_RANK),
        "lambda_q1": 0.1 * jax.random.normal(ks[12], (L, DA_HALF), f32),
        "lambda_k1": 0.1 * jax.random.normal(ks[13], (L, DA_HALF), f32),
        "lambda_q2": 0.1 * jax.random.normal(ks[14], (L, DA_HALF), f32),
        "lambda_k2": 0.1 * jax.random.normal(ks[15], (L, DA_HALF), f32),
        "subln_w": gain(ks[16], (L, HEAD_DIM)),
        "w_o": nrm(ks[17], (L, MIX_WIDTH, D_MODEL), MIX_WIDTH),
        "norm2_w": gain(ks[18], (L, D_MODEL)),
        "w_up": nrm(ks[19], (L, D_MODEL, 2 * D_FF), D_MODEL),
        "conv_w": nrm(ks[20], (L, CONV_W, D_FF), CONV_W),
        "conv_b": 0.02 * jax.random.normal(ks[21], (L, D_FF), f32),
        "w_down": nrm(ks[22], (L, D_FF, D_MODEL), D_FF),
        "final_w": gain(ks[23], (D_MODEL,)),
    }


def reference(x, c, ctx, c_ctx, w_ada, b_ada, norm1_w, w_in, q_norm_w, kv_norm_w, w_uq, w_ukv,
              lambda_q1, lambda_k1, lambda_q2, lambda_k2, subln_w, w_o, norm2_w, w_up,
              conv_w, conv_b, w_down, final_w):
    B, S, D = x.shape
    tabs = _axial_rope_tables(S)
    xc = jnp.broadcast_to(ctx, ctx.shape)
    sc_ = jax.nn.silu(c)
    scc = jax.nn.silu(c_ctx)
    for l in range(DEPTH):
        mod_x = (sc_ @ w_ada[l] + b_ada[l])[:, None, :]
        mod_c = (scc @ w_ada[l] + b_ada[l])[None, None, :]
        sh1, s1, g1, sh2, s2, g2 = jnp.split(mod_x, N_MOD, axis=-1)
        sh1c, s1c, g1c, sh2c, s2c, g2c = jnp.split(mod_c, N_MOD, axis=-1)
        lambda_init = 0.8 - 0.6 * math.exp(-0.3 * l)
        lam = (jnp.exp(jnp.sum(lambda_q1[l].astype(jnp.float32) * lambda_k1[l].astype(jnp.float32)))
               - jnp.exp(jnp.sum(lambda_q2[l].astype(jnp.float32) * lambda_k2[l].astype(jnp.float32)))
               + lambda_init)
        proj = (w_in[l], q_norm_w[l], kv_norm_w[l], w_uq[l], w_ukv[l])

        h = _modulate(_rmsnorm(x, norm1_w[l]), sh1, s1)
        hc = _modulate(_rmsnorm(xc, norm1_w[l]), sh1c, s1c)
        q_da, k_da, v_da, q_mla, k_mla, v_mla = _mixer_inputs(h, tabs, *proj)
        qc_da, kc_da, vc_da, qc_mla, kc_mla, vc_mla = _mixer_inputs(hc, None, *proj)
        k_da_all = jnp.concatenate([kc_da, k_da], axis=2)
        v_da_all = jnp.concatenate([vc_da, v_da], axis=2)
        k_mla_all = jnp.concatenate([kc_mla, k_mla], axis=2)
        v_mla_all = jnp.concatenate([vc_mla, v_mla], axis=2)
        o_da = _sweep(lambda qb: _diff_attend(qb, k_da_all, v_da_all, lam), q_da)
        o_mla = _sweep(lambda qb: _softmax_attend(qb, k_mla_all, v_mla_all, MLA_SCALE), q_mla)
        x = x + g1 * (_merge_heads(o_da, o_mla, subln_w[l], lambda_init) @ w_o[l])

        h2 = _modulate(_rmsnorm(x, norm2_w[l]), sh2, s2)
        x = x + g2 * _conv_ffn(h2, w_up[l], conv_w[l], conv_b[l], w_down[l])

        if l < DEPTH - 1:
            oc_da = _diff_attend(qc_da, kc_da, vc_da, lam)
            oc_mla = _softmax_attend(qc_mla, kc_mla, vc_mla, MLA_SCALE)
            xc = xc + g1c * (_merge_heads(oc_da, oc_mla, subln_w[l], lambda_init) @ w_o[l])
            hc2 = _modulate(_rmsnorm(xc, norm2_w[l]), sh2c, s2c)
            xc = xc + g2c * _conv_ffn(hc2, w_up[l], conv_w[l], conv_b[l], w_down[l])
    return _rmsnorm(x, final_w)
```

```cpp
#include <hip/hip_runtime.h>
#include <hip/hip_cooperative_groups.h>
#include <cstdio>
#include <cstdint>
namespace cg = cooperative_groups;

#define LAS __attribute__((address_space(3)))
#define DI __device__ __forceinline__
typedef unsigned short bf16_t;
typedef short bf16x8 __attribute__((ext_vector_type(8)));
typedef short s16x4 __attribute__((ext_vector_type(4)));
typedef float f32x2 __attribute__((ext_vector_type(2)));
typedef float f32x4 __attribute__((ext_vector_type(4)));
typedef float f32x16 __attribute__((ext_vector_type(16)));
typedef unsigned u32x4 __attribute__((ext_vector_type(4)));
typedef unsigned u32x2 __attribute__((ext_vector_type(2)));
typedef __bf16 bf2_t __attribute__((ext_vector_type(2)));

constexpr int DM = 2048, NBATCH = 4, SEQ = 2048, CTXL = 256, NKEY = SEQ + CTXL;
constexpr int ML = NBATCH * SEQ, MC = NBATCH * CTXL, MT = ML + MC;
constexpr int INW = 3776, INWP = 3840, QRANK = 384, KVRANK = 256, DFF = 5632, NMODC = 6 * DM;
constexpr float EPS = 1e-6f;
constexpr size_t MiB = 1024 * 1024;
constexpr size_t WS_WIN = 0, WS_WUQ = 15 * MiB, WS_WUKV = 17 * MiB, WS_WO = 18 * MiB, WS_WUP = 26 * MiB, WS_WDN = 70 * MiB;
constexpr size_t WS_SMALL = 92 * MiB, WS_MOD = WS_SMALL, WS_ROPE = WS_SMALL + 256 * 1024, WS_SSQ = WS_SMALL + 512 * 1024;
constexpr size_t SSQ_BYTES = (size_t)(ML + MT) * 4;
constexpr size_t WS_X1 = 93 * MiB, WS_H = 157 * MiB, WS_O1 = WS_H, WS_T = 193 * MiB;
constexpr size_t WS_QDA = WS_T, WS_KDA = WS_T + 16 * MiB, WS_VDA = WS_T + 34 * MiB, WS_CQ = WS_T + 52 * MiB, WS_CKV = WS_T + 58 * MiB,
                 WS_KR = WS_T + 63 * MiB, WS_QMLA = WS_T + 65 * MiB, WS_KVM = WS_T + 89 * MiB, WS_MRG = WS_T + 125 * MiB;
constexpr size_t WS_G = WS_T, WS_U = WS_T + 88 * MiB, WS_END = WS_T + 176 * MiB;
constexpr int LDS_BYTES = 131072;

DI unsigned pk2(float lo, float hi) { f32x2 v = {lo, hi}; bf2_t b = __builtin_convertvector(v, bf2_t); return __builtin_bit_cast(unsigned, b); }
DI float bflo(unsigned u) { return __builtin_bit_cast(float, u << 16); }
DI float bfhi(unsigned u) { return __builtin_bit_cast(float, u & 0xffff0000u); }
DI float wave_sum(float v) {
#pragma unroll
    for (int o = 1; o < 64; o <<= 1) v += __shfl_xor(v, o);
    return v;
}

namespace pg8 {
constexpr int BM = 256, BK = 64, HALF = 128, HTB = HALF * BK * 2, STAGE_BYTES = 8 * HTB, NXCD = 8, WGM = 8;
DI int lds_byte(int r, int c) { const int st = (r >> 4) * 2 + (c >> 5), rr = r & 15, cc = c & 31, ob = rr * 64 + cc * 2; return st * 1024 + (ob ^ (((ob >> 9) & 1) << 5)); }
DI void stage_rc(int b, int& R, int& C) { const int st = b / 1024, sb = b % 1024, swz = sb ^ (((sb >> 9) & 1) << 5); R = (st >> 1) * 16 + swz / 64; C = (st & 1) * 32 + (swz % 64) / 2; }
DI int perm32(int rho) { const int n = rho >> 4, i = rho & 15; return 8 * (i >> 2) + 4 * n + (i & 3); }
struct Unit { int pm, pn; };
struct Gemm { const bf16_t* A; const bf16_t* Bt; int M, N, K; };
struct StaticOrder {
    int nM, nN, nwg, G, c;
    DI void init(int M, int N, int G_, int c_) { nM = M / BM; nN = N / BM; nwg = nM * nN; G = G_; c = c_; }
    DI bool next(int i, Unit& u) const {
        const long L = (long)i * G + c; if (L >= nwg) return false;
        int wgid = (int)L; { const int q = nwg / NXCD, r = nwg % NXCD, xcd = wgid % NXCD, off = wgid / NXCD; wgid = (xcd < r ? xcd * (q + 1) : r * (q + 1) + (xcd - r) * q) + off; }
        const int nig = WGM * nN, gid = wgid / nig, fm = gid * WGM, gsz = (nM - fm) < WGM ? (nM - fm) : WGM;
        u.pm = fm + ((wgid % nig) % gsz); u.pn = (wgid % nig) / gsz; return true;
    }
};

template <class Epi, class Sched, bool ALIGN_EPI>
DI void gemm_phase(LAS unsigned char* lds, const Gemm g, const Sched& S, const Epi& E) {
    const int tid = threadIdx.x, wid = __builtin_amdgcn_readfirstlane(tid >> 6), lane = tid & 63, wr = wid >> 2, wc = wid & 3, fr = lane & 15, fq = lane >> 4;
    const int K = g.K, nt = K / BK;
    unsigned voffA[2], voffB[2];
#pragma unroll
    for (int i = 0; i < 2; ++i) { int R, C; stage_rc(tid * 16 + i * 8192, R, C); const int Rb = Epi::PERM ? ((R & ~31) + perm32(R & 31)) : R;
        voffA[i] = (unsigned)(R * K + C) * 2u; voffB[i] = (unsigned)(Rb * K + C) * 2u; }
    const size_t kstep = (size_t)(BK * 2);
    const size_t hstep = (size_t)HALF * K * 2;
    const size_t tstep = 2 * hstep;
    const unsigned ldsw = (unsigned)wid * 1024u;
    const int aoff = lds_byte(wr * 64 + fr, fq * 8), boff = lds_byte(wc * 32 + fr, fq * 8);
#define PG8_SA(b, h) (((b) * 2 + (h)) * HTB)
#define PG8_SB(b, h) ((4 + (b) * 2 + (h)) * HTB)
#define PG8_STAGE(bufoff, gbase, voff) do { _Pragma("unroll") for (int _i = 0; _i < 2; ++_i) \
        __builtin_amdgcn_global_load_lds((const unsigned*)((const char*)(gbase) + (voff)[_i]), (LAS unsigned*)(lds + (bufoff) + ldsw + _i * 8192), 16, 0, 0); } while (0)
#define PG8_LDA(dst, b, h) do { _Pragma("unroll") for (int m = 0; m < 4; ++m) _Pragma("unroll") for (int k = 0; k < 2; ++k) dst[m][k] = *(const LAS bf16x8*)(lds + PG8_SA(b, h) + aoff + m * 2048 + k * 1024); } while (0)
#define PG8_LDB(dst, b, h) do { _Pragma("unroll") for (int n = 0; n < 2; ++n) _Pragma("unroll") for (int k = 0; k < 2; ++k) dst[n][k] = *(const LAS bf16x8*)(lds + PG8_SB(b, h) + boff + n * 2048 + k * 1024); } while (0)
#define PG8_MMA(ai, bj, At, Bt) do { __builtin_amdgcn_s_setprio(1); _Pragma("unroll") for (int m = 0; m < 4; ++m) _Pragma("unroll") for (int n = 0; n < 2; ++n) _Pragma("unroll") for (int k = 0; k < 2; ++k) \
        acc[ai][bj][m][n] = __builtin_amdgcn_mfma_f32_16x16x32_bf16(Bt[n][k], At[m][k], acc[ai][bj][m][n], 0, 0, 0); __builtin_amdgcn_s_setprio(0); } while (0)
#define PG8_WAIT_V(n) asm volatile("s_waitcnt vmcnt(" #n ")" ::: "memory")
#define PG8_WAIT_L(n) asm volatile("s_waitcnt lgkmcnt(" #n ")" ::: "memory")
#define PG8_BAR __builtin_amdgcn_s_barrier()
#define PG8_SCHED __builtin_amdgcn_sched_barrier(0)
    Unit cur, nxt; int ui = 0;
    if (!S.next(0, cur)) return;
    f32x4 acc[2][2][4][2];
#pragma unroll
    for (int a = 0; a < 2; ++a)
#pragma unroll
        for (int b = 0; b < 2; ++b)
#pragma unroll
            for (int m = 0; m < 4; ++m)
#pragma unroll
                for (int n = 0; n < 2; ++n) acc[a][b][m][n] = (f32x4){0.f, 0.f, 0.f, 0.f};
    bf16x8 At[4][2], B0[2][2], B1[2][2];
    const char* cA = (const char*)g.A + (size_t)cur.pm * tstep; const char* cB = (const char*)g.Bt + (size_t)cur.pn * tstep;
    PG8_STAGE(PG8_SB(0, 0), cB, voffB); PG8_STAGE(PG8_SB(0, 1), cB + hstep, voffB); PG8_STAGE(PG8_SA(0, 0), cA, voffA); PG8_STAGE(PG8_SA(0, 1), cA + hstep, voffA);
    if (wr == 1) PG8_BAR;
    PG8_WAIT_V(2); PG8_BAR;
    PG8_STAGE(PG8_SB(1, 0), cB + kstep, voffB); PG8_STAGE(PG8_SA(1, 0), cA + kstep, voffA); PG8_STAGE(PG8_SB(1, 1), cB + hstep + kstep, voffB);
    PG8_WAIT_V(6); PG8_BAR;
    for (;;) {
        const bool has_next = S.next(ui + 1, nxt);
        const char* nA = has_next ? (const char*)g.A + (size_t)nxt.pm * tstep : cA; const char* nB = has_next ? (const char*)g.Bt + (size_t)nxt.pn * tstep : cB;
#pragma unroll 1
        for (int t = 0; t < nt; t += 2) {
            const bool last = (t == nt - 2);
            const char* a1 = cA + (size_t)(t + 1) * kstep;
            const char* a2 = last ? nA : cA + (size_t)(t + 2) * kstep; const char* b2 = last ? nB : cB + (size_t)(t + 2) * kstep;
            const char* a3 = a2 + kstep; const char* b3 = b2 + kstep;
            PG8_LDB(B0, 0, 0); PG8_LDB(B1, 0, 1); PG8_SCHED; PG8_LDA(At, 0, 0); PG8_STAGE(PG8_SA(1, 1), a1 + hstep, voffA);
            PG8_WAIT_V(8); PG8_WAIT_L(0); PG8_BAR; PG8_MMA(0, 0, At, B0); PG8_MMA(0, 1, At, B1); PG8_BAR; PG8_SCHED;
            PG8_LDA(At, 0, 1); PG8_STAGE(PG8_SB(0, 0), b2, voffB); PG8_STAGE(PG8_SB(0, 1), b2 + hstep, voffB); PG8_STAGE(PG8_SA(0, 0), a2, voffA);
            PG8_WAIT_V(8); PG8_WAIT_L(0); PG8_BAR; PG8_MMA(1, 0, At, B0); PG8_MMA(1, 1, At, B1); PG8_BAR; PG8_SCHED;
            PG8_LDB(B0, 1, 0); PG8_LDB(B1, 1, 1); PG8_SCHED; PG8_LDA(At, 1, 0); PG8_STAGE(PG8_SA(0, 1), a2 + hstep, voffA);
            PG8_WAIT_V(8); PG8_WAIT_L(0); PG8_BAR; PG8_MMA(0, 0, At, B0); PG8_MMA(0, 1, At, B1); PG8_BAR; PG8_SCHED;
            PG8_LDA(At, 1, 1); PG8_STAGE(PG8_SB(1, 0), b3, voffB); PG8_STAGE(PG8_SB(1, 1), b3 + hstep, voffB); PG8_STAGE(PG8_SA(1, 0), a3, voffA);
            PG8_WAIT_V(8); PG8_WAIT_L(0); PG8_BAR; PG8_MMA(1, 0, At, B0); PG8_MMA(1, 1, At, B1); PG8_BAR; PG8_SCHED;
        }
        if constexpr (ALIGN_EPI) { if (wr == 0) PG8_BAR; }
        E(acc, cur, wr, wc, fr, fq);
        if (!has_next) break;
#pragma unroll
        for (int a = 0; a < 2; ++a)
#pragma unroll
            for (int b = 0; b < 2; ++b)
#pragma unroll
                for (int m = 0; m < 4; ++m)
#pragma unroll
                    for (int n = 0; n < 2; ++n) acc[a][b][m][n] = (f32x4){0.f, 0.f, 0.f, 0.f};
        cur = nxt; cA = nA; cB = nB; ++ui;
        if constexpr (ALIGN_EPI) { if (wr == 1) PG8_BAR; }
    }
    PG8_WAIT_V(0);
    if constexpr (!ALIGN_EPI) { if (wr == 0) PG8_BAR; }
    PG8_BAR;
#undef PG8_SA
#undef PG8_SB
#undef PG8_STAGE
#undef PG8_LDA
#undef PG8_LDB
#undef PG8_MMA
#undef PG8_WAIT_V
#undef PG8_WAIT_L
#undef PG8_BAR
#undef PG8_SCHED
}
}
using pg8::Unit;

DI void rope4(f32x4& v0, f32x4& v1, const f32x2* rp) {
#pragma unroll
    for (int j = 0; j < 4; ++j) { const f32x2 cs = rp[j]; const float x1 = v0[j], x2 = v1[j]; v0[j] = x1 * cs.x - x2 * cs.y; v1[j] = x2 * cs.x + x1 * cs.y; }
}
DI void store_bf16_pair(bf16_t* dst, int fq, const f32x4& v0, const f32x4& v1) {
    u32x2 w0, w1; w0.x = pk2(v0[0], v0[1]); w0.y = pk2(v0[2], v0[3]); w1.x = pk2(v1[0], v1[1]); w1.y = pk2(v1[2], v1[3]);
    *(u32x2*)(dst + 4 * fq) = w0; *(u32x2*)(dst + 16 + 4 * fq) = w1;
}

struct EpiIn {
    static constexpr bool PERM = false;
    bf16_t *qda, *kda, *vda, *cq, *ckv, *kr; float *ssq_q, *ssq_kv; const f32x2* rope;
    DI void operator()(const f32x4 (&acc)[2][2][4][2], const Unit& u, int wr, int wc, int fr, int fq) const {
        const bool latent = u.pm < 32;
#pragma unroll
        for (int bj = 0; bj < 2; ++bj) {
            const int cb = u.pn * 256 + bj * 128 + wc * 32;
            if (cb >= INW) continue;
            if (cb < 1024 && !latent) continue;
            const bool is_cq = (cb >= 3072 && cb < 3456), is_ckv = (cb >= 3456 && cb < 3712);
            if (is_cq && !latent) continue;
            const bool do_rope = latent && (cb < 2048 || cb >= 3712);
            const bool colpart = (cb >> 5) & 1;
#pragma unroll
            for (int ai = 0; ai < 2; ++ai)
#pragma unroll
                for (int m = 0; m < 4; ++m) {
                    const int row = u.pm * 256 + ai * 128 + wr * 64 + m * 16 + fr;
                    f32x4 v0 = acc[ai][bj][m][0], v1 = acc[ai][bj][m][1];
                    int b, t; if (latent) { b = row >> 11; t = row & 2047; } else { b = (row - ML) >> 8; t = (row - ML) & 255; }
                    const int keyrow = b * NKEY + (latent ? CTXL + t : t);
                    if (do_rope) { const int pos = colpart ? (t & 63) : (t >> 6); rope4(v0, v1, rope + pos * 16 + 4 * fq); }
                    if (is_cq || is_ckv) {
                        float s = (v0[0] * v0[0] + v0[1] * v0[1]) + (v0[2] * v0[2] + v0[3] * v0[3]) + (v1[0] * v1[0] + v1[1] * v1[1]) + (v1[2] * v1[2] + v1[3] * v1[3]);
                        s += __shfl_xor(s, 16); s += __shfl_xor(s, 32);
                        if (fq == 0) atomicAdd((is_cq ? ssq_q : ssq_kv) + row, s);
                    }
                    bf16_t* dst;
                    if (cb < 1024) dst = qda + (size_t)row * 1024 + cb;
                    else if (cb < 2048) dst = kda + (size_t)keyrow * 1024 + (cb - 1024);
                    else if (cb < 3072) dst = vda + (size_t)keyrow * 1024 + (cb - 2048);
                    else if (cb < 3456) dst = cq + (size_t)row * QRANK + (cb - 3072);
                    else if (cb < 3712) dst = ckv + (size_t)row * KVRANK + (cb - 3456);
                    else dst = kr + (size_t)keyrow * 64 + (cb - 3712);
                    store_bf16_pair(dst, fq, v0, v1);
                    asm volatile("" ::: "memory");
                }
        }
    }
};
struct EpiQmla {
    static constexpr bool PERM = false;
    bf16_t* qmla; const float* ssq_q; const f32x2* rope;
    DI void operator()(const f32x4 (&acc)[2][2][4][2], const Unit& u, int wr, int wc, int fr, int fq) const {
#pragma unroll
        for (int bj = 0; bj < 2; ++bj) {
            const int cb = u.pn * 256 + bj * 128 + wc * 32;
            const int gi = (cb >> 5) % 6;
#pragma unroll
            for (int ai = 0; ai < 2; ++ai)
#pragma unroll
                for (int m = 0; m < 4; ++m) {
                    const int row = u.pm * 256 + ai * 128 + wr * 64 + m * 16 + fr;
                    const float rstd = rsqrtf(ssq_q[row] * (1.0f / QRANK) + EPS);
                    f32x4 v0 = acc[ai][bj][m][0] * rstd, v1 = acc[ai][bj][m][1] * rstd;
                    if (gi >= 4) { const int t = row & 2047; const int pos = (gi == 5) ? (t & 63) : (t >> 6); rope4(v0, v1, rope + pos * 16 + 4 * fq); }
                    store_bf16_pair(qmla + (size_t)row * 1536 + cb, fq, v0, v1);
                    asm volatile("" ::: "memory");
                }
        }
    }
};
struct EpiKv {
    static constexpr bool PERM = false;
    bf16_t* kvm; const float* ssq_kv;
    DI void operator()(const f32x4 (&acc)[2][2][4][2], const Unit& u, int wr, int wc, int fr, int fq) const {
        const bool latent = u.pm < 32;
#pragma unroll
        for (int bj = 0; bj < 2; ++bj) {
            const int cb = u.pn * 256 + bj * 128 + wc * 32;
#pragma unroll
            for (int ai = 0; ai < 2; ++ai)
#pragma unroll
                for (int m = 0; m < 4; ++m) {
                    const int row = u.pm * 256 + ai * 128 + wr * 64 + m * 16 + fr;
                    const float rstd = rsqrtf(ssq_kv[row] * (1.0f / KVRANK) + EPS);
                    int b, t; if (latent) { b = row >> 11; t = row & 2047; } else { b = (row - ML) >> 8; t = (row - ML) & 255; }
                    const int keyrow = b * NKEY + (latent ? CTXL + t : t);
                    const f32x4 v0 = acc[ai][bj][m][0] * rstd, v1 = acc[ai][bj][m][1] * rstd;
                    store_bf16_pair(kvm + (size_t)keyrow * 2048 + cb, fq, v0, v1);
                    asm volatile("" ::: "memory");
                }
        }
    }
};
struct EpiRes {
    static constexpr bool PERM = false;
    const float* base; const float* gate; float* out;
    DI void operator()(const f32x4 (&acc)[2][2][4][2], const Unit& u, int wr, int wc, int fr, int fq) const {
        const int b = u.pm >> 3;
#pragma unroll
        for (int bj = 0; bj < 2; ++bj)
#pragma unroll
            for (int n = 0; n < 2; ++n) {
                const int col = u.pn * 256 + bj * 128 + wc * 32 + n * 16 + 4 * fq;
                const f32x4 gv = *(const f32x4*)(gate + (size_t)b * NMODC + col);
#pragma unroll
                for (int ai = 0; ai < 2; ++ai)
#pragma unroll
                    for (int m = 0; m < 4; ++m) {
                        const int row = u.pm * 256 + ai * 128 + wr * 64 + m * 16 + fr;
                        const size_t off = (size_t)row * DM + col;
                        const f32x4 bs = *(const f32x4*)(base + off);
                        *(f32x4*)(out + off) = bs + gv * acc[ai][bj][m][n];
                    }
            }
    }
};
struct EpiUp {
    static constexpr bool PERM = false;
    bf16_t *gbuf, *ubuf;
    DI void operator()(const f32x4 (&acc)[2][2][4][2], const Unit& u, int wr, int wc, int fr, int fq) const {
        const bool isg = u.pn < 22;
        bf16_t* basep = isg ? gbuf : ubuf;
        const int ct = (isg ? u.pn : u.pn - 22) * 256;
#pragma unroll
        for (int bj = 0; bj < 2; ++bj) {
            const int cb = ct + bj * 128 + wc * 32;
#pragma unroll
            for (int ai = 0; ai < 2; ++ai)
#pragma unroll
                for (int m = 0; m < 4; ++m) {
                    const int row = u.pm * 256 + ai * 128 + wr * 64 + m * 16 + fr;
                    store_bf16_pair(basep + (size_t)row * DFF + cb, fq, acc[ai][bj][m][0], acc[ai][bj][m][1]);
                }
        }
    }
};

DI s16x4 tr_read(LAS const unsigned char* p) { return __builtin_bit_cast(s16x4, __builtin_amdgcn_ds_read_tr16_b64_v4i16((LAS s16x4*)p)); }

template <int DQK>
DI void attn_pass(LAS unsigned char* lds, const bf16_t* qrow, const bf16_t* K0, int ldk0, const bf16_t* K1, int ldk1, const bf16_t* V, int ldv,
                  float cexp, f32x16 (&o)[4], float& lsum_out) {
    constexpr int KST = (DQK + 8) * 2, VST = 320, KBUF = 64 * KST, VBUF = 64 * VST, NKC = DQK / 8, KCH = (64 * NKC) / 512, NKK = DQK / 16, NT = NKEY / 64;
    const int tid = threadIdx.x, lane = tid & 63, r = lane & 31, h = lane >> 5;
    bf16x8 qf[NKK];
#pragma unroll
    for (int kk = 0; kk < NKK; ++kk) qf[kk] = *(const bf16x8*)(qrow + 16 * kk + 8 * h);
#pragma unroll
    for (int d = 0; d < 4; ++d)
#pragma unroll
        for (int i = 0; i < 16; ++i) o[d][i] = 0.f;
    float mrun = -INFINITY, lsum = 0.f;
    u32x4 kreg[KCH], vreg[2];
    constexpr int NC0 = (DQK == 64) ? 8 : 16, KCH0 = (64 * NC0) / 512;
    unsigned ksrc[KCH]; int kdst[KCH];
#pragma unroll
    for (int i = 0; i < KCH; ++i) {
        if (i < KCH0) { const int ci = tid + 512 * i, key = ci / NC0, c8 = ci % NC0; ksrc[i] = (unsigned)(key * ldk0 + 8 * c8); kdst[i] = key * KST + c8 * 16; }
        else { const int key = tid >> 3, c8 = tid & 7; ksrc[i] = (unsigned)(key * ldk1 + 8 * c8); kdst[i] = key * KST + (16 + c8) * 16; }
    }
    unsigned vsrc[2]; int vdst[2];
#pragma unroll
    for (int i = 0; i < 2; ++i) { const int ci = tid + 512 * i, key = ci >> 4, c8 = ci & 15; vsrc[i] = (unsigned)(key * ldv + 8 * c8); vdst[i] = 2 * KBUF + key * VST + c8 * 16; }
#define AT_GLOAD(t) do { const bf16_t* k0t = K0 + (size_t)(t) * 64 * ldk0; const bf16_t* k1t = K1 + (size_t)(t) * 64 * ldk1; const bf16_t* vt = V + (size_t)(t) * 64 * ldv; \
                         _Pragma("unroll") for (int i = 0; i < KCH; ++i) kreg[i] = *(const u32x4*)((i < KCH0 ? k0t : k1t) + ksrc[i]); \
                         _Pragma("unroll") for (int i = 0; i < 2; ++i) vreg[i] = *(const u32x4*)(vt + vsrc[i]); } while (0)
#define AT_LSTORE(b) do { _Pragma("unroll") for (int i = 0; i < KCH; ++i) *(LAS u32x4*)(lds + (b) * KBUF + kdst[i]) = kreg[i]; \
                          _Pragma("unroll") for (int i = 0; i < 2; ++i) *(LAS u32x4*)(lds + (b) * VBUF + vdst[i]) = vreg[i]; } while (0)
    const int koff = r * KST + 16 * h;
    const int i16 = lane & 15, q4 = i16 >> 2, p4 = i16 & 3, blk = (lane >> 4) & 1;
    const int voff = 2 * KBUF + (4 * h + q4) * VST + 32 * blk + 8 * p4;
    AT_GLOAD(0); AT_LSTORE(0); __syncthreads();
    for (int t = 0; t < NT; ++t) {
        const int b = t & 1;
        f32x16 st[2];
#pragma unroll
        for (int kb = 0; kb < 2; ++kb) {
#pragma unroll
            for (int i = 0; i < 16; ++i) st[kb][i] = 0.f;
#pragma unroll
            for (int kk = 0; kk < NKK; ++kk) {
                const bf16x8 kf = *(const LAS bf16x8*)(lds + b * KBUF + kb * 32 * KST + koff + 32 * kk);
                st[kb] = __builtin_amdgcn_mfma_f32_32x32x16_bf16(kf, qf[kk], st[kb], 0, 0, 0);
            }
        }
        float mx = st[0][0];
#pragma unroll
        for (int kb = 0; kb < 2; ++kb)
#pragma unroll
            for (int i = 0; i < 16; ++i) mx = fmaxf(mx, st[kb][i]);
        mx = fmaxf(mx, __shfl_xor(mx, 32));
        const float mn = fmaxf(mrun, mx);
        const float alpha = __builtin_amdgcn_exp2f((mrun - mn) * cexp);
        const float mc = mn * cexp;
        float ps = 0.f;
#pragma unroll
        for (int kb = 0; kb < 2; ++kb)
#pragma unroll
            for (int i = 0; i < 16; ++i) { const float pv = __builtin_amdgcn_exp2f(st[kb][i] * cexp - mc); st[kb][i] = pv; ps += pv; }
        lsum = lsum * alpha + ps; mrun = mn;
#pragma unroll
        for (int d = 0; d < 4; ++d)
#pragma unroll
            for (int i = 0; i < 16; ++i) o[d][i] *= alpha;
        if (t + 1 < NT) AT_GLOAD(t + 1);
#pragma unroll
        for (int ks = 0; ks < 4; ++ks) {
            const int kb = ks >> 1, s = ks & 1;
            u32x4 pw; pw.x = pk2(st[kb][8 * s + 0], st[kb][8 * s + 1]); pw.y = pk2(st[kb][8 * s + 2], st[kb][8 * s + 3]);
            pw.z = pk2(st[kb][8 * s + 4], st[kb][8 * s + 5]); pw.w = pk2(st[kb][8 * s + 6], st[kb][8 * s + 7]);
            const bf16x8 pf = __builtin_bit_cast(bf16x8, pw);
#pragma unroll
            for (int d = 0; d < 4; ++d) {
                LAS const unsigned char* ap = lds + b * VBUF + voff + (32 * kb + 16 * s) * VST + d * 64;
                const s16x4 lo = tr_read(ap), hi = tr_read(ap + 8 * VST);
                const bf16x8 vf = __builtin_shufflevector(lo, hi, 0, 1, 2, 3, 4, 5, 6, 7);
                o[d] = __builtin_amdgcn_mfma_f32_32x32x16_bf16(vf, pf, o[d], 0, 0, 0);
            }
        }
        if (t + 1 < NT) AT_LSTORE(b ^ 1);
        __syncthreads();
    }
#undef AT_GLOAD
#undef AT_LSTORE
    lsum += __shfl_xor(lsum, 32);
    lsum_out = lsum;
}

struct Ptrs {
    const float* in[24]; float* out; unsigned char* ws;
};

DI void attention_phase(LAS unsigned char* lds, const Ptrs& P) {
    const int tid = threadIdx.x, lane = tid & 63, wave = tid >> 6, r = lane & 31, h = lane >> 5;
    unsigned char* ws = P.ws;
    const bf16_t* QDA = (const bf16_t*)(ws + WS_QDA); const bf16_t* KDA = (const bf16_t*)(ws + WS_KDA); const bf16_t* VDA = (const bf16_t*)(ws + WS_VDA);
    const bf16_t* QMLA = (const bf16_t*)(ws + WS_QMLA); const bf16_t* KVM = (const bf16_t*)(ws + WS_KVM); const bf16_t* KR = (const bf16_t*)(ws + WS_KR);
    bf16_t* MRG = (bf16_t*)(ws + WS_MRG);
    float* O1 = (float*)(ws + WS_O1) + (size_t)blockIdx.x * (16 * 512 * 4);
    const float LOG2E = 1.4426950408889634f;
    float lam;
    { const float s1 = wave_sum(P.in[12][lane] * P.in[13][lane]), s2 = wave_sum(P.in[14][lane] * P.in[15][lane]); lam = expf(s1) - expf(s2) + 0.2f; }
    const float* subln = P.in[16];
    for (int it = blockIdx.x; it < 256; it += gridDim.x) {
        const int b = it >> 6, hd = (it >> 3) & 7, qb = it & 7;
        const int qr = b * SEQ + qb * 256 + wave * 32 + r;
        f32x16 o[4]; float l;
        const bf16_t* qrow = QDA + (size_t)qr * 1024 + hd * 128;
        const bf16_t* Kb = KDA + (size_t)b * NKEY * 1024 + hd * 128;
        const bf16_t* Vb = VDA + (size_t)b * NKEY * 1024 + hd * 128;
        const float c = 0.125f * LOG2E;
        attn_pass<64>(lds, qrow, Kb, 1024, Kb, 1024, Vb, 1024, c, o, l);
        { const float inv = 1.0f / l;
#pragma unroll
          for (int d = 0; d < 4; ++d)
#pragma unroll
              for (int g = 0; g < 4; ++g) { f32x4 v = {o[d][4 * g] * inv, o[d][4 * g + 1] * inv, o[d][4 * g + 2] * inv, o[d][4 * g + 3] * inv};
                  *(f32x4*)(O1 + ((size_t)(d * 4 + g) * 512 + tid) * 4) = v; } }
        attn_pass<64>(lds, qrow + 64, Kb + 64, 1024, Kb + 64, 1024, Vb, 1024, c, o, l);
        const float inv2 = lam / l;
        float ss = 0.f;
#pragma unroll
        for (int d = 0; d < 4; ++d) {
#pragma unroll
            for (int g = 0; g < 4; ++g) { const f32x4 v1 = *(const f32x4*)(O1 + ((size_t)(d * 4 + g) * 512 + tid) * 4);
#pragma unroll
                for (int j = 0; j < 4; ++j) { const float v = v1[j] - o[d][4 * g + j] * inv2; o[d][4 * g + j] = v; ss += v * v; } }
            asm volatile("" ::: "memory");
        }
        ss += __shfl_xor(ss, 32);
        const float rs = rsqrtf(ss * (1.0f / 128.0f) + EPS) * 0.8f;
        bf16_t* orow = MRG + (size_t)qr * 2048 + hd * 128;
#pragma unroll
        for (int d = 0; d < 4; ++d) {
#pragma unroll
            for (int g = 0; g < 4; ++g) { const int dv = 32 * d + 8 * g + 4 * h; const f32x4 w = *(const f32x4*)(subln + dv);
                u32x2 pw; pw.x = pk2(o[d][4 * g] * rs * w[0], o[d][4 * g + 1] * rs * w[1]); pw.y = pk2(o[d][4 * g + 2] * rs * w[2], o[d][4 * g + 3] * rs * w[3]);
                *(u32x2*)(orow + dv) = pw; }
            asm volatile("" ::: "memory");
        }
    }
    for (int it = blockIdx.x; it < 256; it += gridDim.x) {
        const int b = it >> 6, hd = (it >> 3) & 7, qb = it & 7;
        const int qr = b * SEQ + qb * 256 + wave * 32 + r;
        f32x16 o[4]; float l;
        const bf16_t* qrow = QMLA + (size_t)qr * 1536 + hd * 192;
        const bf16_t* Kb = KVM + (size_t)b * NKEY * 2048 + hd * 256;
        const bf16_t* Krp = KR + (size_t)b * NKEY * 64;
        const float c = 0.07216878364870323f * LOG2E;
        attn_pass<192>(lds, qrow, Kb, 2048, Krp, 64, Kb + 128, 2048, c, o, l);
        const float inv = 1.0f / l;
        bf16_t* orow = MRG + (size_t)qr * 2048 + 1024 + hd * 128;
#pragma unroll
        for (int d = 0; d < 4; ++d)
#pragma unroll
            for (int g = 0; g < 4; ++g) { const int dv = 32 * d + 8 * g + 4 * h;
                u32x2 pw; pw.x = pk2(o[d][4 * g] * inv, o[d][4 * g + 1] * inv); pw.y = pk2(o[d][4 * g + 2] * inv, o[d][4 * g + 3] * inv);
                *(u32x2*)(orow + dv) = pw; }
    }
}

DI void ada_unit(LAS unsigned char* lds, const Ptrs& P, int u) {
    const int tid = threadIdx.x, lane = tid & 63, wave = tid >> 6;
    LAS float* sc = (LAS float*)lds; LAS float* red = (LAS float*)(lds + 40960);
    const float* c = P.in[1]; const float* cc = P.in[3]; const float* w_ada = P.in[4]; const float* b_ada = P.in[5];
    float* MOD = (float*)(P.ws + WS_MOD);
    for (int idx = tid; idx < 5 * DM; idx += 512) { const float v = idx < 4 * DM ? c[idx] : cc[idx - 4 * DM]; sc[idx] = v / (1.0f + __expf(-v)); }
    __syncthreads();
    const int cgp = tid & 15, rg = tid >> 4;
    float acc[5][4];
#pragma unroll
    for (int rr = 0; rr < 5; ++rr)
#pragma unroll
        for (int j = 0; j < 4; ++j) acc[rr][j] = 0.f;
    const float* wp = w_ada + (size_t)rg * NMODC + 64 * u + 4 * cgp;
#pragma unroll 8
    for (int i = 0; i < 64; ++i) {
        const f32x4 w = *(const f32x4*)(wp + (size_t)i * 32 * NMODC);
        const int k = rg + 32 * i;
#pragma unroll
        for (int rr = 0; rr < 5; ++rr) { const float s = sc[rr * DM + k];
#pragma unroll
            for (int j = 0; j < 4; ++j) acc[rr][j] += s * w[j]; }
    }
#pragma unroll
    for (int rr = 0; rr < 5; ++rr)
#pragma unroll
        for (int j = 0; j < 4; ++j) { float a = acc[rr][j]; a += __shfl_xor(a, 16); a += __shfl_xor(a, 32); if (lane < 16) red[(wave * 16 + lane) * 20 + rr * 4 + j] = a; }
    __syncthreads();
    if (tid < 320) { const int cg2 = tid / 20, rj = tid % 20, rr = rj >> 2, j = rj & 3; float s = 0.f;
#pragma unroll
        for (int w = 0; w < 8; ++w) s += red[(w * 16 + cg2) * 20 + rj];
        const int col = 64 * u + 4 * cg2 + j; MOD[(size_t)rr * NMODC + col] = s + b_ada[col]; }
    __syncthreads();
}

DI void transpose_unit(LAS unsigned char* lds, const float* W, int K, int N, bf16_t* Wt, int n0, int k0, const float* kscale) {
    const int tid = threadIdx.x;
    LAS float* sf = (LAS float*)lds;
    if (n0 >= N) {
#pragma unroll
        for (int i = 0; i < 2; ++i) { const int idx = tid + 512 * i, kc = idx & 15, n = idx >> 4; *(u32x4*)(Wt + (size_t)(n0 + n) * K + k0 + 8 * kc) = (u32x4){0u, 0u, 0u, 0u}; }
        return;
    }
#pragma unroll
    for (int i = 0; i < 4; ++i) { const int idx = tid + 512 * i, kr = idx >> 4, c4 = idx & 15;
        f32x4 v = *(const f32x4*)(W + (size_t)(k0 + kr) * N + n0 + 4 * c4);
        if (kscale) v = v * kscale[k0 + kr];
#pragma unroll
        for (int j = 0; j < 4; ++j) sf[kr * 65 + 4 * c4 + j] = v[j]; }
    __syncthreads();
#pragma unroll
    for (int i = 0; i < 2; ++i) { const int idx = tid + 512 * i, kc = idx & 15, n = idx >> 4;
        float f[8];
#pragma unroll
        for (int j = 0; j < 8; ++j) f[j] = sf[(8 * kc + j) * 65 + n];
        u32x4 w; w.x = pk2(f[0], f[1]); w.y = pk2(f[2], f[3]); w.z = pk2(f[4], f[5]); w.w = pk2(f[6], f[7]);
        *(u32x4*)(Wt + (size_t)(n0 + n) * K + k0 + 8 * kc) = w; }
    __syncthreads();
}

DI void p0_phase(LAS unsigned char* lds, const Ptrs& P) {
    unsigned char* ws = P.ws;
    constexpr int U_ADA = 192, U_ROPE = 1;
    constexpr int T0 = 60 * 16, T1 = 24 * 3, T2 = 32 * 2, T3 = 32 * 16, T4 = 176 * 16, T5 = 32 * 44;
    constexpr int NU = U_ADA + U_ROPE + T0 + T1 + T2 + T3 + T4 + T5;
    for (int u = blockIdx.x; u < NU; u += gridDim.x) {
        if (u < U_ADA) { ada_unit(lds, P, u); continue; }
        if (u == U_ADA) {
            f32x2* rope = (f32x2*)(ws + WS_ROPE);
            for (int idx = threadIdx.x; idx < 1024; idx += 512) { const int pos = idx >> 4, i = idx & 15;
                const double inv = pow(10000.0, -(double)i / 16.0); const double ang = (double)pos * (double)(float)inv;
                rope[idx] = (f32x2){(float)cos(ang), (float)sin(ang)}; }
            continue;
        }
        int v = u - U_ADA - U_ROPE;
        if (v < T0) { transpose_unit(lds, P.in[7], DM, INW, (bf16_t*)(ws + WS_WIN), (v % 60) * 64, (v / 60) * 128, nullptr); continue; } v -= T0;
        if (v < T1) { transpose_unit(lds, P.in[10], QRANK, 1536, (bf16_t*)(ws + WS_WUQ), (v % 24) * 64, (v / 24) * 128, P.in[8]); continue; } v -= T1;
        if (v < T2) { transpose_unit(lds, P.in[11], KVRANK, 2048, (bf16_t*)(ws + WS_WUKV), (v % 32) * 64, (v / 32) * 128, P.in[9]); continue; } v -= T2;
        if (v < T3) { transpose_unit(lds, P.in[17], DM, DM, (bf16_t*)(ws + WS_WO), (v % 32) * 64, (v / 32) * 128, nullptr); continue; } v -= T3;
        if (v < T4) { transpose_unit(lds, P.in[19], DM, 2 * DFF, (bf16_t*)(ws + WS_WUP), (v % 176) * 64, (v / 176) * 128, nullptr); continue; } v -= T4;
        transpose_unit(lds, P.in[22], DFF, DM, (bf16_t*)(ws + WS_WDN), (v % 32) * 64, (v / 32) * 128, nullptr);
    }
}

DI void norm_mod_phase(const float* X, const float* XC, int nrows, const float* nw, const float* MOD, int shift_idx, int scale_idx, bf16_t* H) {
    const int lane = threadIdx.x & 63, wave = threadIdx.x >> 6;
    for (int row = blockIdx.x * 8 + wave; row < nrows; row += gridDim.x * 8) {
        const float* xr = row < ML ? X + (size_t)row * DM : XC + (size_t)(row - ML) * DM;
        const int mb = row < ML ? (row >> 11) : 4;
        const float* sh = MOD + (size_t)mb * NMODC + shift_idx * DM; const float* scl = MOD + (size_t)mb * NMODC + scale_idx * DM;
        f32x4 v[8]; float ss = 0.f;
#pragma unroll
        for (int i = 0; i < 8; ++i) { v[i] = *(const f32x4*)(xr + 4 * (lane + 64 * i)); ss += (v[i][0] * v[i][0] + v[i][1] * v[i][1]) + (v[i][2] * v[i][2] + v[i][3] * v[i][3]); }
        ss = wave_sum(ss);
        const float rstd = rsqrtf(ss * (1.0f / DM) + EPS);
#pragma unroll
        for (int i = 0; i < 8; ++i) { const int col = 4 * (lane + 64 * i);
            const f32x4 w = *(const f32x4*)(nw + col), s = *(const f32x4*)(scl + col), t = *(const f32x4*)(sh + col);
            const f32x4 y = (v[i] * rstd) * w * (s + 1.0f) + t;
            u32x2 pw; pw.x = pk2(y[0], y[1]); pw.y = pk2(y[2], y[3]);
            *(u32x2*)(H + (size_t)row * DM + col) = pw; }
    }
}
DI void final_norm_phase(float* out, const float* fw) {
    const int lane = threadIdx.x & 63, wave = threadIdx.x >> 6;
    for (int row = blockIdx.x * 8 + wave; row < ML; row += gridDim.x * 8) {
        float* xr = out + (size_t)row * DM;
        f32x4 v[8]; float ss = 0.f;
#pragma unroll
        for (int i = 0; i < 8; ++i) { v[i] = *(const f32x4*)(xr + 4 * (lane + 64 * i)); ss += (v[i][0] * v[i][0] + v[i][1] * v[i][1]) + (v[i][2] * v[i][2] + v[i][3] * v[i][3]); }
        ss = wave_sum(ss);
        const float rstd = rsqrtf(ss * (1.0f / DM) + EPS);
#pragma unroll
        for (int i = 0; i < 8; ++i) { const int col = 4 * (lane + 64 * i); const f32x4 w = *(const f32x4*)(fw + col); *(f32x4*)(xr + col) = (v[i] * rstd) * w; }
    }
}
DI void unpack8(const u32x4& w, float (&f)[8]) { f[0] = bflo(w.x); f[1] = bfhi(w.x); f[2] = bflo(w.y); f[3] = bfhi(w.y); f[4] = bflo(w.z); f[5] = bfhi(w.z); f[6] = bflo(w.w); f[7] = bfhi(w.w); }
DI void act_phase(const bf16_t* G, bf16_t* U, const float* conv_w, const float* conv_b) {
    constexpr int NCC = DFF / 8, RCH = 16, TOTAL = (ML / RCH) * NCC;
    for (int item = blockIdx.x * 512 + threadIdx.x; item < TOTAL; item += gridDim.x * 512) {
        const int cc = item % NCC, rc = item / NCC, t0 = rc * RCH, f = cc * 8;
        float w0[8], w1[8], w2[8], bb[8];
#pragma unroll
        for (int j = 0; j < 8; j += 4) { const f32x4 a = *(const f32x4*)(conv_w + f + j), b = *(const f32x4*)(conv_w + DFF + f + j), c = *(const f32x4*)(conv_w + 2 * DFF + f + j), d = *(const f32x4*)(conv_b + f + j);
#pragma unroll
            for (int q = 0; q < 4; ++q) { w0[j + q] = a[q]; w1[j + q] = b[q]; w2[j + q] = c[q]; bb[j + q] = d[q]; } }
        float prev[8], cur[8], nxt[8], uu[8];
        const bf16_t* gp = G + (size_t)t0 * DFF + f; bf16_t* up = U + (size_t)t0 * DFF + f;
        if (t0 & 2047) unpack8(*(const u32x4*)(gp - DFF), prev); else {
#pragma unroll
            for (int j = 0; j < 8; ++j) prev[j] = 0.f; }
        unpack8(*(const u32x4*)gp, cur);
#pragma unroll 4
        for (int i = 0; i < RCH; ++i) {
            const int t = t0 + i;
            if ((t & 2047) != 2047) unpack8(*(const u32x4*)(gp + (size_t)(i + 1) * DFF), nxt); else {
#pragma unroll
                for (int j = 0; j < 8; ++j) nxt[j] = 0.f; }
            unpack8(*(const u32x4*)(up + (size_t)i * DFF), uu);
            float a[8];
#pragma unroll
            for (int j = 0; j < 8; ++j) { const float z = w0[j] * prev[j] + w1[j] * cur[j] + w2[j] * nxt[j] + bb[j]; a[j] = z / (1.0f + __expf(-z)) * uu[j]; prev[j] = cur[j]; cur[j] = nxt[j]; }
            u32x4 w; w.x = pk2(a[0], a[1]); w.y = pk2(a[2], a[3]); w.z = pk2(a[4], a[5]); w.w = pk2(a[6], a[7]);
            *(u32x4*)(up + (size_t)i * DFF) = w;
        }
    }
}

__global__ void __launch_bounds__(512, 2) fwd_megakernel(Ptrs P) {
    extern __shared__ __attribute__((aligned(16))) unsigned char lds_raw[];
    LAS unsigned char* lds = (LAS unsigned char*)lds_raw;
    cg::grid_group grid = cg::this_grid();
    unsigned char* ws = P.ws;
    const int G = gridDim.x, cid = blockIdx.x;
    float* MOD = (float*)(ws + WS_MOD);
    const f32x2* ROPE = (const f32x2*)(ws + WS_ROPE);
    float* SSQQ = (float*)(ws + WS_SSQ); float* SSQKV = SSQQ + ML;
    bf16_t* H = (bf16_t*)(ws + WS_H);
    float* X1 = (float*)(ws + WS_X1);

#ifndef NO_P0
    p0_phase(lds, P);
#endif
    grid.sync();
    norm_mod_phase(P.in[0], P.in[2], MT, P.in[6], MOD, 0, 1, H);
    grid.sync();
    {
        pg8::Gemm g{H, (const bf16_t*)(ws + WS_WIN), MT, INWP, DM}; pg8::StaticOrder S; S.init(MT, INWP, G, cid);
        EpiIn E{(bf16_t*)(ws + WS_QDA), (bf16_t*)(ws + WS_KDA), (bf16_t*)(ws + WS_VDA), (bf16_t*)(ws + WS_CQ), (bf16_t*)(ws + WS_CKV), (bf16_t*)(ws + WS_KR), SSQQ, SSQKV, ROPE};
#ifndef NO_G1
        pg8::gemm_phase<EpiIn, pg8::StaticOrder, true>(lds, g, S, E);
#endif
    }
    grid.sync();
    {
        pg8::Gemm g{(const bf16_t*)(ws + WS_CQ), (const bf16_t*)(ws + WS_WUQ), ML, 1536, QRANK}; pg8::StaticOrder S; S.init(ML, 1536, G, cid);
        EpiQmla E{(bf16_t*)(ws + WS_QMLA), SSQQ, ROPE};
#if !defined(NO_G2) && !defined(NO_G2A)
        pg8::gemm_phase<EpiQmla, pg8::StaticOrder, true>(lds, g, S, E);
#endif
    }
    {
        pg8::Gemm g{(const bf16_t*)(ws + WS_CKV), (const bf16_t*)(ws + WS_WUKV), MT, 2048, KVRANK}; pg8::StaticOrder S; S.init(MT, 2048, G, (cid + 64) % G);
        EpiKv E{(bf16_t*)(ws + WS_KVM), SSQKV};
#if !defined(NO_G2) && !defined(NO_G2B)
        pg8::gemm_phase<EpiKv, pg8::StaticOrder, true>(lds, g, S, E);
#endif
    }
    grid.sync();
#ifndef NO_ATTN
    attention_phase(lds, P);
#endif
    grid.sync();
    {
        pg8::Gemm g{(const bf16_t*)(ws + WS_MRG), (const bf16_t*)(ws + WS_WO), ML, DM, DM}; pg8::StaticOrder S; S.init(ML, DM, G, cid);
        EpiRes E{P.in[0], MOD + 2 * DM, X1};
#ifndef NO_G3
        pg8::gemm_phase<EpiRes, pg8::StaticOrder, true>(lds, g, S, E);
#endif
    }
    grid.sync();
    norm_mod_phase(X1, nullptr, ML, P.in[18], MOD, 3, 4, H);
    grid.sync();
    {
        pg8::Gemm g{H, (const bf16_t*)(ws + WS_WUP), ML, 2 * DFF, DM}; pg8::StaticOrder S; S.init(ML, 2 * DFF, G, cid);
        EpiUp E{(bf16_t*)(ws + WS_G), (bf16_t*)(ws + WS_U)};
#ifndef NO_G4
        pg8::gemm_phase<EpiUp, pg8::StaticOrder, true>(lds, g, S, E);
#endif
    }
    grid.sync();
#ifndef NO_ACT
    act_phase((const bf16_t*)(ws + WS_G), (bf16_t*)(ws + WS_U), P.in[20], P.in[21]);
#endif
    grid.sync();
    {
        pg8::Gemm g{(const bf16_t*)(ws + WS_U), (const bf16_t*)(ws + WS_WDN), ML, DM, DFF}; pg8::StaticOrder S; S.init(ML, DM, G, cid);
        EpiRes E{X1, MOD + 5 * DM, P.out};
#ifndef NO_G3
        pg8::gemm_phase<EpiRes, pg8::StaticOrder, true>(lds, g, S, E);
#endif
    }
    grid.sync();
    final_norm_phase(P.out, P.in[23]);
}

extern "C" void kernel_launch(void* const* d_in, const int* in_sizes, int n_in, void* d_out, int out_size, void* d_ws, size_t ws_size, hipStream_t stream) {
    static int grid_blocks = 0;
    if (grid_blocks == 0) {
        if (n_in != 24 || out_size != ML * DM || ws_size < WS_END) { fprintf(stderr, "kernel_launch: unexpected shapes (n_in %d out %d ws %zu, need %zu)\n", n_in, out_size, ws_size, (size_t)WS_END); grid_blocks = -1; return; }
        int dev = 0, cus = 0, per_cu = 0;
        hipGetDevice(&dev);
        hipDeviceGetAttribute(&cus, hipDeviceAttributeMultiprocessorCount, dev);
        if (hipFuncSetAttribute((const void*)fwd_megakernel, hipFuncAttributeMaxDynamicSharedMemorySize, LDS_BYTES) != hipSuccess) { fprintf(stderr, "kernel_launch: hipFuncSetAttribute failed\n"); grid_blocks = -1; return; }
        if (hipOccupancyMaxActiveBlocksPerMultiprocessor(&per_cu, (const void*)fwd_megakernel, 512, LDS_BYTES) != hipSuccess || per_cu < 1) { fprintf(stderr, "kernel_launch: occupancy query failed (%d)\n", per_cu); grid_blocks = -1; return; }
        grid_blocks = cus;
    }
    if (grid_blocks < 0) return;
    hipMemsetAsync((unsigned char*)d_ws + WS_SSQ, 0, SSQ_BYTES, stream);
    Ptrs p{};
    for (int i = 0; i < 24; ++i) p.in[i] = (const float*)d_in[i];
    p.out = (float*)d_out; p.ws = (unsigned char*)d_ws;
    void* args[] = {&p};
    hipError_t e = hipLaunchCooperativeKernel((const void*)fwd_megakernel, dim3(grid_blocks), dim3(512), args, LDS_BYTES, stream);
    if (e != hipSuccess) fprintf(stderr, "cooperative launch failed: %s (grid %d)\n", hipGetErrorString(e), grid_blocks);
}
```

```cpp
#include <hip/hip_runtime.h>
#include <hip/hip_cooperative_groups.h>
#include <cstdio>
#include <cstdint>
namespace cg = cooperative_groups;

#define LAS __attribute__((address_space(3)))
#define DI __device__ __forceinline__
typedef unsigned short bf16_t;
typedef short bf16x8 __attribute__((ext_vector_type(8)));
typedef short s16x4 __attribute__((ext_vector_type(4)));
typedef float f32x2 __attribute__((ext_vector_type(2)));
typedef float f32x4 __attribute__((ext_vector_type(4)));
typedef float f32x16 __attribute__((ext_vector_type(16)));
typedef unsigned u32x4 __attribute__((ext_vector_type(4)));
typedef unsigned u32x2 __attribute__((ext_vector_type(2)));
typedef __bf16 bf2_t __attribute__((ext_vector_type(2)));

constexpr int DM = 2048, NBATCH = 4, SEQ = 2048, CTXL = 256, NKEY = SEQ + CTXL;
constexpr int ML = NBATCH * SEQ, MC = NBATCH * CTXL, MT = ML + MC;
constexpr int INW = 3776, INWP = 3840, QRANK = 384, KVRANK = 256, DFF = 5632, NMODC = 6 * DM;
constexpr float EPS = 1e-6f;
constexpr size_t MiB = 1024 * 1024;
constexpr size_t WS_WIN = 0, WS_WUQ = 15 * MiB, WS_WUKV = 17 * MiB, WS_WO = 18 * MiB, WS_WUP = 26 * MiB, WS_WDN = 70 * MiB;
constexpr size_t WS_SMALL = 92 * MiB, WS_MOD = WS_SMALL, WS_ROPE = WS_SMALL + 256 * 1024, WS_SSQ = WS_SMALL + 512 * 1024;
constexpr size_t SSQ_BYTES = (size_t)(ML + MT) * 4;
constexpr size_t WS_BAR = WS_SSQ + 72 * 1024;
constexpr size_t WS_X1 = 93 * MiB, WS_H = 157 * MiB, WS_O1 = WS_H, WS_T = 193 * MiB;
constexpr size_t WS_QDA = WS_T, WS_KDA = WS_T + 16 * MiB, WS_VDA = WS_T + 34 * MiB, WS_CQ = WS_T + 52 * MiB, WS_CKV = WS_T + 58 * MiB,
                 WS_KR = WS_T + 63 * MiB, WS_QMLA = WS_T + 65 * MiB, WS_KVM = WS_T + 89 * MiB, WS_MRG = WS_T + 125 * MiB;
constexpr size_t WS_G = WS_T, WS_U = WS_T + 88 * MiB, WS_END = WS_T + 176 * MiB;
constexpr int LDS_MAIN = 131072, LDS_BYTES = LDS_MAIN + 64;
#ifndef PROBE_DUP
#define PROBE_DUP -1
#endif

DI unsigned pk2(float lo, float hi) { f32x2 v = {lo, hi}; bf2_t b = __builtin_convertvector(v, bf2_t); return __builtin_bit_cast(unsigned, b); }
DI float bflo(unsigned u) { return __builtin_bit_cast(float, u << 16); }
DI float bfhi(unsigned u) { return __builtin_bit_cast(float, u & 0xffff0000u); }
DI float wave_sum(float v) {
#pragma unroll
    for (int o = 1; o < 64; o <<= 1) v += __shfl_xor(v, o);
    return v;
}

namespace pg8 {
constexpr int BM = 256, BK = 64, HALF = 128, HTB = HALF * BK * 2, STAGE_BYTES = 8 * HTB, NXCD = 8, WGM = 8;
DI int lds_byte(int r, int c) { const int st = (r >> 4) * 2 + (c >> 5), rr = r & 15, cc = c & 31, ob = rr * 64 + cc * 2; return st * 1024 + (ob ^ (((ob >> 9) & 1) << 5)); }
DI void stage_rc(int b, int& R, int& C) { const int st = b / 1024, sb = b % 1024, swz = sb ^ (((sb >> 9) & 1) << 5); R = (st >> 1) * 16 + swz / 64; C = (st & 1) * 32 + (swz % 64) / 2; }
DI int perm32(int rho) { const int n = rho >> 4, i = rho & 15; return 8 * (i >> 2) + 4 * n + (i & 3); }
struct Unit { int pm, pn; };
struct Gemm { const bf16_t* A; const bf16_t* Bt; int M, N, K; };
struct StaticOrder {
    int nM, nN, nwg, G, c;
    DI void init(int M, int N, int G_, int c_) { nM = M / BM; nN = N / BM; nwg = nM * nN; G = G_; c = c_; }
    DI bool next(int i, Unit& u) const {
        const long L = (long)i * G + c; if (L >= nwg) return false;
        int wgid = (int)L; { const int q = nwg / NXCD, r = nwg % NXCD, xcd = wgid % NXCD, off = wgid / NXCD; wgid = (xcd < r ? xcd * (q + 1) : r * (q + 1) + (xcd - r) * q) + off; }
        const int nig = WGM * nN, gid = wgid / nig, fm = gid * WGM, gsz = (nM - fm) < WGM ? (nM - fm) : WGM;
        u.pm = fm + ((wgid % nig) % gsz); u.pn = (wgid % nig) / gsz; return true;
    }
};

template <class Epi, class Sched, bool ALIGN_EPI>
DI void gemm_phase(LAS unsigned char* lds, const Gemm g, const Sched& S, const Epi& E) {
    const int tid = threadIdx.x, wid = __builtin_amdgcn_readfirstlane(tid >> 6), lane = tid & 63, wr = wid >> 2, wc = wid & 3, fr = lane & 15, fq = lane >> 4;
    const int K = g.K, nt = K / BK;
    unsigned voffA[2], voffB[2];
#pragma unroll
    for (int i = 0; i < 2; ++i) { int R, C; stage_rc(tid * 16 + i * 8192, R, C); const int Rb = Epi::PERM ? ((R & ~31) + perm32(R & 31)) : R;
        voffA[i] = (unsigned)(R * K + C) * 2u; voffB[i] = (unsigned)(Rb * K + C) * 2u; }
    const size_t kstep = (size_t)(BK * 2);
    const size_t hstep = (size_t)HALF * K * 2;
    const size_t tstep = 2 * hstep;
    const unsigned ldsw = (unsigned)wid * 1024u;
    const int aoff = lds_byte(wr * 64 + fr, fq * 8), boff = lds_byte(wc * 32 + fr, fq * 8);
#define PG8_SA(b, h) (((b) * 2 + (h)) * HTB)
#define PG8_SB(b, h) ((4 + (b) * 2 + (h)) * HTB)
#define PG8_STAGE(bufoff, gbase, voff) do { _Pragma("unroll") for (int _i = 0; _i < 2; ++_i) \
        __builtin_amdgcn_global_load_lds((const unsigned*)((const char*)(gbase) + (voff)[_i]), (LAS unsigned*)(lds + (bufoff) + ldsw + _i * 8192), 16, 0, 0); } while (0)
#define PG8_LDA(dst, b, h) do { _Pragma("unroll") for (int m = 0; m < 4; ++m) _Pragma("unroll") for (int k = 0; k < 2; ++k) dst[m][k] = *(const LAS bf16x8*)(lds + PG8_SA(b, h) + aoff + m * 2048 + k * 1024); } while (0)
#define PG8_LDB(dst, b, h) do { _Pragma("unroll") for (int n = 0; n < 2; ++n) _Pragma("unroll") for (int k = 0; k < 2; ++k) dst[n][k] = *(const LAS bf16x8*)(lds + PG8_SB(b, h) + boff + n * 2048 + k * 1024); } while (0)
#define PG8_MMA(ai, bj, At, Bt) do { __builtin_amdgcn_s_setprio(1); _Pragma("unroll") for (int m = 0; m < 4; ++m) _Pragma("unroll") for (int n = 0; n < 2; ++n) _Pragma("unroll") for (int k = 0; k < 2; ++k) \
        acc[ai][bj][m][n] = __builtin_amdgcn_mfma_f32_16x16x32_bf16(Bt[n][k], At[m][k], acc[ai][bj][m][n], 0, 0, 0); __builtin_amdgcn_s_setprio(0); } while (0)
#define PG8_WAIT_V(n) asm volatile("s_waitcnt vmcnt(" #n ")" ::: "memory")
#define PG8_WAIT_L(n) asm volatile("s_waitcnt lgkmcnt(" #n ")" ::: "memory")
#define PG8_BAR __builtin_amdgcn_s_barrier()
#define PG8_SCHED __builtin_amdgcn_sched_barrier(0)
    Unit cur, nxt; int ui = 0;
    if (!S.next(0, cur)) return;
    f32x4 acc[2][2][4][2];
#pragma unroll
    for (int a = 0; a < 2; ++a)
#pragma unroll
        for (int b = 0; b < 2; ++b)
#pragma unroll
            for (int m = 0; m < 4; ++m)
#pragma unroll
                for (int n = 0; n < 2; ++n) acc[a][b][m][n] = (f32x4){0.f, 0.f, 0.f, 0.f};
    bf16x8 At[4][2], B0[2][2], B1[2][2];
    const char* cA = (const char*)g.A + (size_t)cur.pm * tstep; const char* cB = (const char*)g.Bt + (size_t)cur.pn * tstep;
    PG8_STAGE(PG8_SB(0, 0), cB, voffB); PG8_STAGE(PG8_SB(0, 1), cB + hstep, voffB); PG8_STAGE(PG8_SA(0, 0), cA, voffA); PG8_STAGE(PG8_SA(0, 1), cA + hstep, voffA);
    if (wr == 1) PG8_BAR;
    PG8_WAIT_V(2); PG8_BAR;
    PG8_STAGE(PG8_SB(1, 0), cB + kstep, voffB); PG8_STAGE(PG8_SA(1, 0), cA + kstep, voffA); PG8_STAGE(PG8_SB(1, 1), cB + hstep + kstep, voffB);
    PG8_WAIT_V(6); PG8_BAR;
    for (;;) {
        const bool has_next = S.next(ui + 1, nxt);
        const char* nA = has_next ? (const char*)g.A + (size_t)nxt.pm * tstep : cA; const char* nB = has_next ? (const char*)g.Bt + (size_t)nxt.pn * tstep : cB;
#pragma unroll 1
        for (int t = 0; t < nt; t += 2) {
            const bool last = (t == nt - 2);
            const char* a1 = cA + (size_t)(t + 1) * kstep;
            const char* a2 = last ? nA : cA + (size_t)(t + 2) * kstep; const char* b2 = last ? nB : cB + (size_t)(t + 2) * kstep;
            const char* a3 = a2 + kstep; const char* b3 = b2 + kstep;
            PG8_LDB(B0, 0, 0); PG8_LDB(B1, 0, 1); PG8_SCHED; PG8_LDA(At, 0, 0); PG8_STAGE(PG8_SA(1, 1), a1 + hstep, voffA);
            PG8_WAIT_V(8); PG8_WAIT_L(0); PG8_BAR; PG8_MMA(0, 0, At, B0); PG8_MMA(0, 1, At, B1); PG8_BAR; PG8_SCHED;
            PG8_LDA(At, 0, 1); PG8_STAGE(PG8_SB(0, 0), b2, voffB); PG8_STAGE(PG8_SB(0, 1), b2 + hstep, voffB); PG8_STAGE(PG8_SA(0, 0), a2, voffA);
            PG8_WAIT_V(8); PG8_WAIT_L(0); PG8_BAR; PG8_MMA(1, 0, At, B0); PG8_MMA(1, 1, At, B1); PG8_BAR; PG8_SCHED;
            PG8_LDB(B0, 1, 0); PG8_LDB(B1, 1, 1); PG8_SCHED; PG8_LDA(At, 1, 0); PG8_STAGE(PG8_SA(0, 1), a2 + hstep, voffA);
            PG8_WAIT_V(8); PG8_WAIT_L(0); PG8_BAR; PG8_MMA(0, 0, At, B0); PG8_MMA(0, 1, At, B1); PG8_BAR; PG8_SCHED;
            PG8_LDA(At, 1, 1); PG8_STAGE(PG8_SB(1, 0), b3, voffB); PG8_STAGE(PG8_SB(1, 1), b3 + hstep, voffB); PG8_STAGE(PG8_SA(1, 0), a3, voffA);
            PG8_WAIT_V(8); PG8_WAIT_L(0); PG8_BAR; PG8_MMA(1, 0, At, B0); PG8_MMA(1, 1, At, B1); PG8_BAR; PG8_SCHED;
        }
        if constexpr (ALIGN_EPI) { if (wr == 0) PG8_BAR; }
        E(acc, cur, wr, wc, fr, fq);
        if (!has_next) break;
#pragma unroll
        for (int a = 0; a < 2; ++a)
#pragma unroll
            for (int b = 0; b < 2; ++b)
#pragma unroll
                for (int m = 0; m < 4; ++m)
#pragma unroll
                    for (int n = 0; n < 2; ++n) acc[a][b][m][n] = (f32x4){0.f, 0.f, 0.f, 0.f};
        cur = nxt; cA = nA; cB = nB; ++ui;
        if constexpr (ALIGN_EPI) { if (wr == 1) PG8_BAR; }
    }
    PG8_WAIT_V(0);
    if constexpr (!ALIGN_EPI) { if (wr == 0) PG8_BAR; }
    PG8_BAR;
#undef PG8_SA
#undef PG8_SB
#undef PG8_STAGE
#undef PG8_LDA
#undef PG8_LDB
#undef PG8_MMA
#undef PG8_WAIT_V
#undef PG8_WAIT_L
#undef PG8_BAR
#undef PG8_SCHED
}
}
using pg8::Unit;

DI void rope4(f32x4& v0, f32x4& v1, const f32x2* rp) {
#pragma unroll
    for (int j = 0; j < 4; ++j) { const f32x2 cs = rp[j]; const float x1 = v0[j], x2 = v1[j]; v0[j] = x1 * cs.x - x2 * cs.y; v1[j] = x2 * cs.x + x1 * cs.y; }
}
DI void store_bf16_pair(bf16_t* dst, int fq, const f32x4& v0, const f32x4& v1) {
    u32x2 w0, w1; w0.x = pk2(v0[0], v0[1]); w0.y = pk2(v0[2], v0[3]); w1.x = pk2(v1[0], v1[1]); w1.y = pk2(v1[2], v1[3]);
    *(u32x2*)(dst + 4 * fq) = w0; *(u32x2*)(dst + 16 + 4 * fq) = w1;
}

struct EpiIn {
    static constexpr bool PERM = false;
    bf16_t *qda, *kda, *vda, *cq, *ckv, *kr; float *ssq_q, *ssq_kv; const f32x2* rope; bool do_ssq;
    DI void operator()(const f32x4 (&acc)[2][2][4][2], const Unit& u, int wr, int wc, int fr, int fq) const {
        const bool latent = u.pm < 32;
#pragma unroll
        for (int bj = 0; bj < 2; ++bj) {
            const int cb = u.pn * 256 + bj * 128 + wc * 32;
            if (cb >= INW) continue;
            if (cb < 1024 && !latent) continue;
            const bool is_cq = (cb >= 3072 && cb < 3456), is_ckv = (cb >= 3456 && cb < 3712);
            if (is_cq && !latent) continue;
            const bool do_rope = latent && (cb < 2048 || cb >= 3712);
            const bool colpart = (cb >> 5) & 1;
#pragma unroll
            for (int ai = 0; ai < 2; ++ai)
#pragma unroll
                for (int m = 0; m < 4; ++m) {
                    const int row = u.pm * 256 + ai * 128 + wr * 64 + m * 16 + fr;
                    f32x4 v0 = acc[ai][bj][m][0], v1 = acc[ai][bj][m][1];
                    int b, t; if (latent) { b = row >> 11; t = row & 2047; } else { b = (row - ML) >> 8; t = (row - ML) & 255; }
                    const int keyrow = b * NKEY + (latent ? CTXL + t : t);
                    if (do_rope) { const int pos = colpart ? (t & 63) : (t >> 6); rope4(v0, v1, rope + pos * 16 + 4 * fq); }
                    if ((is_cq || is_ckv) && do_ssq) {
                        float s = (v0[0] * v0[0] + v0[1] * v0[1]) + (v0[2] * v0[2] + v0[3] * v0[3]) + (v1[0] * v1[0] + v1[1] * v1[1]) + (v1[2] * v1[2] + v1[3] * v1[3]);
                        s += __shfl_xor(s, 16); s += __shfl_xor(s, 32);
                        if (fq == 0) atomicAdd((is_cq ? ssq_q : ssq_kv) + row, s);
                    }
                    bf16_t* dst;
                    if (cb < 1024) dst = qda + (size_t)row * 1024 + cb;
                    else if (cb < 2048) dst = kda + (size_t)keyrow * 1024 + (cb - 1024);
                    else if (cb < 3072) dst = vda + (size_t)keyrow * 1024 + (cb - 2048);
                    else if (cb < 3456) dst = cq + (size_t)row * QRANK + (cb - 3072);
                    else if (cb < 3712) dst = ckv + (size_t)row * KVRANK + (cb - 3456);
                    else dst = kr + (size_t)keyrow * 64 + (cb - 3712);
                    store_bf16_pair(dst, fq, v0, v1);
                    asm volatile("" ::: "memory");
                }
        }
    }
};
struct EpiQmla {
    static constexpr bool PERM = false;
    bf16_t* qmla; const float* ssq_q; const f32x2* rope;
    DI void operator()(const f32x4 (&acc)[2][2][4][2], const Unit& u, int wr, int wc, int fr, int fq) const {
#pragma unroll
        for (int bj = 0; bj < 2; ++bj) {
            const int cb = u.pn * 256 + bj * 128 + wc * 32;
            const int gi = (cb >> 5) % 6;
#pragma unroll
            for (int ai = 0; ai < 2; ++ai)
#pragma unroll
                for (int m = 0; m < 4; ++m) {
                    const int row = u.pm * 256 + ai * 128 + wr * 64 + m * 16 + fr;
                    const float rstd = rsqrtf(ssq_q[row] * (1.0f / QRANK) + EPS);
                    f32x4 v0 = acc[ai][bj][m][0] * rstd, v1 = acc[ai][bj][m][1] * rstd;
                    if (gi >= 4) { const int t = row & 2047; const int pos = (gi == 5) ? (t & 63) : (t >> 6); rope4(v0, v1, rope + pos * 16 + 4 * fq); }
                    store_bf16_pair(qmla + (size_t)row * 1536 + cb, fq, v0, v1);
                    asm volatile("" ::: "memory");
                }
        }
    }
};
struct EpiKv {
    static constexpr bool PERM = false;
    bf16_t* kvm; const float* ssq_kv;
    DI void operator()(const f32x4 (&acc)[2][2][4][2], const Unit& u, int wr, int wc, int fr, int fq) const {
        const bool latent = u.pm < 32;
#pragma unroll
        for (int bj = 0; bj < 2; ++bj) {
            const int cb = u.pn * 256 + bj * 128 + wc * 32;
#pragma unroll
            for (int ai = 0; ai < 2; ++ai)
#pragma unroll
                for (int m = 0; m < 4; ++m) {
                    const int row = u.pm * 256 + ai * 128 + wr * 64 + m * 16 + fr;
                    const float rstd = rsqrtf(ssq_kv[row] * (1.0f / KVRANK) + EPS);
                    int b, t; if (latent) { b = row >> 11; t = row & 2047; } else { b = (row - ML) >> 8; t = (row - ML) & 255; }
                    const int keyrow = b * NKEY + (latent ? CTXL + t : t);
                    const f32x4 v0 = acc[ai][bj][m][0] * rstd, v1 = acc[ai][bj][m][1] * rstd;
                    store_bf16_pair(kvm + (size_t)keyrow * 2048 + cb, fq, v0, v1);
                    asm volatile("" ::: "memory");
                }
        }
    }
};
struct EpiRes {
    static constexpr bool PERM = false;
    const float* base; const float* gate; float* out;
    DI void operator()(const f32x4 (&acc)[2][2][4][2], const Unit& u, int wr, int wc, int fr, int fq) const {
        const int b = u.pm >> 3;
#pragma unroll
        for (int bj = 0; bj < 2; ++bj)
#pragma unroll
            for (int n = 0; n < 2; ++n) {
                const int col = u.pn * 256 + bj * 128 + wc * 32 + n * 16 + 4 * fq;
                const f32x4 gv = *(const f32x4*)(gate + (size_t)b * NMODC + col);
#pragma unroll
                for (int ai = 0; ai < 2; ++ai)
#pragma unroll
                    for (int m = 0; m < 4; ++m) {
                        const int row = u.pm * 256 + ai * 128 + wr * 64 + m * 16 + fr;
                        const size_t off = (size_t)row * DM + col;
                        const f32x4 bs = *(const f32x4*)(base + off);
                        *(f32x4*)(out + off) = bs + gv * acc[ai][bj][m][n];
                    }
            }
    }
};
struct EpiUp {
    static constexpr bool PERM = false;
    bf16_t *gbuf, *ubuf;
    DI void operator()(const f32x4 (&acc)[2][2][4][2], const Unit& u, int wr, int wc, int fr, int fq) const {
        const bool isg = u.pn < 22;
        bf16_t* basep = isg ? gbuf : ubuf;
        const int ct = (isg ? u.pn : u.pn - 22) * 256;
#pragma unroll
        for (int bj = 0; bj < 2; ++bj) {
            const int cb = ct + bj * 128 + wc * 32;
#pragma unroll
            for (int ai = 0; ai < 2; ++ai)
#pragma unroll
                for (int m = 0; m < 4; ++m) {
                    const int row = u.pm * 256 + ai * 128 + wr * 64 + m * 16 + fr;
                    store_bf16_pair(basep + (size_t)row * DFF + cb, fq, acc[ai][bj][m][0], acc[ai][bj][m][1]);
                }
        }
    }
};

DI s16x4 tr_read(LAS const unsigned char* p) { return __builtin_bit_cast(s16x4, __builtin_amdgcn_ds_read_tr16_b64_v4i16((LAS s16x4*)p)); }

template <int DQK>
DI void attn_pass(LAS unsigned char* lds, const bf16_t* qrow, const bf16_t* K0, int ldk0, const bf16_t* K1, int ldk1, const bf16_t* V, int ldv,
                  float cexp, f32x16 (&o)[4], float& lsum_out) {
    constexpr int KST = (DQK + 8) * 2, VST = 320, KBUF = 64 * KST, VBUF = 64 * VST, NKC = DQK / 8, KCH = (64 * NKC) / 512, NKK = DQK / 16, NT = NKEY / 64;
    const int tid = threadIdx.x, lane = tid & 63, r = lane & 31, h = lane >> 5;
    bf16x8 qf[NKK];
#pragma unroll
    for (int kk = 0; kk < NKK; ++kk) qf[kk] = *(const bf16x8*)(qrow + 16 * kk + 8 * h);
#pragma unroll
    for (int d = 0; d < 4; ++d)
#pragma unroll
        for (int i = 0; i < 16; ++i) o[d][i] = 0.f;
    float mrun = -INFINITY, lsum = 0.f;
    u32x4 kreg[KCH], vreg[2];
    constexpr int NC0 = (DQK == 64) ? 8 : 16, KCH0 = (64 * NC0) / 512;
    unsigned ksrc[KCH]; int kdst[KCH];
#pragma unroll
    for (int i = 0; i < KCH; ++i) {
        if (i < KCH0) { const int ci = tid + 512 * i, key = ci / NC0, c8 = ci % NC0; ksrc[i] = (unsigned)(key * ldk0 + 8 * c8); kdst[i] = key * KST + c8 * 16; }
        else { const int key = tid >> 3, c8 = tid & 7; ksrc[i] = (unsigned)(key * ldk1 + 8 * c8); kdst[i] = key * KST + (16 + c8) * 16; }
    }
    unsigned vsrc[2]; int vdst[2];
#pragma unroll
    for (int i = 0; i < 2; ++i) { const int ci = tid + 512 * i, key = ci >> 4, c8 = ci & 15; vsrc[i] = (unsigned)(key * ldv + 8 * c8); vdst[i] = 2 * KBUF + key * VST + c8 * 16; }
#define AT_GLOAD(t) do { const bf16_t* k0t = K0 + (size_t)(t) * 64 * ldk0; const bf16_t* k1t = K1 + (size_t)(t) * 64 * ldk1; const bf16_t* vt = V + (size_t)(t) * 64 * ldv; \
                         _Pragma("unroll") for (int i = 0; i < KCH; ++i) kreg[i] = *(const u32x4*)((i < KCH0 ? k0t : k1t) + ksrc[i]); \
                         _Pragma("unroll") for (int i = 0; i < 2; ++i) vreg[i] = *(const u32x4*)(vt + vsrc[i]); } while (0)
#define AT_LSTORE(b) do { _Pragma("unroll") for (int i = 0; i < KCH; ++i) *(LAS u32x4*)(lds + (b) * KBUF + kdst[i]) = kreg[i]; \
                          _Pragma("unroll") for (int i = 0; i < 2; ++i) *(LAS u32x4*)(lds + (b) * VBUF + vdst[i]) = vreg[i]; } while (0)
    const int koff = r * KST + 16 * h;
    const int i16 = lane & 15, q4 = i16 >> 2, p4 = i16 & 3, blk = (lane >> 4) & 1;
    const int voff = 2 * KBUF + (4 * h + q4) * VST + 32 * blk + 8 * p4;
    AT_GLOAD(0); AT_LSTORE(0); __syncthreads();
    for (int t = 0; t < NT; ++t) {
        const int b = t & 1;
        f32x16 st[2];
#pragma unroll
        for (int kb = 0; kb < 2; ++kb) {
#pragma unroll
            for (int i = 0; i < 16; ++i) st[kb][i] = 0.f;
#pragma unroll
            for (int kk = 0; kk < NKK; ++kk) {
                const bf16x8 kf = *(const LAS bf16x8*)(lds + b * KBUF + kb * 32 * KST + koff + 32 * kk);
                st[kb] = __builtin_amdgcn_mfma_f32_32x32x16_bf16(kf, qf[kk], st[kb], 0, 0, 0);
            }
        }
        float mx = st[0][0];
#pragma unroll
        for (int kb = 0; kb < 2; ++kb)
#pragma unroll
            for (int i = 0; i < 16; ++i) mx = fmaxf(mx, st[kb][i]);
        mx = fmaxf(mx, __shfl_xor(mx, 32));
        const float mn = fmaxf(mrun, mx);
        const float alpha = __builtin_amdgcn_exp2f((mrun - mn) * cexp);
        const float mc = mn * cexp;
        float ps = 0.f;
#pragma unroll
        for (int kb = 0; kb < 2; ++kb)
#pragma unroll
            for (int i = 0; i < 16; ++i) { const float pv = __builtin_amdgcn_exp2f(st[kb][i] * cexp - mc); st[kb][i] = pv; ps += pv; }
        lsum = lsum * alpha + ps; mrun = mn;
#pragma unroll
        for (int d = 0; d < 4; ++d)
#pragma unroll
            for (int i = 0; i < 16; ++i) o[d][i] *= alpha;
        if (t + 1 < NT) AT_GLOAD(t + 1);
#pragma unroll
        for (int ks = 0; ks < 4; ++ks) {
            const int kb = ks >> 1, s = ks & 1;
            u32x4 pw; pw.x = pk2(st[kb][8 * s + 0], st[kb][8 * s + 1]); pw.y = pk2(st[kb][8 * s + 2], st[kb][8 * s + 3]);
            pw.z = pk2(st[kb][8 * s + 4], st[kb][8 * s + 5]); pw.w = pk2(st[kb][8 * s + 6], st[kb][8 * s + 7]);
            const bf16x8 pf = __builtin_bit_cast(bf16x8, pw);
#pragma unroll
            for (int d = 0; d < 4; ++d) {
                LAS const unsigned char* ap = lds + b * VBUF + voff + (32 * kb + 16 * s) * VST + d * 64;
                const s16x4 lo = tr_read(ap), hi = tr_read(ap + 8 * VST);
                const bf16x8 vf = __builtin_shufflevector(lo, hi, 0, 1, 2, 3, 4, 5, 6, 7);
                o[d] = __builtin_amdgcn_mfma_f32_32x32x16_bf16(vf, pf, o[d], 0, 0, 0);
            }
        }
        if (t + 1 < NT) AT_LSTORE(b ^ 1);
        __syncthreads();
    }
#undef AT_GLOAD
#undef AT_LSTORE
    lsum += __shfl_xor(lsum, 32);
    lsum_out = lsum;
}

struct Ptrs {
    const float* in[24]; float* out; unsigned char* ws;
};

DI void attention_phase(LAS unsigned char* lds, const Ptrs& P) {
    const int tid = threadIdx.x, lane = tid & 63, wave = tid >> 6, r = lane & 31, h = lane >> 5;
    unsigned char* ws = P.ws;
    const bf16_t* QDA = (const bf16_t*)(ws + WS_QDA); const bf16_t* KDA = (const bf16_t*)(ws + WS_KDA); const bf16_t* VDA = (const bf16_t*)(ws + WS_VDA);
    const bf16_t* QMLA = (const bf16_t*)(ws + WS_QMLA); const bf16_t* KVM = (const bf16_t*)(ws + WS_KVM); const bf16_t* KR = (const bf16_t*)(ws + WS_KR);
    bf16_t* MRG = (bf16_t*)(ws + WS_MRG);
    float* O1 = (float*)(ws + WS_O1) + (size_t)blockIdx.x * (16 * 512 * 4);
    const float LOG2E = 1.4426950408889634f;
    float lam;
    { const float s1 = wave_sum(P.in[12][lane] * P.in[13][lane]), s2 = wave_sum(P.in[14][lane] * P.in[15][lane]); lam = expf(s1) - expf(s2) + 0.2f; }
    const float* subln = P.in[16];
    for (int it = blockIdx.x; it < 256; it += gridDim.x) {
        const int b = it >> 6, hd = (it >> 3) & 7, qb = it & 7;
        const int qr = b * SEQ + qb * 256 + wave * 32 + r;
        f32x16 o[4]; float l;
        const bf16_t* qrow = QDA + (size_t)qr * 1024 + hd * 128;
        const bf16_t* Kb = KDA + (size_t)b * NKEY * 1024 + hd * 128;
        const bf16_t* Vb = VDA + (size_t)b * NKEY * 1024 + hd * 128;
        const float c = 0.125f * LOG2E;
        attn_pass<64>(lds, qrow, Kb, 1024, Kb, 1024, Vb, 1024, c, o, l);
        { const float inv = 1.0f / l;
#pragma unroll
          for (int d = 0; d < 4; ++d)
#pragma unroll
              for (int g = 0; g < 4; ++g) { f32x4 v = {o[d][4 * g] * inv, o[d][4 * g + 1] * inv, o[d][4 * g + 2] * inv, o[d][4 * g + 3] * inv};
                  *(f32x4*)(O1 + ((size_t)(d * 4 + g) * 512 + tid) * 4) = v; } }
        attn_pass<64>(lds, qrow + 64, Kb + 64, 1024, Kb + 64, 1024, Vb, 1024, c, o, l);
        const float inv2 = lam / l;
        float ss = 0.f;
#pragma unroll
        for (int d = 0; d < 4; ++d) {
#pragma unroll
            for (int g = 0; g < 4; ++g) { const f32x4 v1 = *(const f32x4*)(O1 + ((size_t)(d * 4 + g) * 512 + tid) * 4);
#pragma unroll
                for (int j = 0; j < 4; ++j) { const float v = v1[j] - o[d][4 * g + j] * inv2; o[d][4 * g + j] = v; ss += v * v; } }
            asm volatile("" ::: "memory");
        }
        ss += __shfl_xor(ss, 32);
        const float rs = rsqrtf(ss * (1.0f / 128.0f) + EPS) * 0.8f;
        bf16_t* orow = MRG + (size_t)qr * 2048 + hd * 128;
#pragma unroll
        for (int d = 0; d < 4; ++d) {
#pragma unroll
            for (int g = 0; g < 4; ++g) { const int dv = 32 * d + 8 * g + 4 * h; const f32x4 w = *(const f32x4*)(subln + dv);
                u32x2 pw; pw.x = pk2(o[d][4 * g] * rs * w[0], o[d][4 * g + 1] * rs * w[1]); pw.y = pk2(o[d][4 * g + 2] * rs * w[2], o[d][4 * g + 3] * rs * w[3]);
                *(u32x2*)(orow + dv) = pw; }
            asm volatile("" ::: "memory");
        }
    }
}
DI void attention_mla_phase(LAS unsigned char* lds, const Ptrs& P) {
    const int tid = threadIdx.x, lane = tid & 63, wave = tid >> 6, r = lane & 31, h = lane >> 5;
    unsigned char* ws = P.ws;
    const bf16_t* QMLA = (const bf16_t*)(ws + WS_QMLA); const bf16_t* KVM = (const bf16_t*)(ws + WS_KVM); const bf16_t* KR = (const bf16_t*)(ws + WS_KR);
    bf16_t* MRG = (bf16_t*)(ws + WS_MRG);
    const float LOG2E = 1.4426950408889634f;
    (void)tid;
    for (int it = blockIdx.x; it < 256; it += gridDim.x) {
        const int b = it >> 6, hd = (it >> 3) & 7, qb = it & 7;
        const int qr = b * SEQ + qb * 256 + wave * 32 + r;
        f32x16 o[4]; float l;
        const bf16_t* qrow = QMLA + (size_t)qr * 1536 + hd * 192;
        const bf16_t* Kb = KVM + (size_t)b * NKEY * 2048 + hd * 256;
        const bf16_t* Krp = KR + (size_t)b * NKEY * 64;
        const float c = 0.07216878364870323f * LOG2E;
        attn_pass<192>(lds, qrow, Kb, 2048, Krp, 64, Kb + 128, 2048, c, o, l);
        const float inv = 1.0f / l;
        bf16_t* orow = MRG + (size_t)qr * 2048 + 1024 + hd * 128;
#pragma unroll
        for (int d = 0; d < 4; ++d)
#pragma unroll
            for (int g = 0; g < 4; ++g) { const int dv = 32 * d + 8 * g + 4 * h;
                u32x2 pw; pw.x = pk2(o[d][4 * g] * inv, o[d][4 * g + 1] * inv); pw.y = pk2(o[d][4 * g + 2] * inv, o[d][4 * g + 3] * inv);
                *(u32x2*)(orow + dv) = pw; }
    }
}

DI void ada_unit(LAS unsigned char* lds, const Ptrs& P, int u) {
    const int tid = threadIdx.x, lane = tid & 63, wave = tid >> 6;
    LAS float* sc = (LAS float*)lds; LAS float* red = (LAS float*)(lds + 40960);
    const float* c = P.in[1]; const float* cc = P.in[3]; const float* w_ada = P.in[4]; const float* b_ada = P.in[5];
    float* MOD = (float*)(P.ws + WS_MOD);
    for (int idx = tid; idx < 5 * DM; idx += 512) { const float v = idx < 4 * DM ? c[idx] : cc[idx - 4 * DM]; sc[idx] = v / (1.0f + __expf(-v)); }
    __syncthreads();
    const int cgp = tid & 15, rg = tid >> 4;
    float acc[5][4];
#pragma unroll
    for (int rr = 0; rr < 5; ++rr)
#pragma unroll
        for (int j = 0; j < 4; ++j) acc[rr][j] = 0.f;
    const float* wp = w_ada + (size_t)rg * NMODC + 64 * u + 4 * cgp;
#pragma unroll 8
    for (int i = 0; i < 64; ++i) {
        const f32x4 w = *(const f32x4*)(wp + (size_t)i * 32 * NMODC);
        const int k = rg + 32 * i;
#pragma unroll
        for (int rr = 0; rr < 5; ++rr) { const float s = sc[rr * DM + k];
#pragma unroll
            for (int j = 0; j < 4; ++j) acc[rr][j] += s * w[j]; }
    }
#pragma unroll
    for (int rr = 0; rr < 5; ++rr)
#pragma unroll
        for (int j = 0; j < 4; ++j) { float a = acc[rr][j]; a += __shfl_xor(a, 16); a += __shfl_xor(a, 32); if (lane < 16) red[(wave * 16 + lane) * 20 + rr * 4 + j] = a; }
    __syncthreads();
    if (tid < 320) { const int cg2 = tid / 20, rj = tid % 20, rr = rj >> 2, j = rj & 3; float s = 0.f;
#pragma unroll
        for (int w = 0; w < 8; ++w) s += red[(w * 16 + cg2) * 20 + rj];
        const int col = 64 * u + 4 * cg2 + j; MOD[(size_t)rr * NMODC + col] = s + b_ada[col]; }
    __syncthreads();
}

DI void transpose_unit(LAS unsigned char* lds, const float* W, int K, int N, bf16_t* Wt, int n0, int k0, const float* kscale) {
    const int tid = threadIdx.x;
    LAS float* sf = (LAS float*)lds;
    if (n0 >= N) {
#pragma unroll
        for (int i = 0; i < 2; ++i) { const int idx = tid + 512 * i, kc = idx & 15, n = idx >> 4; *(u32x4*)(Wt + (size_t)(n0 + n) * K + k0 + 8 * kc) = (u32x4){0u, 0u, 0u, 0u}; }
        return;
    }
#pragma unroll
    for (int i = 0; i < 4; ++i) { const int idx = tid + 512 * i, kr = idx >> 4, c4 = idx & 15;
        f32x4 v = *(const f32x4*)(W + (size_t)(k0 + kr) * N + n0 + 4 * c4);
        if (kscale) v = v * kscale[k0 + kr];
#pragma unroll
        for (int j = 0; j < 4; ++j) sf[kr * 65 + 4 * c4 + j] = v[j]; }
    __syncthreads();
#pragma unroll
    for (int i = 0; i < 2; ++i) { const int idx = tid + 512 * i, kc = idx & 15, n = idx >> 4;
        float f[8];
#pragma unroll
        for (int j = 0; j < 8; ++j) f[j] = sf[(8 * kc + j) * 65 + n];
        u32x4 w; w.x = pk2(f[0], f[1]); w.y = pk2(f[2], f[3]); w.z = pk2(f[4], f[5]); w.w = pk2(f[6], f[7]);
        *(u32x4*)(Wt + (size_t)(n0 + n) * K + k0 + 8 * kc) = w; }
    __syncthreads();
}

DI void p0_phase(LAS unsigned char* lds, const Ptrs& P) {
    unsigned char* ws = P.ws;
    constexpr int U_ADA = 192, U_ROPE = 1;
    constexpr int T0 = 60 * 16, T1 = 24 * 3, T2 = 32 * 2, T3 = 32 * 16, T4 = 176 * 16, T5 = 32 * 44;
    constexpr int NU = U_ADA + U_ROPE + T0 + T1 + T2 + T3 + T4 + T5;
    for (int u = blockIdx.x; u < NU; u += gridDim.x) {
        if (u < U_ADA) { ada_unit(lds, P, u); continue; }
        if (u == U_ADA) {
            f32x2* rope = (f32x2*)(ws + WS_ROPE);
            for (int idx = threadIdx.x; idx < 1024; idx += 512) { const int pos = idx >> 4, i = idx & 15;
                const double inv = pow(10000.0, -(double)i / 16.0); const double ang = (double)pos * (double)(float)inv;
                rope[idx] = (f32x2){(float)cos(ang), (float)sin(ang)}; }
            continue;
        }
        int v = u - U_ADA - U_ROPE;
        if (v < T0) { transpose_unit(lds, P.in[7], DM, INW, (bf16_t*)(ws + WS_WIN), (v % 60) * 64, (v / 60) * 128, nullptr); continue; } v -= T0;
        if (v < T1) { transpose_unit(lds, P.in[10], QRANK, 1536, (bf16_t*)(ws + WS_WUQ), (v % 24) * 64, (v / 24) * 128, P.in[8]); continue; } v -= T1;
        if (v < T2) { transpose_unit(lds, P.in[11], KVRANK, 2048, (bf16_t*)(ws + WS_WUKV), (v % 32) * 64, (v / 32) * 128, P.in[9]); continue; } v -= T2;
        if (v < T3) { transpose_unit(lds, P.in[17], DM, DM, (bf16_t*)(ws + WS_WO), (v % 32) * 64, (v / 32) * 128, nullptr); continue; } v -= T3;
        if (v < T4) { transpose_unit(lds, P.in[19], DM, 2 * DFF, (bf16_t*)(ws + WS_WUP), (v % 176) * 64, (v / 176) * 128, nullptr); continue; } v -= T4;
        transpose_unit(lds, P.in[22], DFF, DM, (bf16_t*)(ws + WS_WDN), (v % 32) * 64, (v / 32) * 128, nullptr);
    }
}

DI void norm_mod_phase(const float* X, const float* XC, int nrows, const float* nw, const float* MOD, int shift_idx, int scale_idx, bf16_t* H) {
    const int lane = threadIdx.x & 63, wave = threadIdx.x >> 6;
    for (int row = blockIdx.x * 8 + wave; row < nrows; row += gridDim.x * 8) {
        const float* xr = row < ML ? X + (size_t)row * DM : XC + (size_t)(row - ML) * DM;
        const int mb = row < ML ? (row >> 11) : 4;
        const float* sh = MOD + (size_t)mb * NMODC + shift_idx * DM; const float* scl = MOD + (size_t)mb * NMODC + scale_idx * DM;
        f32x4 v[8]; float ss = 0.f;
#pragma unroll
        for (int i = 0; i < 8; ++i) { v[i] = *(const f32x4*)(xr + 4 * (lane + 64 * i)); ss += (v[i][0] * v[i][0] + v[i][1] * v[i][1]) + (v[i][2] * v[i][2] + v[i][3] * v[i][3]); }
        ss = wave_sum(ss);
        const float rstd = rsqrtf(ss * (1.0f / DM) + EPS);
#pragma unroll
        for (int i = 0; i < 8; ++i) { const int col = 4 * (lane + 64 * i);
            const f32x4 w = *(const f32x4*)(nw + col), s = *(const f32x4*)(scl + col), t = *(const f32x4*)(sh + col);
            const f32x4 y = (v[i] * rstd) * w * (s + 1.0f) + t;
            u32x2 pw; pw.x = pk2(y[0], y[1]); pw.y = pk2(y[2], y[3]);
            *(u32x2*)(H + (size_t)row * DM + col) = pw; }
    }
}
DI void final_norm_phase(const float* xin, float* out, const float* fw) {
    const int lane = threadIdx.x & 63, wave = threadIdx.x >> 6;
    for (int row = blockIdx.x * 8 + wave; row < ML; row += gridDim.x * 8) {
        const float* xr = xin + (size_t)row * DM; float* orow = out + (size_t)row * DM;
        f32x4 v[8]; float ss = 0.f;
#pragma unroll
        for (int i = 0; i < 8; ++i) { v[i] = *(const f32x4*)(xr + 4 * (lane + 64 * i)); ss += (v[i][0] * v[i][0] + v[i][1] * v[i][1]) + (v[i][2] * v[i][2] + v[i][3] * v[i][3]); }
        ss = wave_sum(ss);
        const float rstd = rsqrtf(ss * (1.0f / DM) + EPS);
#pragma unroll
        for (int i = 0; i < 8; ++i) { const int col = 4 * (lane + 64 * i); const f32x4 w = *(const f32x4*)(fw + col); *(f32x4*)(orow + col) = (v[i] * rstd) * w; }
    }
}
DI void unpack8(const u32x4& w, float (&f)[8]) { f[0] = bflo(w.x); f[1] = bfhi(w.x); f[2] = bflo(w.y); f[3] = bfhi(w.y); f[4] = bflo(w.z); f[5] = bfhi(w.z); f[6] = bflo(w.w); f[7] = bfhi(w.w); }
DI void act_phase(const bf16_t* G, const bf16_t* U, bf16_t* OUT, int nrows, const float* conv_w, const float* conv_b) {
    constexpr int NCC = DFF / 8, RCH = 16; const int TOTAL = (nrows / RCH) * NCC;
    for (int item = blockIdx.x * 512 + threadIdx.x; item < TOTAL; item += gridDim.x * 512) {
        const int cc = item % NCC, rc = item / NCC, t0 = rc * RCH, f = cc * 8;
        float w0[8], w1[8], w2[8], bb[8];
#pragma unroll
        for (int j = 0; j < 8; j += 4) { const f32x4 a = *(const f32x4*)(conv_w + f + j), b = *(const f32x4*)(conv_w + DFF + f + j), c = *(const f32x4*)(conv_w + 2 * DFF + f + j), d = *(const f32x4*)(conv_b + f + j);
#pragma unroll
            for (int q = 0; q < 4; ++q) { w0[j + q] = a[q]; w1[j + q] = b[q]; w2[j + q] = c[q]; bb[j + q] = d[q]; } }
        float prev[8], cur[8], nxt[8], uu[8];
        const bf16_t* gp = G + (size_t)t0 * DFF + f; const bf16_t* up = U + (size_t)t0 * DFF + f; bf16_t* op = OUT + (size_t)t0 * DFF + f;
        if (t0 & 2047) unpack8(*(const u32x4*)(gp - DFF), prev); else {
#pragma unroll
            for (int j = 0; j < 8; ++j) prev[j] = 0.f; }
        unpack8(*(const u32x4*)gp, cur);
#pragma unroll 4
        for (int i = 0; i < RCH; ++i) {
            const int t = t0 + i;
            if ((t & 2047) != 2047) unpack8(*(const u32x4*)(gp + (size_t)(i + 1) * DFF), nxt); else {
#pragma unroll
                for (int j = 0; j < 8; ++j) nxt[j] = 0.f; }
            unpack8(*(const u32x4*)(up + (size_t)i * DFF), uu);
            float a[8];
#pragma unroll
            for (int j = 0; j < 8; ++j) { const float z = w0[j] * prev[j] + w1[j] * cur[j] + w2[j] * nxt[j] + bb[j]; a[j] = z / (1.0f + __expf(-z)) * uu[j]; prev[j] = cur[j]; cur[j] = nxt[j]; }
            u32x4 w; w.x = pk2(a[0], a[1]); w.y = pk2(a[2], a[3]); w.z = pk2(a[4], a[5]); w.w = pk2(a[6], a[7]);
            *(u32x4*)(op + (size_t)i * DFF) = w;
        }
    }
}


#define XB_TMO      128
#define XB_XCNT(j)  (256  + 64 * (j))
#define XB_XSUB(j)  (1280 + 64 * (j))
#define XB_XGEN(j)  (2304 + 64 * (j))
#define XB_TOP      3328
#define XB_TOPGEN   3392
#define XCD_BAR_WORDS 3456
#define XB_SPIN_CAP (1u << 22)
DI unsigned xb_ld(unsigned* p)              { return __hip_atomic_load(p, __ATOMIC_RELAXED, __HIP_MEMORY_SCOPE_AGENT); }
DI unsigned xb_add(unsigned* p, unsigned v) { return __hip_atomic_fetch_add(p, v, __ATOMIC_RELAXED, __HIP_MEMORY_SCOPE_AGENT); }
DI unsigned xb_xcc_id() { return (unsigned)__builtin_amdgcn_s_getreg((3 << 11) | 20) & 0xFu; }
#define XB_SPIN(cond, bar) do { unsigned _sp = 0; while (cond) { __builtin_amdgcn_s_sleep(1); \
    if ((++_sp & 255u) == 0u) { if (xb_ld(&(bar)[XB_TMO])) break; if (_sp > XB_SPIN_CAP) { atomicAdd(&(bar)[XB_TMO], 1u); break; } } } } while (0)
struct XcdBarrier { unsigned* bar; unsigned x; volatile LAS unsigned* st; };
DI XcdBarrier xcd_barrier_post(unsigned* bar, volatile LAS unsigned* st) {
    XcdBarrier b; b.bar = bar; b.x = xb_xcc_id(); b.st = st;
    if (threadIdx.x == 0) (void)xb_add(&bar[XB_XCNT(b.x)], 1u);
    return b;
}
DI void xcd_barrier_complete(unsigned* bar, unsigned x, unsigned& nloc, unsigned& nx) {
    const unsigned G = gridDim.x * gridDim.y * gridDim.z;
    unsigned sum, cnt, mine, sp = 0u;
    for (;;) {
        sum = 0u; cnt = 0u; mine = 0u;
#pragma unroll
        for (unsigned j = 0; j < 16; ++j) { const unsigned c = xb_ld(&bar[XB_XCNT(j)]); sum += c; cnt += (c > 0u) ? 1u : 0u; mine = (j == x) ? c : mine; }
        if (sum == G) break;
        __builtin_amdgcn_s_sleep(1);
        if ((++sp & 255u) == 0u) { if (xb_ld(&bar[XB_TMO])) break; if (sp > XB_SPIN_CAP) { atomicAdd(&bar[XB_TMO], 1u); break; } }
    }
    nloc = mine > 0u ? mine : 1u; nx = cnt > 0u ? cnt : 1u;
}
DI void xcd_barrier(const XcdBarrier& b) {
    asm volatile("s_waitcnt vmcnt(0)" ::: "memory");
    __syncthreads();
    if (threadIdx.x == 0) {
        unsigned* bar = b.bar;
        __builtin_amdgcn_s_waitcnt(0);
        unsigned nloc = b.st[0], nx = b.st[1];
        if (nloc == 0u) { xcd_barrier_complete(bar, b.x, nloc, nx); b.st[0] = nloc; b.st[1] = nx; }
        const unsigned old = xb_add(&bar[XB_XSUB(b.x)], 1u);
        const unsigned gen = old / nloc;
        if (old + 1u == (gen + 1u) * nloc) {
            __builtin_amdgcn_fence(__ATOMIC_RELEASE, "agent");
            asm volatile("s_waitcnt vmcnt(0)" ::: "memory");
            const unsigned og = xb_add(&bar[XB_TOP], 1u);
            const unsigned tg = og / nx;
            if (og + 1u == (tg + 1u) * nx) xb_add(&bar[XB_TOPGEN], 1u);
            else XB_SPIN(xb_ld(&bar[XB_TOPGEN]) == tg, bar);
            __builtin_amdgcn_fence(__ATOMIC_ACQUIRE, "agent");
            xb_add(&bar[XB_XGEN(b.x)], 1u);
            asm volatile("s_waitcnt vmcnt(0)" ::: "memory");
        } else {
            XB_SPIN(xb_ld(&bar[XB_XGEN(b.x)]) == gen, bar);
            __builtin_amdgcn_fence(__ATOMIC_ACQUIRE, "agent");
            asm volatile("s_waitcnt vmcnt(0)" ::: "memory");
        }
    }
    __syncthreads();
}

__global__ void __launch_bounds__(512, 2) fwd_megakernel(Ptrs P) {
    extern __shared__ __attribute__((aligned(16))) unsigned char lds_raw[];
    LAS unsigned char* lds = (LAS unsigned char*)lds_raw;
    cg::grid_group grid = cg::this_grid();
    if (gridDim.x == 0x7fffffffu) grid.sync();
    volatile LAS unsigned* bst = (volatile LAS unsigned*)(lds + LDS_MAIN);
    if (threadIdx.x < 4) bst[threadIdx.x] = 0u;
    __syncthreads();
    const XcdBarrier gbar = xcd_barrier_post((unsigned*)(P.ws + WS_BAR), bst);
#define GRID_SYNC() xcd_barrier(gbar)
    unsigned char* ws = P.ws;
    const int G = gridDim.x, cid = blockIdx.x;
    float* MOD = (float*)(ws + WS_MOD);
    const f32x2* ROPE = (const f32x2*)(ws + WS_ROPE);
    float* SSQQ = (float*)(ws + WS_SSQ); float* SSQKV = SSQQ + ML;
    bf16_t* H = (bf16_t*)(ws + WS_H);
    float* X1 = (float*)(ws + WS_X1);

    p0_phase(lds, P);
#if PROBE_DUP == 0
    p0_phase(lds, P);
#endif
    GRID_SYNC();
#if PROBE_DUP == 20
    for (int i_ = 0; i_ < 10; ++i_) GRID_SYNC();
#endif
    norm_mod_phase(P.in[0], P.in[2], MT, P.in[6], MOD, 0, 1, H);
#if PROBE_DUP == 1 || PROBE_DUP == 16
    norm_mod_phase(P.in[0], P.in[2], MT, P.in[6], MOD, 0, 1, H);
#endif
    GRID_SYNC();
    {
        pg8::Gemm g{H, (const bf16_t*)(ws + WS_WIN), MT, INWP, DM}; pg8::StaticOrder S; S.init(MT, INWP, G, cid);
        EpiIn E{(bf16_t*)(ws + WS_QDA), (bf16_t*)(ws + WS_KDA), (bf16_t*)(ws + WS_VDA), (bf16_t*)(ws + WS_CQ), (bf16_t*)(ws + WS_CKV), (bf16_t*)(ws + WS_KR), SSQQ, SSQKV, ROPE, true};
        pg8::gemm_phase<EpiIn, pg8::StaticOrder, true>(lds, g, S, E);
#if PROBE_DUP == 2
        E.do_ssq = false; pg8::gemm_phase<EpiIn, pg8::StaticOrder, true>(lds, g, S, E);
#endif
    }
    GRID_SYNC();
    {
        pg8::Gemm g{(const bf16_t*)(ws + WS_CQ), (const bf16_t*)(ws + WS_WUQ), ML, 1536, QRANK}; pg8::StaticOrder S; S.init(ML, 1536, G, cid);
        EpiQmla E{(bf16_t*)(ws + WS_QMLA), SSQQ, ROPE};
        pg8::gemm_phase<EpiQmla, pg8::StaticOrder, true>(lds, g, S, E);
#if PROBE_DUP == 3 || PROBE_DUP == 35
        pg8::gemm_phase<EpiQmla, pg8::StaticOrder, true>(lds, g, S, E);
#endif
    }
    {
        pg8::Gemm g{(const bf16_t*)(ws + WS_CKV), (const bf16_t*)(ws + WS_WUKV), MT, 2048, KVRANK}; pg8::StaticOrder S; S.init(MT, 2048, G, (cid + 64) % G);
        EpiKv E{(bf16_t*)(ws + WS_KVM), SSQKV};
        pg8::gemm_phase<EpiKv, pg8::StaticOrder, true>(lds, g, S, E);
#if PROBE_DUP == 3 || PROBE_DUP == 35
        pg8::gemm_phase<EpiKv, pg8::StaticOrder, true>(lds, g, S, E);
#endif
    }
    GRID_SYNC();
    attention_phase(lds, P);
#if PROBE_DUP == 41
    attention_phase(lds, P);
#endif
    attention_mla_phase(lds, P);
#if PROBE_DUP == 42
    attention_mla_phase(lds, P);
#endif
    GRID_SYNC();
    {
        pg8::Gemm g{(const bf16_t*)(ws + WS_MRG), (const bf16_t*)(ws + WS_WO), ML, DM, DM}; pg8::StaticOrder S; S.init(ML, DM, G, cid);
        EpiRes E{P.in[0], MOD + 2 * DM, X1};
        pg8::gemm_phase<EpiRes, pg8::StaticOrder, true>(lds, g, S, E);
#if PROBE_DUP == 5 || PROBE_DUP == 35
        pg8::gemm_phase<EpiRes, pg8::StaticOrder, true>(lds, g, S, E);
#endif
    }
    GRID_SYNC();
    norm_mod_phase(X1, nullptr, ML, P.in[18], MOD, 3, 4, H);
#if PROBE_DUP == 6 || PROBE_DUP == 16
    norm_mod_phase(X1, nullptr, ML, P.in[18], MOD, 3, 4, H);
#endif
    GRID_SYNC();
    {
        pg8::Gemm g{H, (const bf16_t*)(ws + WS_WUP), ML, 2 * DFF, DM}; pg8::StaticOrder S; S.init(ML, 2 * DFF, G, cid);
        EpiUp E{(bf16_t*)(ws + WS_G), (bf16_t*)(ws + WS_U)};
        pg8::gemm_phase<EpiUp, pg8::StaticOrder, true>(lds, g, S, E);
#if PROBE_DUP == 7
        pg8::gemm_phase<EpiUp, pg8::StaticOrder, true>(lds, g, S, E);
#endif
    }
    GRID_SYNC();
#if PROBE_DUP == 8
    act_phase((const bf16_t*)(ws + WS_G), (const bf16_t*)(ws + WS_U), (bf16_t*)ws, 6144, P.in[20], P.in[21]);
#endif
    act_phase((const bf16_t*)(ws + WS_G), (const bf16_t*)(ws + WS_U), (bf16_t*)(ws + WS_U), ML, P.in[20], P.in[21]);
    GRID_SYNC();
    {
        pg8::Gemm g{(const bf16_t*)(ws + WS_U), (const bf16_t*)(ws + WS_WDN), ML, DM, DFF}; pg8::StaticOrder S; S.init(ML, DM, G, cid);
        EpiRes E{X1, MOD + 5 * DM, P.out};
        pg8::gemm_phase<EpiRes, pg8::StaticOrder, true>(lds, g, S, E);
#if PROBE_DUP == 9
        pg8::gemm_phase<EpiRes, pg8::StaticOrder, true>(lds, g, S, E);
#endif
    }
    GRID_SYNC();
#if PROBE_DUP == 10
    final_norm_phase(P.out, (float*)ws, P.in[23]);
#endif
    final_norm_phase(P.out, P.out, P.in[23]);
}

extern "C" void kernel_launch(void* const* d_in, const int* in_sizes, int n_in, void* d_out, int out_size, void* d_ws, size_t ws_size, hipStream_t stream) {
    static int grid_blocks = 0;
    if (grid_blocks == 0) {
        if (n_in != 24 || out_size != ML * DM || ws_size < WS_END) { fprintf(stderr, "kernel_launch: unexpected shapes (n_in %d out %d ws %zu, need %zu)\n", n_in, out_size, ws_size, (size_t)WS_END); grid_blocks = -1; return; }
        int dev = 0, cus = 0, per_cu = 0;
        (void)hipGetDevice(&dev);
        (void)hipDeviceGetAttribute(&cus, hipDeviceAttributeMultiprocessorCount, dev);
        if (hipFuncSetAttribute((const void*)fwd_megakernel, hipFuncAttributeMaxDynamicSharedMemorySize, LDS_BYTES) != hipSuccess) { fprintf(stderr, "kernel_launch: hipFuncSetAttribute failed\n"); grid_blocks = -1; return; }
        if (hipOccupancyMaxActiveBlocksPerMultiprocessor(&per_cu, (const void*)fwd_megakernel, 512, LDS_BYTES) != hipSuccess || per_cu < 1) { fprintf(stderr, "kernel_launch: occupancy query failed (%d)\n", per_cu); grid_blocks = -1; return; }
        grid_blocks = cus;
    }
    if (grid_blocks < 0) return;
    (void)hipMemsetAsync((unsigned char*)d_ws + WS_SSQ, 0, (WS_BAR - WS_SSQ) + XCD_BAR_WORDS * 4, stream);
    Ptrs p{};
    for (int i = 0; i < 24; ++i) p.in[i] = (const float*)d_in[i];
    p.out = (float*)d_out; p.ws = (unsigned char*)d_ws;
    void* args[] = {&p};
    hipError_t e = hipLaunchCooperativeKernel((const void*)fwd_megakernel, dim3(grid_blocks), dim3(512), args, LDS_BYTES, stream);
    if (e != hipSuccess) fprintf(stderr, "cooperative launch failed: %s (grid %d)\n", hipGetErrorString(e), grid_blocks);
}
```

```cpp
#include <hip/hip_runtime.h>
#include <hip/hip_cooperative_groups.h>
#include <cstdio>
#include <cstdint>
namespace cg = cooperative_groups;

#define LAS __attribute__((address_space(3)))
#define DI __device__ __forceinline__
typedef unsigned short bf16_t;
typedef short bf16x8 __attribute__((ext_vector_type(8)));
typedef short s16x4 __attribute__((ext_vector_type(4)));
typedef float f32x2 __attribute__((ext_vector_type(2)));
typedef float f32x4 __attribute__((ext_vector_type(4)));
typedef float f32x16 __attribute__((ext_vector_type(16)));
typedef unsigned u32x4 __attribute__((ext_vector_type(4)));
typedef unsigned u32x2 __attribute__((ext_vector_type(2)));
typedef __bf16 bf2_t __attribute__((ext_vector_type(2)));

constexpr int DM = 2048, NBATCH = 4, SEQ = 2048, CTXL = 256, NKEY = SEQ + CTXL;
constexpr int ML = NBATCH * SEQ, MC = NBATCH * CTXL, MT = ML + MC;
constexpr int INW = 3776, INWP = 3840, QRANK = 384, KVRANK = 256, DFF = 5632, NMODC = 6 * DM;
constexpr float EPS = 1e-6f;
constexpr size_t MiB = 1024 * 1024;
constexpr size_t WS_WIN = 0, WS_WUQ = 15 * MiB, WS_WUKV = 17 * MiB, WS_WO = 18 * MiB, WS_WUP = 26 * MiB, WS_WDN = 70 * MiB;
constexpr size_t WS_SMALL = 92 * MiB, WS_MOD = WS_SMALL, WS_ROPE = WS_SMALL + 256 * 1024, WS_SSQ = WS_SMALL + 512 * 1024;
constexpr size_t SSQ_BYTES = (size_t)(ML + MT) * 4;
constexpr size_t WS_BAR = WS_SSQ + 72 * 1024;
constexpr size_t WS_X1 = 93 * MiB, WS_H = 157 * MiB, WS_O1 = WS_H, WS_T = 193 * MiB;
constexpr size_t WS_QDA = WS_T, WS_KDA = WS_T + 16 * MiB, WS_VDA = WS_T + 34 * MiB, WS_CQ = WS_T + 52 * MiB, WS_CKV = WS_T + 58 * MiB,
                 WS_KR = WS_T + 63 * MiB, WS_QMLA = WS_T + 65 * MiB, WS_KVM = WS_T + 89 * MiB, WS_MRG = WS_T + 125 * MiB;
constexpr size_t WS_G = WS_T, WS_U = WS_T + 88 * MiB, WS_END = WS_T + 176 * MiB;
constexpr int LDS_MAIN = 131072, LDS_BYTES = LDS_MAIN + 64;
#ifndef PROBE_DUP
#define PROBE_DUP -1
#endif

DI unsigned pk2(float lo, float hi) { f32x2 v = {lo, hi}; bf2_t b = __builtin_convertvector(v, bf2_t); return __builtin_bit_cast(unsigned, b); }
DI float bflo(unsigned u) { return __builtin_bit_cast(float, u << 16); }
DI float bfhi(unsigned u) { return __builtin_bit_cast(float, u & 0xffff0000u); }
DI float wave_sum(float v) {
#pragma unroll
    for (int o = 1; o < 64; o <<= 1) v += __shfl_xor(v, o);
    return v;
}

namespace pg8 {
constexpr int BM = 256, BK = 64, HALF = 128, HTB = HALF * BK * 2, STAGE_BYTES = 8 * HTB, NXCD = 8, WGM = 8;
DI int lds_byte(int r, int c) { const int st = (r >> 4) * 2 + (c >> 5), rr = r & 15, cc = c & 31, ob = rr * 64 + cc * 2; return st * 1024 + (ob ^ (((ob >> 9) & 1) << 5)); }
DI void stage_rc(int b, int& R, int& C) { const int st = b / 1024, sb = b % 1024, swz = sb ^ (((sb >> 9) & 1) << 5); R = (st >> 1) * 16 + swz / 64; C = (st & 1) * 32 + (swz % 64) / 2; }
DI int perm32(int rho) { const int n = rho >> 4, i = rho & 15; return 8 * (i >> 2) + 4 * n + (i & 3); }
struct Unit { int pm, pn; };
struct Gemm { const bf16_t* A; const bf16_t* Bt; int M, N, K; };
struct StaticOrder {
    int nM, nN, nwg, G, c;
    DI void init(int M, int N, int G_, int c_) { nM = M / BM; nN = N / BM; nwg = nM * nN; G = G_; c = c_; }
    DI bool next(int i, Unit& u) const {
        const long L = (long)i * G + c; if (L >= nwg) return false;
        int wgid = (int)L; { const int q = nwg / NXCD, r = nwg % NXCD, xcd = wgid % NXCD, off = wgid / NXCD; wgid = (xcd < r ? xcd * (q + 1) : r * (q + 1) + (xcd - r) * q) + off; }
        const int nig = WGM * nN, gid = wgid / nig, fm = gid * WGM, gsz = (nM - fm) < WGM ? (nM - fm) : WGM;
        u.pm = fm + ((wgid % nig) % gsz); u.pn = (wgid % nig) / gsz; return true;
    }
};

template <class Epi, class Sched, bool ALIGN_EPI>
DI void gemm_phase(LAS unsigned char* lds, const Gemm g, const Sched& S, const Epi& E) {
    const int tid = threadIdx.x, wid = __builtin_amdgcn_readfirstlane(tid >> 6), lane = tid & 63, wr = wid >> 2, wc = wid & 3, fr = lane & 15, fq = lane >> 4;
    const int K = g.K, nt = K / BK;
    unsigned voffA[2], voffB[2];
#pragma unroll
    for (int i = 0; i < 2; ++i) { int R, C; stage_rc(tid * 16 + i * 8192, R, C); const int Rb = Epi::PERM ? ((R & ~31) + perm32(R & 31)) : R;
        voffA[i] = (unsigned)(R * K + C) * 2u; voffB[i] = (unsigned)(Rb * K + C) * 2u; }
    const size_t kstep = (size_t)(BK * 2);
    const size_t hstep = (size_t)HALF * K * 2;
    const size_t tstep = 2 * hstep;
    const unsigned ldsw = (unsigned)wid * 1024u;
    const int aoff = lds_byte(wr * 64 + fr, fq * 8), boff = lds_byte(wc * 32 + fr, fq * 8);
#define PG8_SA(b, h) (((b) * 2 + (h)) * HTB)
#define PG8_SB(b, h) ((4 + (b) * 2 + (h)) * HTB)
#define PG8_STAGE(bufoff, gbase, voff) do { _Pragma("unroll") for (int _i = 0; _i < 2; ++_i) \
        __builtin_amdgcn_global_load_lds((const unsigned*)((const char*)(gbase) + (voff)[_i]), (LAS unsigned*)(lds + (bufoff) + ldsw + _i * 8192), 16, 0, 0); } while (0)
#define PG8_LDA(dst, b, h) do { _Pragma("unroll") for (int m = 0; m < 4; ++m) _Pragma("unroll") for (int k = 0; k < 2; ++k) dst[m][k] = *(const LAS bf16x8*)(lds + PG8_SA(b, h) + aoff + m * 2048 + k * 1024); } while (0)
#define PG8_LDB(dst, b, h) do { _Pragma("unroll") for (int n = 0; n < 2; ++n) _Pragma("unroll") for (int k = 0; k < 2; ++k) dst[n][k] = *(const LAS bf16x8*)(lds + PG8_SB(b, h) + boff + n * 2048 + k * 1024); } while (0)
#define PG8_MMA(ai, bj, At, Bt) do { __builtin_amdgcn_s_setprio(1); _Pragma("unroll") for (int m = 0; m < 4; ++m) _Pragma("unroll") for (int n = 0; n < 2; ++n) _Pragma("unroll") for (int k = 0; k < 2; ++k) \
        acc[ai][bj][m][n] = __builtin_amdgcn_mfma_f32_16x16x32_bf16(Bt[n][k], At[m][k], acc[ai][bj][m][n], 0, 0, 0); __builtin_amdgcn_s_setprio(0); } while (0)
#define PG8_WAIT_V(n) asm volatile("s_waitcnt vmcnt(" #n ")" ::: "memory")
#define PG8_WAIT_L(n) asm volatile("s_waitcnt lgkmcnt(" #n ")" ::: "memory")
#define PG8_BAR __builtin_amdgcn_s_barrier()
#define PG8_SCHED __builtin_amdgcn_sched_barrier(0)
    Unit cur, nxt; int ui = 0;
    if (!S.next(0, cur)) return;
    f32x4 acc[2][2][4][2];
#pragma unroll
    for (int a = 0; a < 2; ++a)
#pragma unroll
        for (int b = 0; b < 2; ++b)
#pragma unroll
            for (int m = 0; m < 4; ++m)
#pragma unroll
                for (int n = 0; n < 2; ++n) acc[a][b][m][n] = (f32x4){0.f, 0.f, 0.f, 0.f};
    bf16x8 At[4][2], B0[2][2], B1[2][2];
    const char* cA = (const char*)g.A + (size_t)cur.pm * tstep; const char* cB = (const char*)g.Bt + (size_t)cur.pn * tstep;
    PG8_STAGE(PG8_SB(0, 0), cB, voffB); PG8_STAGE(PG8_SB(0, 1), cB + hstep, voffB); PG8_STAGE(PG8_SA(0, 0), cA, voffA); PG8_STAGE(PG8_SA(0, 1), cA + hstep, voffA);
    if (wr == 1) PG8_BAR;
    PG8_WAIT_V(2); PG8_BAR;
    PG8_STAGE(PG8_SB(1, 0), cB + kstep, voffB); PG8_STAGE(PG8_SA(1, 0), cA + kstep, voffA); PG8_STAGE(PG8_SB(1, 1), cB + hstep + kstep, voffB);
    PG8_WAIT_V(6); PG8_BAR;
    for (;;) {
        const bool has_next = S.next(ui + 1, nxt);
        const char* nA = has_next ? (const char*)g.A + (size_t)nxt.pm * tstep : cA; const char* nB = has_next ? (const char*)g.Bt + (size_t)nxt.pn * tstep : cB;
#pragma unroll 1
        for (int t = 0; t < nt; t += 2) {
            const bool last = (t == nt - 2);
            const char* a1 = cA + (size_t)(t + 1) * kstep;
            const char* a2 = last ? nA : cA + (size_t)(t + 2) * kstep; const char* b2 = last ? nB : cB + (size_t)(t + 2) * kstep;
            const char* a3 = a2 + kstep; const char* b3 = b2 + kstep;
            PG8_LDB(B0, 0, 0); PG8_LDB(B1, 0, 1); PG8_SCHED; PG8_LDA(At, 0, 0); PG8_STAGE(PG8_SA(1, 1), a1 + hstep, voffA);
            PG8_WAIT_V(8); PG8_WAIT_L(0); PG8_BAR; PG8_MMA(0, 0, At, B0); PG8_MMA(0, 1, At, B1); PG8_BAR; PG8_SCHED;
            PG8_LDA(At, 0, 1); PG8_STAGE(PG8_SB(0, 0), b2, voffB); PG8_STAGE(PG8_SB(0, 1), b2 + hstep, voffB); PG8_STAGE(PG8_SA(0, 0), a2, voffA);
            PG8_WAIT_V(8); PG8_WAIT_L(0); PG8_BAR; PG8_MMA(1, 0, At, B0); PG8_MMA(1, 1, At, B1); PG8_BAR; PG8_SCHED;
            PG8_LDB(B0, 1, 0); PG8_LDB(B1, 1, 1); PG8_SCHED; PG8_LDA(At, 1, 0); PG8_STAGE(PG8_SA(0, 1), a2 + hstep, voffA);
            PG8_WAIT_V(8); PG8_WAIT_L(0); PG8_BAR; PG8_MMA(0, 0, At, B0); PG8_MMA(0, 1, At, B1); PG8_BAR; PG8_SCHED;
            PG8_LDA(At, 1, 1); PG8_STAGE(PG8_SB(1, 0), b3, voffB); PG8_STAGE(PG8_SB(1, 1), b3 + hstep, voffB); PG8_STAGE(PG8_SA(1, 0), a3, voffA);
            PG8_WAIT_V(8); PG8_WAIT_L(0); PG8_BAR; PG8_MMA(1, 0, At, B0); PG8_MMA(1, 1, At, B1); PG8_BAR; PG8_SCHED;
        }
        if constexpr (ALIGN_EPI) { if (wr == 0) PG8_BAR; }
        E(acc, cur, wr, wc, fr, fq);
        if (!has_next) break;
#pragma unroll
        for (int a = 0; a < 2; ++a)
#pragma unroll
            for (int b = 0; b < 2; ++b)
#pragma unroll
                for (int m = 0; m < 4; ++m)
#pragma unroll
                    for (int n = 0; n < 2; ++n) acc[a][b][m][n] = (f32x4){0.f, 0.f, 0.f, 0.f};
        cur = nxt; cA = nA; cB = nB; ++ui;
        if constexpr (ALIGN_EPI) { if (wr == 1) PG8_BAR; }
    }
    PG8_WAIT_V(0);
    if constexpr (!ALIGN_EPI) { if (wr == 0) PG8_BAR; }
    PG8_BAR;
#undef PG8_SA
#undef PG8_SB
#undef PG8_STAGE
#undef PG8_LDA
#undef PG8_LDB
#undef PG8_MMA
#undef PG8_WAIT_V
#undef PG8_WAIT_L
#undef PG8_BAR
#undef PG8_SCHED
}
}
using pg8::Unit;

DI void rope4(f32x4& v0, f32x4& v1, const f32x2* rp) {
#pragma unroll
    for (int j = 0; j < 4; ++j) { const f32x2 cs = rp[j]; const float x1 = v0[j], x2 = v1[j]; v0[j] = x1 * cs.x - x2 * cs.y; v1[j] = x2 * cs.x + x1 * cs.y; }
}
DI void store_bf16_pair(bf16_t* dst, int fq, const f32x4& v0, const f32x4& v1) {
    u32x2 w0, w1; w0.x = pk2(v0[0], v0[1]); w0.y = pk2(v0[2], v0[3]); w1.x = pk2(v1[0], v1[1]); w1.y = pk2(v1[2], v1[3]);
    *(u32x2*)(dst + 4 * fq) = w0; *(u32x2*)(dst + 16 + 4 * fq) = w1;
}

struct EpiIn {
    static constexpr bool PERM = false;
    bf16_t *qda, *kda, *vda, *cq, *ckv, *kr; float *ssq_q, *ssq_kv; const f32x2* rope; bool do_ssq;
    DI void operator()(const f32x4 (&acc)[2][2][4][2], const Unit& u, int wr, int wc, int fr, int fq) const {
        const bool latent = u.pm < 32;
#pragma unroll
        for (int bj = 0; bj < 2; ++bj) {
            const int cb = u.pn * 256 + bj * 128 + wc * 32;
            if (cb >= INW) continue;
            if (cb < 1024 && !latent) continue;
            const bool is_cq = (cb >= 3072 && cb < 3456), is_ckv = (cb >= 3456 && cb < 3712);
            if (is_cq && !latent) continue;
            const bool do_rope = latent && (cb < 2048 || cb >= 3712);
            const bool colpart = (cb >> 5) & 1;
#pragma unroll
            for (int ai = 0; ai < 2; ++ai)
#pragma unroll
                for (int m = 0; m < 4; ++m) {
                    const int row = u.pm * 256 + ai * 128 + wr * 64 + m * 16 + fr;
                    f32x4 v0 = acc[ai][bj][m][0], v1 = acc[ai][bj][m][1];
                    int b, t; if (latent) { b = row >> 11; t = row & 2047; } else { b = (row - ML) >> 8; t = (row - ML) & 255; }
                    const int keyrow = b * NKEY + (latent ? CTXL + t : t);
                    if (do_rope) { const int pos = colpart ? (t & 63) : (t >> 6); rope4(v0, v1, rope + pos * 16 + 4 * fq); }
                    if ((is_cq || is_ckv) && do_ssq) {
                        float s = (v0[0] * v0[0] + v0[1] * v0[1]) + (v0[2] * v0[2] + v0[3] * v0[3]) + (v1[0] * v1[0] + v1[1] * v1[1]) + (v1[2] * v1[2] + v1[3] * v1[3]);
                        s += __shfl_xor(s, 16); s += __shfl_xor(s, 32);
                        if (fq == 0) atomicAdd((is_cq ? ssq_q : ssq_kv) + row, s);
                    }
                    bf16_t* dst;
                    if (cb < 1024) dst = qda + (size_t)row * 1024 + cb;
                    else if (cb < 2048) dst = kda + (size_t)keyrow * 1024 + (cb - 1024);
                    else if (cb < 3072) dst = vda + (size_t)keyrow * 1024 + (cb - 2048);
                    else if (cb < 3456) dst = cq + (size_t)row * QRANK + (cb - 3072);
                    else if (cb < 3712) dst = ckv + (size_t)row * KVRANK + (cb - 3456);
                    else dst = kr + (size_t)keyrow * 64 + (cb - 3712);
                    store_bf16_pair(dst, fq, v0, v1);
                    asm volatile("" ::: "memory");
                }
        }
    }
};
struct EpiQmla {
    static constexpr bool PERM = false;
    bf16_t* qmla; const float* ssq_q; const f32x2* rope;
    DI void operator()(const f32x4 (&acc)[2][2][4][2], const Unit& u, int wr, int wc, int fr, int fq) const {
#pragma unroll
        for (int bj = 0; bj < 2; ++bj) {
            const int cb = u.pn * 256 + bj * 128 + wc * 32;
            const int gi = (cb >> 5) % 6;
#pragma unroll
            for (int ai = 0; ai < 2; ++ai)
#pragma unroll
                for (int m = 0; m < 4; ++m) {
                    const int row = u.pm * 256 + ai * 128 + wr * 64 + m * 16 + fr;
                    const float rstd = rsqrtf(ssq_q[row] * (1.0f / QRANK) + EPS);
                    f32x4 v0 = acc[ai][bj][m][0] * rstd, v1 = acc[ai][bj][m][1] * rstd;
                    if (gi >= 4) { const int t = row & 2047; const int pos = (gi == 5) ? (t & 63) : (t >> 6); rope4(v0, v1, rope + pos * 16 + 4 * fq); }
                    store_bf16_pair(qmla + (size_t)row * 1536 + cb, fq, v0, v1);
                    asm volatile("" ::: "memory");
                }
        }
    }
};
struct EpiKv {
    static constexpr bool PERM = false;
    bf16_t* kvm; const float* ssq_kv;
    DI void operator()(const f32x4 (&acc)[2][2][4][2], const Unit& u, int wr, int wc, int fr, int fq) const {
        const bool latent = u.pm < 32;
#pragma unroll
        for (int bj = 0; bj < 2; ++bj) {
            const int cb = u.pn * 256 + bj * 128 + wc * 32;
#pragma unroll
            for (int ai = 0; ai < 2; ++ai)
#pragma unroll
                for (int m = 0; m < 4; ++m) {
                    const int row = u.pm * 256 + ai * 128 + wr * 64 + m * 16 + fr;
                    const float rstd = rsqrtf(ssq_kv[row] * (1.0f / KVRANK) + EPS);
                    int b, t; if (latent) { b = row >> 11; t = row & 2047; } else { b = (row - ML) >> 8; t = (row - ML) & 255; }
                    const int keyrow = b * NKEY + (latent ? CTXL + t : t);
                    const f32x4 v0 = acc[ai][bj][m][0] * rstd, v1 = acc[ai][bj][m][1] * rstd;
                    store_bf16_pair(kvm + (size_t)keyrow * 2048 + cb, fq, v0, v1);
                    asm volatile("" ::: "memory");
                }
        }
    }
};
struct EpiRes {
    static constexpr bool PERM = false;
    const float* base; const float* gate; float* out;
    DI void operator()(const f32x4 (&acc)[2][2][4][2], const Unit& u, int wr, int wc, int fr, int fq) const {
        const int b = u.pm >> 3;
#pragma unroll
        for (int bj = 0; bj < 2; ++bj)
#pragma unroll
            for (int n = 0; n < 2; ++n) {
                const int col = u.pn * 256 + bj * 128 + wc * 32 + n * 16 + 4 * fq;
                const f32x4 gv = *(const f32x4*)(gate + (size_t)b * NMODC + col);
#pragma unroll
                for (int ai = 0; ai < 2; ++ai)
#pragma unroll
                    for (int m = 0; m < 4; ++m) {
                        const int row = u.pm * 256 + ai * 128 + wr * 64 + m * 16 + fr;
                        const size_t off = (size_t)row * DM + col;
                        const f32x4 bs = *(const f32x4*)(base + off);
                        *(f32x4*)(out + off) = bs + gv * acc[ai][bj][m][n];
                    }
            }
    }
};
struct EpiUp {
    static constexpr bool PERM = false;
    bf16_t *gbuf, *ubuf;
    DI void operator()(const f32x4 (&acc)[2][2][4][2], const Unit& u, int wr, int wc, int fr, int fq) const {
        const bool isg = u.pn < 22;
        bf16_t* basep = isg ? gbuf : ubuf;
        const int ct = (isg ? u.pn : u.pn - 22) * 256;
#pragma unroll
        for (int bj = 0; bj < 2; ++bj) {
            const int cb = ct + bj * 128 + wc * 32;
#pragma unroll
            for (int ai = 0; ai < 2; ++ai)
#pragma unroll
                for (int m = 0; m < 4; ++m) {
                    const int row = u.pm * 256 + ai * 128 + wr * 64 + m * 16 + fr;
                    store_bf16_pair(basep + (size_t)row * DFF + cb, fq, acc[ai][bj][m][0], acc[ai][bj][m][1]);
                }
        }
    }
};

DI s16x4 tr_read(LAS const unsigned char* p) { return __builtin_bit_cast(s16x4, __builtin_amdgcn_ds_read_tr16_b64_v4i16((LAS s16x4*)p)); }

template <int DQK>
DI void attn_pass(LAS unsigned char* lds, const bf16_t* qrow, const bf16_t* K0, int ldk0, const bf16_t* K1, int ldk1, const bf16_t* V, int ldv,
                  float cexp, f32x16 (&o)[4], float& lsum_out) {
    constexpr int KST = (DQK + 8) * 2, VST = 320, KBUF = 64 * KST, VBUF = 64 * VST, NKC = DQK / 8, KCH = (64 * NKC) / 512, NKK = DQK / 16, NT = NKEY / 64;
    const int tid = threadIdx.x, lane = tid & 63, r = lane & 31, h = lane >> 5;
    bf16x8 qf[NKK];
#pragma unroll
    for (int kk = 0; kk < NKK; ++kk) qf[kk] = *(const bf16x8*)(qrow + 16 * kk + 8 * h);
#pragma unroll
    for (int d = 0; d < 4; ++d)
#pragma unroll
        for (int i = 0; i < 16; ++i) o[d][i] = 0.f;
    float mrun = -INFINITY, lsum = 0.f;
    u32x4 kreg[KCH], vreg[2];
    constexpr int NC0 = (DQK == 64) ? 8 : 16, KCH0 = (64 * NC0) / 512;
    unsigned ksrc[KCH]; int kdst[KCH];
#pragma unroll
    for (int i = 0; i < KCH; ++i) {
        if (i < KCH0) { const int ci = tid + 512 * i, key = ci / NC0, c8 = ci % NC0; ksrc[i] = (unsigned)(key * ldk0 + 8 * c8); kdst[i] = key * KST + c8 * 16; }
        else { const int key = tid >> 3, c8 = tid & 7; ksrc[i] = (unsigned)(key * ldk1 + 8 * c8); kdst[i] = key * KST + (16 + c8) * 16; }
    }
    unsigned vsrc[2]; int vdst[2];
#pragma unroll
    for (int i = 0; i < 2; ++i) { const int ci = tid + 512 * i, key = ci >> 4, c8 = ci & 15; vsrc[i] = (unsigned)(key * ldv + 8 * c8); vdst[i] = 2 * KBUF + key * VST + c8 * 16; }
#define AT_GLOAD(t) do { const bf16_t* k0t = K0 + (size_t)(t) * 64 * ldk0; const bf16_t* k1t = K1 + (size_t)(t) * 64 * ldk1; const bf16_t* vt = V + (size_t)(t) * 64 * ldv; \
                         _Pragma("unroll") for (int i = 0; i < KCH; ++i) kreg[i] = *(const u32x4*)((i < KCH0 ? k0t : k1t) + ksrc[i]); \
                         _Pragma("unroll") for (int i = 0; i < 2; ++i) vreg[i] = *(const u32x4*)(vt + vsrc[i]); } while (0)
#define AT_LSTORE(b) do { _Pragma("unroll") for (int i = 0; i < KCH; ++i) *(LAS u32x4*)(lds + (b) * KBUF + kdst[i]) = kreg[i]; \
                          _Pragma("unroll") for (int i = 0; i < 2; ++i) *(LAS u32x4*)(lds + (b) * VBUF + vdst[i]) = vreg[i]; } while (0)
    const int koff = r * KST + 16 * h;
    const int i16 = lane & 15, q4 = i16 >> 2, p4 = i16 & 3, blk = (lane >> 4) & 1;
    const int voff = 2 * KBUF + (4 * h + q4) * VST + 32 * blk + 8 * p4;
    AT_GLOAD(0); AT_LSTORE(0); __syncthreads();
    for (int t = 0; t < NT; ++t) {
        const int b = t & 1;
        f32x16 st[2];
#pragma unroll
        for (int kb = 0; kb < 2; ++kb) {
#pragma unroll
            for (int i = 0; i < 16; ++i) st[kb][i] = 0.f;
#pragma unroll
            for (int kk = 0; kk < NKK; ++kk) {
                const bf16x8 kf = *(const LAS bf16x8*)(lds + b * KBUF + kb * 32 * KST + koff + 32 * kk);
                st[kb] = __builtin_amdgcn_mfma_f32_32x32x16_bf16(kf, qf[kk], st[kb], 0, 0, 0);
            }
        }
        float mx = st[0][0];
#pragma unroll
        for (int kb = 0; kb < 2; ++kb)
#pragma unroll
            for (int i = 0; i < 16; ++i) mx = fmaxf(mx, st[kb][i]);
        mx = fmaxf(mx, __shfl_xor(mx, 32));
        const float mn = fmaxf(mrun, mx);
        const float alpha = __builtin_amdgcn_exp2f((mrun - mn) * cexp);
        const float mc = mn * cexp;
        float ps = 0.f;
#pragma unroll
        for (int kb = 0; kb < 2; ++kb)
#pragma unroll
            for (int i = 0; i < 16; ++i) { const float pv = __builtin_amdgcn_exp2f(st[kb][i] * cexp - mc); st[kb][i] = pv; ps += pv; }
        lsum = lsum * alpha + ps; mrun = mn;
#pragma unroll
        for (int d = 0; d < 4; ++d)
#pragma unroll
            for (int i = 0; i < 16; ++i) o[d][i] *= alpha;
        if (t + 1 < NT) AT_GLOAD(t + 1);
#pragma unroll
        for (int ks = 0; ks < 4; ++ks) {
            const int kb = ks >> 1, s = ks & 1;
            u32x4 pw; pw.x = pk2(st[kb][8 * s + 0], st[kb][8 * s + 1]); pw.y = pk2(st[kb][8 * s + 2], st[kb][8 * s + 3]);
            pw.z = pk2(st[kb][8 * s + 4], st[kb][8 * s + 5]); pw.w = pk2(st[kb][8 * s + 6], st[kb][8 * s + 7]);
            const bf16x8 pf = __builtin_bit_cast(bf16x8, pw);
#pragma unroll
            for (int d = 0; d < 4; ++d) {
                LAS const unsigned char* ap = lds + b * VBUF + voff + (32 * kb + 16 * s) * VST + d * 64;
                const s16x4 lo = tr_read(ap), hi = tr_read(ap + 8 * VST);
                const bf16x8 vf = __builtin_shufflevector(lo, hi, 0, 1, 2, 3, 4, 5, 6, 7);
                o[d] = __builtin_amdgcn_mfma_f32_32x32x16_bf16(vf, pf, o[d], 0, 0, 0);
            }
        }
        if (t + 1 < NT) AT_LSTORE(b ^ 1);
        __syncthreads();
    }
#undef AT_GLOAD
#undef AT_LSTORE
    lsum += __shfl_xor(lsum, 32);
    lsum_out = lsum;
}

struct Ptrs {
    const float* in[24]; float* out; unsigned char* ws;
};

DI void attention_phase(LAS unsigned char* lds, const Ptrs& P) {
    const int tid = threadIdx.x, lane = tid & 63, wave = tid >> 6, r = lane & 31, h = lane >> 5;
    unsigned char* ws = P.ws;
    const bf16_t* QDA = (const bf16_t*)(ws + WS_QDA); const bf16_t* KDA = (const bf16_t*)(ws + WS_KDA); const bf16_t* VDA = (const bf16_t*)(ws + WS_VDA);
    const bf16_t* QMLA = (const bf16_t*)(ws + WS_QMLA); const bf16_t* KVM = (const bf16_t*)(ws + WS_KVM); const bf16_t* KR = (const bf16_t*)(ws + WS_KR);
    bf16_t* MRG = (bf16_t*)(ws + WS_MRG);
    float* O1 = (float*)(ws + WS_O1) + (size_t)blockIdx.x * (16 * 512 * 4);
    const float LOG2E = 1.4426950408889634f;
    float lam;
    { const float s1 = wave_sum(P.in[12][lane] * P.in[13][lane]), s2 = wave_sum(P.in[14][lane] * P.in[15][lane]); lam = expf(s1) - expf(s2) + 0.2f; }
    const float* subln = P.in[16];
    for (int it = blockIdx.x; it < 256; it += gridDim.x) {
        const int b = it >> 6, hd = (it >> 3) & 7, qb = it & 7;
        const int qr = b * SEQ + qb * 256 + wave * 32 + r;
        f32x16 o[4]; float l;
        const bf16_t* qrow = QDA + (size_t)qr * 1024 + hd * 128;
        const bf16_t* Kb = KDA + (size_t)b * NKEY * 1024 + hd * 128;
        const bf16_t* Vb = VDA + (size_t)b * NKEY * 1024 + hd * 128;
        const float c = 0.125f * LOG2E;
        attn_pass<64>(lds, qrow, Kb, 1024, Kb, 1024, Vb, 1024, c, o, l);
        { const float inv = 1.0f / l;
#pragma unroll
          for (int d = 0; d < 4; ++d)
#pragma unroll
              for (int g = 0; g < 4; ++g) { f32x4 v = {o[d][4 * g] * inv, o[d][4 * g + 1] * inv, o[d][4 * g + 2] * inv, o[d][4 * g + 3] * inv};
                  *(f32x4*)(O1 + ((size_t)(d * 4 + g) * 512 + tid) * 4) = v; } }
        attn_pass<64>(lds, qrow + 64, Kb + 64, 1024, Kb + 64, 1024, Vb, 1024, c, o, l);
        const float inv2 = lam / l;
        float ss = 0.f;
#pragma unroll
        for (int d = 0; d < 4; ++d) {
#pragma unroll
            for (int g = 0; g < 4; ++g) { const f32x4 v1 = *(const f32x4*)(O1 + ((size_t)(d * 4 + g) * 512 + tid) * 4);
#pragma unroll
                for (int j = 0; j < 4; ++j) { const float v = v1[j] - o[d][4 * g + j] * inv2; o[d][4 * g + j] = v; ss += v * v; } }
            asm volatile("" ::: "memory");
        }
        ss += __shfl_xor(ss, 32);
        const float rs = rsqrtf(ss * (1.0f / 128.0f) + EPS) * 0.8f;
        bf16_t* orow = MRG + (size_t)qr * 2048 + hd * 128;
#pragma unroll
        for (int d = 0; d < 4; ++d) {
#pragma unroll
            for (int g = 0; g < 4; ++g) { const int dv = 32 * d + 8 * g + 4 * h; const f32x4 w = *(const f32x4*)(subln + dv);
                u32x2 pw; pw.x = pk2(o[d][4 * g] * rs * w[0], o[d][4 * g + 1] * rs * w[1]); pw.y = pk2(o[d][4 * g + 2] * rs * w[2], o[d][4 * g + 3] * rs * w[3]);
                *(u32x2*)(orow + dv) = pw; }
            asm volatile("" ::: "memory");
        }
    }
}
DI void attention_mla_phase(LAS unsigned char* lds, const Ptrs& P) {
    const int tid = threadIdx.x, lane = tid & 63, wave = tid >> 6, r = lane & 31, h = lane >> 5;
    unsigned char* ws = P.ws;
    const bf16_t* QMLA = (const bf16_t*)(ws + WS_QMLA); const bf16_t* KVM = (const bf16_t*)(ws + WS_KVM); const bf16_t* KR = (const bf16_t*)(ws + WS_KR);
    bf16_t* MRG = (bf16_t*)(ws + WS_MRG);
    const float LOG2E = 1.4426950408889634f;
    (void)tid;
    for (int it = blockIdx.x; it < 256; it += gridDim.x) {
        const int b = it >> 6, hd = (it >> 3) & 7, qb = it & 7;
        const int qr = b * SEQ + qb * 256 + wave * 32 + r;
        f32x16 o[4]; float l;
        const bf16_t* qrow = QMLA + (size_t)qr * 1536 + hd * 192;
        const bf16_t* Kb = KVM + (size_t)b * NKEY * 2048 + hd * 256;
        const bf16_t* Krp = KR + (size_t)b * NKEY * 64;
        const float c = 0.07216878364870323f * LOG2E;
        attn_pass<192>(lds, qrow, Kb, 2048, Krp, 64, Kb + 128, 2048, c, o, l);
        const float inv = 1.0f / l;
        bf16_t* orow = MRG + (size_t)qr * 2048 + 1024 + hd * 128;
#pragma unroll
        for (int d = 0; d < 4; ++d)
#pragma unroll
            for (int g = 0; g < 4; ++g) { const int dv = 32 * d + 8 * g + 4 * h;
                u32x2 pw; pw.x = pk2(o[d][4 * g] * inv, o[d][4 * g + 1] * inv); pw.y = pk2(o[d][4 * g + 2] * inv, o[d][4 * g + 3] * inv);
                *(u32x2*)(orow + dv) = pw; }
    }
}

DI void ada_unit(LAS unsigned char* lds, const Ptrs& P, int u) {
    const int tid = threadIdx.x, lane = tid & 63, wave = tid >> 6;
    LAS float* sc = (LAS float*)lds; LAS float* red = (LAS float*)(lds + 40960);
    const float* c = P.in[1]; const float* cc = P.in[3]; const float* w_ada = P.in[4]; const float* b_ada = P.in[5];
    float* MOD = (float*)(P.ws + WS_MOD);
    for (int idx = tid; idx < 5 * DM; idx += 512) { const float v = idx < 4 * DM ? c[idx] : cc[idx - 4 * DM]; sc[idx] = v / (1.0f + __expf(-v)); }
    __syncthreads();
    const int cgp = tid & 15, rg = tid >> 4;
    float acc[5][4];
#pragma unroll
    for (int rr = 0; rr < 5; ++rr)
#pragma unroll
        for (int j = 0; j < 4; ++j) acc[rr][j] = 0.f;
    const float* wp = w_ada + (size_t)rg * NMODC + 64 * u + 4 * cgp;
#pragma unroll 8
    for (int i = 0; i < 64; ++i) {
        const f32x4 w = *(const f32x4*)(wp + (size_t)i * 32 * NMODC);
        const int k = rg + 32 * i;
#pragma unroll
        for (int rr = 0; rr < 5; ++rr) { const float s = sc[rr * DM + k];
#pragma unroll
            for (int j = 0; j < 4; ++j) acc[rr][j] += s * w[j]; }
    }
#pragma unroll
    for (int rr = 0; rr < 5; ++rr)
#pragma unroll
        for (int j = 0; j < 4; ++j) { float a = acc[rr][j]; a += __shfl_xor(a, 16); a += __shfl_xor(a, 32); if (lane < 16) red[(wave * 16 + lane) * 20 + rr * 4 + j] = a; }
    __syncthreads();
    if (tid < 320) { const int cg2 = tid / 20, rj = tid % 20, rr = rj >> 2, j = rj & 3; float s = 0.f;
#pragma unroll
        for (int w = 0; w < 8; ++w) s += red[(w * 16 + cg2) * 20 + rj];
        const int col = 64 * u + 4 * cg2 + j; MOD[(size_t)rr * NMODC + col] = s + b_ada[col]; }
    __syncthreads();
}

DI void transpose_unit(LAS unsigned char* lds, const float* W, int K, int N, bf16_t* Wt, int n0, int k0, const float* kscale) {
    const int tid = threadIdx.x;
    LAS float* sf = (LAS float*)lds;
    if (n0 >= N) {
#pragma unroll
        for (int i = 0; i < 2; ++i) { const int idx = tid + 512 * i, kc = idx & 15, n = idx >> 4; *(u32x4*)(Wt + (size_t)(n0 + n) * K + k0 + 8 * kc) = (u32x4){0u, 0u, 0u, 0u}; }
        return;
    }
#pragma unroll
    for (int i = 0; i < 4; ++i) { const int idx = tid + 512 * i, kr = idx >> 4, c4 = idx & 15;
        f32x4 v = *(const f32x4*)(W + (size_t)(k0 + kr) * N + n0 + 4 * c4);
        if (kscale) v = v * kscale[k0 + kr];
#pragma unroll
        for (int j = 0; j < 4; ++j) sf[kr * 65 + 4 * c4 + j] = v[j]; }
    __syncthreads();
#pragma unroll
    for (int i = 0; i < 2; ++i) { const int idx = tid + 512 * i, kc = idx & 15, n = idx >> 4;
        float f[8];
#pragma unroll
        for (int j = 0; j < 8; ++j) f[j] = sf[(8 * kc + j) * 65 + n];
        u32x4 w; w.x = pk2(f[0], f[1]); w.y = pk2(f[2], f[3]); w.z = pk2(f[4], f[5]); w.w = pk2(f[6], f[7]);
        *(u32x4*)(Wt + (size_t)(n0 + n) * K + k0 + 8 * kc) = w; }
    __syncthreads();
}

DI void p0_phase(LAS unsigned char* lds, const Ptrs& P) {
    unsigned char* ws = P.ws;
    constexpr int U_ADA = 192, U_ROPE = 1;
    constexpr int T0 = 60 * 16, T1 = 24 * 3, T2 = 32 * 2;
    constexpr int NU = U_ADA + U_ROPE + T0 + T1 + T2;
    for (int u = blockIdx.x; u < NU; u += gridDim.x) {
        if (u < U_ADA) { ada_unit(lds, P, u); continue; }
        if (u == U_ADA) {
            f32x2* rope = (f32x2*)(ws + WS_ROPE);
            for (int idx = threadIdx.x; idx < 1024; idx += 512) { const int pos = idx >> 4, i = idx & 15;
                const double inv = pow(10000.0, -(double)i / 16.0); const double ang = (double)pos * (double)(float)inv;
                rope[idx] = (f32x2){(float)cos(ang), (float)sin(ang)}; }
            continue;
        }
        int v = u - U_ADA - U_ROPE;
        if (v < T0) { transpose_unit(lds, P.in[7], DM, INW, (bf16_t*)(ws + WS_WIN), (v % 60) * 64, (v / 60) * 128, nullptr); continue; } v -= T0;
        if (v < T1) { transpose_unit(lds, P.in[10], QRANK, 1536, (bf16_t*)(ws + WS_WUQ), (v % 24) * 64, (v / 24) * 128, P.in[8]); continue; } v -= T1;
        transpose_unit(lds, P.in[11], KVRANK, 2048, (bf16_t*)(ws + WS_WUKV), (v % 32) * 64, (v / 32) * 128, P.in[9]);
    }
}
DI void convert_wo_wup(LAS unsigned char* lds, const Ptrs& P, int idx, int nblk) {
    unsigned char* ws = P.ws;
    constexpr int T3 = 32 * 16, T4 = 176 * 16;
    for (int v = idx; v < T3 + T4; v += nblk) {
        if (v < T3) transpose_unit(lds, P.in[17], DM, DM, (bf16_t*)(ws + WS_WO), (v % 32) * 64, (v / 32) * 128, nullptr);
        else { const int w = v - T3; transpose_unit(lds, P.in[19], DM, 2 * DFF, (bf16_t*)(ws + WS_WUP), (w % 176) * 64, (w / 176) * 128, nullptr); }
    }
}
DI void convert_wdown(LAS unsigned char* lds, const Ptrs& P, int idx, int nblk) {
    constexpr int T5 = 32 * 44;
    for (int v = idx; v < T5; v += nblk) transpose_unit(lds, P.in[22], DFF, DM, (bf16_t*)(P.ws + WS_WDN), (v % 32) * 64, (v / 32) * 128, nullptr);
}

DI void norm_mod_phase(const float* X, const float* XC, int nrows, const float* nw, const float* MOD, int shift_idx, int scale_idx, bf16_t* H) {
    const int lane = threadIdx.x & 63, wave = threadIdx.x >> 6;
    for (int row = blockIdx.x * 8 + wave; row < nrows; row += gridDim.x * 8) {
        const float* xr = row < ML ? X + (size_t)row * DM : XC + (size_t)(row - ML) * DM;
        const int mb = row < ML ? (row >> 11) : 4;
        const float* sh = MOD + (size_t)mb * NMODC + shift_idx * DM; const float* scl = MOD + (size_t)mb * NMODC + scale_idx * DM;
        f32x4 v[8]; float ss = 0.f;
#pragma unroll
        for (int i = 0; i < 8; ++i) { v[i] = *(const f32x4*)(xr + 4 * (lane + 64 * i)); ss += (v[i][0] * v[i][0] + v[i][1] * v[i][1]) + (v[i][2] * v[i][2] + v[i][3] * v[i][3]); }
        ss = wave_sum(ss);
        const float rstd = rsqrtf(ss * (1.0f / DM) + EPS);
#pragma unroll
        for (int i = 0; i < 8; ++i) { const int col = 4 * (lane + 64 * i);
            const f32x4 w = *(const f32x4*)(nw + col), s = *(const f32x4*)(scl + col), t = *(const f32x4*)(sh + col);
            const f32x4 y = (v[i] * rstd) * w * (s + 1.0f) + t;
            u32x2 pw; pw.x = pk2(y[0], y[1]); pw.y = pk2(y[2], y[3]);
            *(u32x2*)(H + (size_t)row * DM + col) = pw; }
    }
}
DI void final_norm_phase(const float* xin, float* out, const float* fw) {
    const int lane = threadIdx.x & 63, wave = threadIdx.x >> 6;
    for (int row = blockIdx.x * 8 + wave; row < ML; row += gridDim.x * 8) {
        const float* xr = xin + (size_t)row * DM; float* orow = out + (size_t)row * DM;
        f32x4 v[8]; float ss = 0.f;
#pragma unroll
        for (int i = 0; i < 8; ++i) { v[i] = *(const f32x4*)(xr + 4 * (lane + 64 * i)); ss += (v[i][0] * v[i][0] + v[i][1] * v[i][1]) + (v[i][2] * v[i][2] + v[i][3] * v[i][3]); }
        ss = wave_sum(ss);
        const float rstd = rsqrtf(ss * (1.0f / DM) + EPS);
#pragma unroll
        for (int i = 0; i < 8; ++i) { const int col = 4 * (lane + 64 * i); const f32x4 w = *(const f32x4*)(fw + col); *(f32x4*)(orow + col) = (v[i] * rstd) * w; }
    }
}
DI void unpack8(const u32x4& w, float (&f)[8]) { f[0] = bflo(w.x); f[1] = bfhi(w.x); f[2] = bflo(w.y); f[3] = bfhi(w.y); f[4] = bflo(w.z); f[5] = bfhi(w.z); f[6] = bflo(w.w); f[7] = bfhi(w.w); }
DI void act_phase(const bf16_t* G, const bf16_t* U, bf16_t* OUT, int nrows, const float* conv_w, const float* conv_b) {
    constexpr int NCC = DFF / 8, RCH = 16; const int TOTAL = (nrows / RCH) * NCC;
    for (int item = blockIdx.x * 512 + threadIdx.x; item < TOTAL; item += gridDim.x * 512) {
        const int cc = item % NCC, rc = item / NCC, t0 = rc * RCH, f = cc * 8;
        float w0[8], w1[8], w2[8], bb[8];
#pragma unroll
        for (int j = 0; j < 8; j += 4) { const f32x4 a = *(const f32x4*)(conv_w + f + j), b = *(const f32x4*)(conv_w + DFF + f + j), c = *(const f32x4*)(conv_w + 2 * DFF + f + j), d = *(const f32x4*)(conv_b + f + j);
#pragma unroll
            for (int q = 0; q < 4; ++q) { w0[j + q] = a[q]; w1[j + q] = b[q]; w2[j + q] = c[q]; bb[j + q] = d[q]; } }
        float prev[8], cur[8], nxt[8], uu[8];
        const bf16_t* gp = G + (size_t)t0 * DFF + f; const bf16_t* up = U + (size_t)t0 * DFF + f; bf16_t* op = OUT + (size_t)t0 * DFF + f;
        if (t0 & 2047) unpack8(*(const u32x4*)(gp - DFF), prev); else {
#pragma unroll
            for (int j = 0; j < 8; ++j) prev[j] = 0.f; }
        unpack8(*(const u32x4*)gp, cur);
#pragma unroll 4
        for (int i = 0; i < RCH; ++i) {
            const int t = t0 + i;
            if ((t & 2047) != 2047) unpack8(*(const u32x4*)(gp + (size_t)(i + 1) * DFF), nxt); else {
#pragma unroll
                for (int j = 0; j < 8; ++j) nxt[j] = 0.f; }
            unpack8(*(const u32x4*)(up + (size_t)i * DFF), uu);
            float a[8];
#pragma unroll
            for (int j = 0; j < 8; ++j) { const float z = w0[j] * prev[j] + w1[j] * cur[j] + w2[j] * nxt[j] + bb[j]; a[j] = z / (1.0f + __expf(-z)) * uu[j]; prev[j] = cur[j]; cur[j] = nxt[j]; }
            u32x4 w; w.x = pk2(a[0], a[1]); w.y = pk2(a[2], a[3]); w.z = pk2(a[4], a[5]); w.w = pk2(a[6], a[7]);
            *(u32x4*)(op + (size_t)i * DFF) = w;
        }
    }
}


#define XB_TMO      128
#define XB_XCNT(j)  (256  + 64 * (j))
#define XB_XSUB(j)  (1280 + 64 * (j))
#define XB_XGEN(j)  (2304 + 64 * (j))
#define XB_TOP      3328
#define XB_TOPGEN   3392
#define XCD_BAR_WORDS 3456
#define XB_SPIN_CAP (1u << 22)
DI unsigned xb_ld(unsigned* p)              { return __hip_atomic_load(p, __ATOMIC_RELAXED, __HIP_MEMORY_SCOPE_AGENT); }
DI unsigned xb_add(unsigned* p, unsigned v) { return __hip_atomic_fetch_add(p, v, __ATOMIC_RELAXED, __HIP_MEMORY_SCOPE_AGENT); }
DI unsigned xb_xcc_id() { return (unsigned)__builtin_amdgcn_s_getreg((3 << 11) | 20) & 0xFu; }
#define XB_SPIN(cond, bar) do { unsigned _sp = 0; while (cond) { __builtin_amdgcn_s_sleep(1); \
    if ((++_sp & 255u) == 0u) { if (xb_ld(&(bar)[XB_TMO])) break; if (_sp > XB_SPIN_CAP) { atomicAdd(&(bar)[XB_TMO], 1u); break; } } } } while (0)
struct XcdBarrier { unsigned* bar; unsigned x; volatile LAS unsigned* st; };
DI XcdBarrier xcd_barrier_post(unsigned* bar, volatile LAS unsigned* st) {
    XcdBarrier b; b.bar = bar; b.x = xb_xcc_id(); b.st = st;
    if (threadIdx.x == 0) (void)xb_add(&bar[XB_XCNT(b.x)], 1u);
    return b;
}
DI void xcd_barrier_complete(unsigned* bar, unsigned x, unsigned& nloc, unsigned& nx) {
    const unsigned G = gridDim.x * gridDim.y * gridDim.z;
    unsigned sum, cnt, mine, sp = 0u;
    for (;;) {
        sum = 0u; cnt = 0u; mine = 0u;
#pragma unroll
        for (unsigned j = 0; j < 16; ++j) { const unsigned c = xb_ld(&bar[XB_XCNT(j)]); sum += c; cnt += (c > 0u) ? 1u : 0u; mine = (j == x) ? c : mine; }
        if (sum == G) break;
        __builtin_amdgcn_s_sleep(1);
        if ((++sp & 255u) == 0u) { if (xb_ld(&bar[XB_TMO])) break; if (sp > XB_SPIN_CAP) { atomicAdd(&bar[XB_TMO], 1u); break; } }
    }
    nloc = mine > 0u ? mine : 1u; nx = cnt > 0u ? cnt : 1u;
}
DI void xcd_barrier(const XcdBarrier& b) {
    asm volatile("s_waitcnt vmcnt(0)" ::: "memory");
    __syncthreads();
    if (threadIdx.x == 0) {
        unsigned* bar = b.bar;
        __builtin_amdgcn_s_waitcnt(0);
        unsigned nloc = b.st[0], nx = b.st[1];
        if (nloc == 0u) { xcd_barrier_complete(bar, b.x, nloc, nx); b.st[0] = nloc; b.st[1] = nx; }
        const unsigned old = xb_add(&bar[XB_XSUB(b.x)], 1u);
        const unsigned gen = old / nloc;
        if (old + 1u == (gen + 1u) * nloc) {
            __builtin_amdgcn_fence(__ATOMIC_RELEASE, "agent");
            asm volatile("s_waitcnt vmcnt(0)" ::: "memory");
            const unsigned og = xb_add(&bar[XB_TOP], 1u);
            const unsigned tg = og / nx;
            if (og + 1u == (tg + 1u) * nx) xb_add(&bar[XB_TOPGEN], 1u);
            else XB_SPIN(xb_ld(&bar[XB_TOPGEN]) == tg, bar);
            __builtin_amdgcn_fence(__ATOMIC_ACQUIRE, "agent");
            xb_add(&bar[XB_XGEN(b.x)], 1u);
            asm volatile("s_waitcnt vmcnt(0)" ::: "memory");
        } else {
            XB_SPIN(xb_ld(&bar[XB_XGEN(b.x)]) == gen, bar);
            __builtin_amdgcn_fence(__ATOMIC_ACQUIRE, "agent");
            asm volatile("s_waitcnt vmcnt(0)" ::: "memory");
        }
    }
    __syncthreads();
}

__global__ void __launch_bounds__(512, 2) fwd_megakernel(Ptrs P) {
    extern __shared__ __attribute__((aligned(16))) unsigned char lds_raw[];
    LAS unsigned char* lds = (LAS unsigned char*)lds_raw;
    cg::grid_group grid = cg::this_grid();
    if (gridDim.x == 0x7fffffffu) grid.sync();
    volatile LAS unsigned* bst = (volatile LAS unsigned*)(lds + LDS_MAIN);
    if (threadIdx.x < 4) bst[threadIdx.x] = 0u;
    __syncthreads();
    const XcdBarrier gbar = xcd_barrier_post((unsigned*)(P.ws + WS_BAR), bst);
#define GRID_SYNC() xcd_barrier(gbar)
    unsigned char* ws = P.ws;
    const int G = gridDim.x, cid = blockIdx.x;
    float* MOD = (float*)(ws + WS_MOD);
    const f32x2* ROPE = (const f32x2*)(ws + WS_ROPE);
    float* SSQQ = (float*)(ws + WS_SSQ); float* SSQKV = SSQQ + ML;
    bf16_t* H = (bf16_t*)(ws + WS_H);
    float* X1 = (float*)(ws + WS_X1);

    p0_phase(lds, P);
#if PROBE_DUP == 0
    p0_phase(lds, P);
#endif
    GRID_SYNC();
#if PROBE_DUP == 20
    for (int i_ = 0; i_ < 10; ++i_) GRID_SYNC();
#endif
    norm_mod_phase(P.in[0], P.in[2], MT, P.in[6], MOD, 0, 1, H);
#if PROBE_DUP == 1 || PROBE_DUP == 16
    norm_mod_phase(P.in[0], P.in[2], MT, P.in[6], MOD, 0, 1, H);
#endif
    GRID_SYNC();
    {
        pg8::Gemm g{H, (const bf16_t*)(ws + WS_WIN), MT, INWP, DM}; pg8::StaticOrder S; S.init(MT, INWP, G, cid);
        EpiIn E{(bf16_t*)(ws + WS_QDA), (bf16_t*)(ws + WS_KDA), (bf16_t*)(ws + WS_VDA), (bf16_t*)(ws + WS_CQ), (bf16_t*)(ws + WS_CKV), (bf16_t*)(ws + WS_KR), SSQQ, SSQKV, ROPE, true};
        pg8::gemm_phase<EpiIn, pg8::StaticOrder, true>(lds, g, S, E);
#if PROBE_DUP == 2
        E.do_ssq = false; pg8::gemm_phase<EpiIn, pg8::StaticOrder, true>(lds, g, S, E);
#endif
        { const int rem = S.nwg % G; if (rem == 0) convert_wo_wup(lds, P, cid, G); else if (cid >= rem) convert_wo_wup(lds, P, cid - rem, G - rem); }
    }
    GRID_SYNC();
    {
        pg8::Gemm g{(const bf16_t*)(ws + WS_CQ), (const bf16_t*)(ws + WS_WUQ), ML, 1536, QRANK}; pg8::StaticOrder S; S.init(ML, 1536, G, cid);
        EpiQmla E{(bf16_t*)(ws + WS_QMLA), SSQQ, ROPE};
        pg8::gemm_phase<EpiQmla, pg8::StaticOrder, true>(lds, g, S, E);
#if PROBE_DUP == 3 || PROBE_DUP == 35
        pg8::gemm_phase<EpiQmla, pg8::StaticOrder, true>(lds, g, S, E);
#endif
    }
    {
        pg8::Gemm g{(const bf16_t*)(ws + WS_CKV), (const bf16_t*)(ws + WS_WUKV), MT, 2048, KVRANK}; pg8::StaticOrder S; S.init(MT, 2048, G, (cid + 64) % G);
        EpiKv E{(bf16_t*)(ws + WS_KVM), SSQKV};
        pg8::gemm_phase<EpiKv, pg8::StaticOrder, true>(lds, g, S, E);
#if PROBE_DUP == 3 || PROBE_DUP == 35
        pg8::gemm_phase<EpiKv, pg8::StaticOrder, true>(lds, g, S, E);
#endif
    }
    GRID_SYNC();
    attention_phase(lds, P);
#if PROBE_DUP == 41
    attention_phase(lds, P);
#endif
    attention_mla_phase(lds, P);
#if PROBE_DUP == 42
    attention_mla_phase(lds, P);
#endif
    GRID_SYNC();
    {
        pg8::Gemm g{(const bf16_t*)(ws + WS_MRG), (const bf16_t*)(ws + WS_WO), ML, DM, DM}; pg8::StaticOrder S; S.init(ML, DM, G, cid);
        EpiRes E{P.in[0], MOD + 2 * DM, X1};
        pg8::gemm_phase<EpiRes, pg8::StaticOrder, true>(lds, g, S, E);
#if PROBE_DUP == 5 || PROBE_DUP == 35
        pg8::gemm_phase<EpiRes, pg8::StaticOrder, true>(lds, g, S, E);
#endif
    }
    GRID_SYNC();
    norm_mod_phase(X1, nullptr, ML, P.in[18], MOD, 3, 4, H);
#if PROBE_DUP == 6 || PROBE_DUP == 16
    norm_mod_phase(X1, nullptr, ML, P.in[18], MOD, 3, 4, H);
#endif
    GRID_SYNC();
    {
        pg8::Gemm g{H, (const bf16_t*)(ws + WS_WUP), ML, 2 * DFF, DM}; pg8::StaticOrder S; S.init(ML, 2 * DFF, G, cid);
        EpiUp E{(bf16_t*)(ws + WS_G), (bf16_t*)(ws + WS_U)};
        pg8::gemm_phase<EpiUp, pg8::StaticOrder, true>(lds, g, S, E);
#if PROBE_DUP == 7
        pg8::gemm_phase<EpiUp, pg8::StaticOrder, true>(lds, g, S, E);
#endif
        { const int rem = S.nwg % G; if (rem == 0) convert_wdown(lds, P, cid, G); else if (cid >= rem) convert_wdown(lds, P, cid - rem, G - rem); }
    }
    GRID_SYNC();
#if PROBE_DUP == 8
    act_phase((const bf16_t*)(ws + WS_G), (const bf16_t*)(ws + WS_U), (bf16_t*)ws, 6144, P.in[20], P.in[21]);
#endif
    act_phase((const bf16_t*)(ws + WS_G), (const bf16_t*)(ws + WS_U), (bf16_t*)(ws + WS_U), ML, P.in[20], P.in[21]);
    GRID_SYNC();
    {
        pg8::Gemm g{(const bf16_t*)(ws + WS_U), (const bf16_t*)(ws + WS_WDN), ML, DM, DFF}; pg8::StaticOrder S; S.init(ML, DM, G, cid);
        EpiRes E{X1, MOD + 5 * DM, P.out};
        pg8::gemm_phase<EpiRes, pg8::StaticOrder, true>(lds, g, S, E);
#if PROBE_DUP == 9
        pg8::gemm_phase<EpiRes, pg8::StaticOrder, true>(lds, g, S, E);
#endif
    }
    GRID_SYNC();
#if PROBE_DUP == 10
    final_norm_phase(P.out, (float*)ws, P.in[23]);
#endif
    final_norm_phase(P.out, P.out, P.in[23]);
}

extern "C" void kernel_launch(void* const* d_in, const int* in_sizes, int n_in, void* d_out, int out_size, void* d_ws, size_t ws_size, hipStream_t stream) {
    static int grid_blocks = 0;
    if (grid_blocks == 0) {
        if (n_in != 24 || out_size != ML * DM || ws_size < WS_END) { fprintf(stderr, "kernel_launch: unexpected shapes (n_in %d out %d ws %zu, need %zu)\n", n_in, out_size, ws_size, (size_t)WS_END); grid_blocks = -1; return; }
        int dev = 0, cus = 0, per_cu = 0;
        (void)hipGetDevice(&dev);
        (void)hipDeviceGetAttribute(&cus, hipDeviceAttributeMultiprocessorCount, dev);
        if (hipFuncSetAttribute((const void*)fwd_megakernel, hipFuncAttributeMaxDynamicSharedMemorySize, LDS_BYTES) != hipSuccess) { fprintf(stderr, "kernel_launch: hipFuncSetAttribute failed\n"); grid_blocks = -1; return; }
        if (hipOccupancyMaxActiveBlocksPerMultiprocessor(&per_cu, (const void*)fwd_megakernel, 512, LDS_BYTES) != hipSuccess || per_cu < 1) { fprintf(stderr, "kernel_launch: occupancy query failed (%d)\n", per_cu); grid_blocks = -1; return; }
        grid_blocks = cus;
    }
    if (grid_blocks < 0) return;
    (void)hipMemsetAsync((unsigned char*)d_ws + WS_SSQ, 0, (WS_BAR - WS_SSQ) + XCD_BAR_WORDS * 4, stream);
    Ptrs p{};
    for (int i = 0; i < 24; ++i) p.in[i] = (const float*)d_in[i];
    p.out = (float*)d_out; p.ws = (unsigned char*)d_ws;
    void* args[] = {&p};
    hipError_t e = hipLaunchCooperativeKernel((const void*)fwd_megakernel, dim3(grid_blocks), dim3(512), args, LDS_BYTES, stream);
    if (e != hipSuccess) fprintf(stderr, "cooperative launch failed: %s (grid %d)\n", hipGetErrorString(e), grid_blocks);
}
```

```cpp
#include <hip/hip_runtime.h>
#include <hip/hip_cooperative_groups.h>
#include <cstdio>
#include <cstdint>
namespace cg = cooperative_groups;

#define LAS __attribute__((address_space(3)))
#define DI __device__ __forceinline__
typedef unsigned short bf16_t;
typedef short bf16x8 __attribute__((ext_vector_type(8)));
typedef short s16x4 __attribute__((ext_vector_type(4)));
typedef float f32x2 __attribute__((ext_vector_type(2)));
typedef float f32x4 __attribute__((ext_vector_type(4)));
typedef float f32x16 __attribute__((ext_vector_type(16)));
typedef unsigned u32x4 __attribute__((ext_vector_type(4)));
typedef unsigned u32x2 __attribute__((ext_vector_type(2)));
typedef __bf16 bf2_t __attribute__((ext_vector_type(2)));

constexpr int DM = 2048, NBATCH = 4, SEQ = 2048, CTXL = 256, NKEY = SEQ + CTXL;
constexpr int ML = NBATCH * SEQ, MC = NBATCH * CTXL, MT = ML + MC;
constexpr int INW = 3776, INWP = 3840, QRANK = 384, KVRANK = 256, DFF = 5632, NMODC = 6 * DM;
constexpr float EPS = 1e-6f;
constexpr size_t MiB = 1024 * 1024;
constexpr size_t WS_WIN = 0, WS_WUQ = 15 * MiB, WS_WUKV = 17 * MiB, WS_WO = 18 * MiB, WS_WUP = 26 * MiB, WS_WDN = 70 * MiB;
constexpr size_t WS_SMALL = 92 * MiB, WS_MOD = WS_SMALL, WS_ROPE = WS_SMALL + 256 * 1024, WS_SSQ = WS_SMALL + 512 * 1024;
constexpr size_t SSQ_BYTES = (size_t)(ML + MT) * 4;
constexpr size_t WS_BAR = WS_SSQ + 72 * 1024;
constexpr size_t WS_X1 = 93 * MiB, WS_H = 157 * MiB, WS_O1 = WS_H, WS_T = 193 * MiB;
constexpr size_t WS_QDA = WS_T, WS_KDA = WS_T + 16 * MiB, WS_VDA = WS_T + 34 * MiB, WS_CQ = WS_T + 52 * MiB, WS_CKV = WS_T + 58 * MiB,
                 WS_KR = WS_T + 63 * MiB, WS_QMLA = WS_T + 65 * MiB, WS_KVM = WS_T + 89 * MiB, WS_MRG = WS_T + 125 * MiB;
constexpr size_t WS_G = WS_T, WS_U = WS_T + 88 * MiB, WS_END = WS_T + 176 * MiB;
constexpr int LDS_MAIN = 131072, LDS_BYTES = LDS_MAIN + 64;
#ifndef PROBE_DUP
#define PROBE_DUP -1
#endif

DI unsigned pk2(float lo, float hi) { f32x2 v = {lo, hi}; bf2_t b = __builtin_convertvector(v, bf2_t); return __builtin_bit_cast(unsigned, b); }
DI float bflo(unsigned u) { return __builtin_bit_cast(float, u << 16); }
DI float bfhi(unsigned u) { return __builtin_bit_cast(float, u & 0xffff0000u); }
DI int tid_fresh() { int t = threadIdx.x; asm volatile("" : "+v"(t)); return t; }
DI float wave_sum(float v) {
#pragma unroll
    for (int o = 1; o < 64; o <<= 1) v += __shfl_xor(v, o);
    return v;
}

namespace pg8 {
constexpr int BM = 256, BK = 64, HALF = 128, HTB = HALF * BK * 2, STAGE_BYTES = 8 * HTB, NXCD = 8, WGM = 8;
DI int lds_byte(int r, int c) { const int st = (r >> 4) * 2 + (c >> 5), rr = r & 15, cc = c & 31, ob = rr * 64 + cc * 2; return st * 1024 + (ob ^ (((ob >> 9) & 1) << 5)); }
DI void stage_rc(int b, int& R, int& C) { const int st = b / 1024, sb = b % 1024, swz = sb ^ (((sb >> 9) & 1) << 5); R = (st >> 1) * 16 + swz / 64; C = (st & 1) * 32 + (swz % 64) / 2; }
DI int perm32(int rho) { const int n = rho >> 4, i = rho & 15; return 8 * (i >> 2) + 4 * n + (i & 3); }
struct Unit { int pm, pn; };
struct Gemm { const bf16_t* A; const bf16_t* Bt; int M, N, K; };
struct StaticOrder {
    int nM, nN, nwg, G, c;
    DI void init(int M, int N, int G_, int c_) { nM = M / BM; nN = N / BM; nwg = nM * nN; G = G_; c = c_; }
    DI bool next(int i, Unit& u) const {
        const long L = (long)i * G + c; if (L >= nwg) return false;
        int wgid = (int)L; { const int q = nwg / NXCD, r = nwg % NXCD, xcd = wgid % NXCD, off = wgid / NXCD; wgid = (xcd < r ? xcd * (q + 1) : r * (q + 1) + (xcd - r) * q) + off; }
        const int nig = WGM * nN, gid = wgid / nig, fm = gid * WGM, gsz = (nM - fm) < WGM ? (nM - fm) : WGM;
        u.pm = fm + ((wgid % nig) % gsz); u.pn = (wgid % nig) / gsz; return true;
    }
};

template <class Epi, class Sched, bool ALIGN_EPI>
DI void gemm_phase(LAS unsigned char* lds, const Gemm g, const Sched& S, const Epi& E) {
    const int tid = tid_fresh(), wid = __builtin_amdgcn_readfirstlane(tid >> 6), lane = tid & 63, wr = wid >> 2, wc = wid & 3, fr = lane & 15, fq = lane >> 4;
    const int K = g.K, nt = K / BK;
    unsigned voffA[2], voffB[2];
#pragma unroll
    for (int i = 0; i < 2; ++i) { int R, C; stage_rc(tid * 16 + i * 8192, R, C); const int Rb = Epi::PERM ? ((R & ~31) + perm32(R & 31)) : R;
        voffA[i] = (unsigned)(R * K + C) * 2u; voffB[i] = (unsigned)(Rb * K + C) * 2u; }
    const size_t kstep = (size_t)(BK * 2);
    const size_t hstep = (size_t)HALF * K * 2;
    const size_t tstep = 2 * hstep;
    const unsigned ldsw = (unsigned)wid * 1024u;
    const int aoff = lds_byte(wr * 64 + fr, fq * 8), boff = lds_byte(wc * 32 + fr, fq * 8);
#define PG8_SA(b, h) (((b) * 2 + (h)) * HTB)
#define PG8_SB(b, h) ((4 + (b) * 2 + (h)) * HTB)
#define PG8_STAGE(bufoff, gbase, voff) do { _Pragma("unroll") for (int _i = 0; _i < 2; ++_i) \
        __builtin_amdgcn_global_load_lds((const unsigned*)((const char*)(gbase) + (voff)[_i]), (LAS unsigned*)(lds + (bufoff) + ldsw + _i * 8192), 16, 0, 0); } while (0)
#define PG8_LDA(dst, b, h) do { _Pragma("unroll") for (int m = 0; m < 4; ++m) _Pragma("unroll") for (int k = 0; k < 2; ++k) dst[m][k] = *(const LAS bf16x8*)(lds + PG8_SA(b, h) + aoff + m * 2048 + k * 1024); } while (0)
#define PG8_LDB(dst, b, h) do { _Pragma("unroll") for (int n = 0; n < 2; ++n) _Pragma("unroll") for (int k = 0; k < 2; ++k) dst[n][k] = *(const LAS bf16x8*)(lds + PG8_SB(b, h) + boff + n * 2048 + k * 1024); } while (0)
#define PG8_MMA(ai, bj, At, Bt) do { __builtin_amdgcn_s_setprio(1); _Pragma("unroll") for (int m = 0; m < 4; ++m) _Pragma("unroll") for (int n = 0; n < 2; ++n) _Pragma("unroll") for (int k = 0; k < 2; ++k) \
        acc[ai][bj][m][n] = __builtin_amdgcn_mfma_f32_16x16x32_bf16(Bt[n][k], At[m][k], acc[ai][bj][m][n], 0, 0, 0); __builtin_amdgcn_s_setprio(0); } while (0)
#define PG8_WAIT_V(n) asm volatile("s_waitcnt vmcnt(" #n ")" ::: "memory")
#define PG8_WAIT_L(n) asm volatile("s_waitcnt lgkmcnt(" #n ")" ::: "memory")
#define PG8_BAR __builtin_amdgcn_s_barrier()
#define PG8_SCHED __builtin_amdgcn_sched_barrier(0)
    Unit cur, nxt; int ui = 0;
    if (!S.next(0, cur)) return;
    f32x4 acc[2][2][4][2];
#pragma unroll
    for (int a = 0; a < 2; ++a)
#pragma unroll
        for (int b = 0; b < 2; ++b)
#pragma unroll
            for (int m = 0; m < 4; ++m)
#pragma unroll
                for (int n = 0; n < 2; ++n) acc[a][b][m][n] = (f32x4){0.f, 0.f, 0.f, 0.f};
    bf16x8 At[4][2], B0[2][2], B1[2][2];
    const char* cA = (const char*)g.A + (size_t)cur.pm * tstep; const char* cB = (const char*)g.Bt + (size_t)cur.pn * tstep;
    PG8_STAGE(PG8_SB(0, 0), cB, voffB); PG8_STAGE(PG8_SB(0, 1), cB + hstep, voffB); PG8_STAGE(PG8_SA(0, 0), cA, voffA); PG8_STAGE(PG8_SA(0, 1), cA + hstep, voffA);
    if (wr == 1) PG8_BAR;
    PG8_WAIT_V(2); PG8_BAR;
    PG8_STAGE(PG8_SB(1, 0), cB + kstep, voffB); PG8_STAGE(PG8_SA(1, 0), cA + kstep, voffA); PG8_STAGE(PG8_SB(1, 1), cB + hstep + kstep, voffB);
    PG8_WAIT_V(6); PG8_BAR;
    for (;;) {
        const bool has_next = S.next(ui + 1, nxt);
        const char* nA = has_next ? (const char*)g.A + (size_t)nxt.pm * tstep : cA; const char* nB = has_next ? (const char*)g.Bt + (size_t)nxt.pn * tstep : cB;
#pragma unroll 1
        for (int t = 0; t < nt; t += 2) {
            const bool last = (t == nt - 2);
            const char* a1 = cA + (size_t)(t + 1) * kstep;
            const char* a2 = last ? nA : cA + (size_t)(t + 2) * kstep; const char* b2 = last ? nB : cB + (size_t)(t + 2) * kstep;
            const char* a3 = a2 + kstep; const char* b3 = b2 + kstep;
            PG8_LDB(B0, 0, 0); PG8_LDB(B1, 0, 1); PG8_SCHED; PG8_LDA(At, 0, 0); PG8_STAGE(PG8_SA(1, 1), a1 + hstep, voffA);
            PG8_WAIT_V(8); PG8_WAIT_L(0); PG8_BAR; PG8_MMA(0, 0, At, B0); PG8_MMA(0, 1, At, B1); PG8_BAR; PG8_SCHED;
            PG8_LDA(At, 0, 1); PG8_STAGE(PG8_SB(0, 0), b2, voffB); PG8_STAGE(PG8_SB(0, 1), b2 + hstep, voffB); PG8_STAGE(PG8_SA(0, 0), a2, voffA);
            PG8_WAIT_V(8); PG8_WAIT_L(0); PG8_BAR; PG8_MMA(1, 0, At, B0); PG8_MMA(1, 1, At, B1); PG8_BAR; PG8_SCHED;
            PG8_LDB(B0, 1, 0); PG8_LDB(B1, 1, 1); PG8_SCHED; PG8_LDA(At, 1, 0); PG8_STAGE(PG8_SA(0, 1), a2 + hstep, voffA);
            PG8_WAIT_V(8); PG8_WAIT_L(0); PG8_BAR; PG8_MMA(0, 0, At, B0); PG8_MMA(0, 1, At, B1); PG8_BAR; PG8_SCHED;
            PG8_LDA(At, 1, 1); PG8_STAGE(PG8_SB(1, 0), b3, voffB); PG8_STAGE(PG8_SB(1, 1), b3 + hstep, voffB); PG8_STAGE(PG8_SA(1, 0), a3, voffA);
            PG8_WAIT_V(8); PG8_WAIT_L(0); PG8_BAR; PG8_MMA(1, 0, At, B0); PG8_MMA(1, 1, At, B1); PG8_BAR; PG8_SCHED;
        }
        if constexpr (ALIGN_EPI) { if (wr == 0) PG8_BAR; }
        E(acc, cur, wr, wc, fr, fq);
        if (!has_next) break;
#pragma unroll
        for (int a = 0; a < 2; ++a)
#pragma unroll
            for (int b = 0; b < 2; ++b)
#pragma unroll
                for (int m = 0; m < 4; ++m)
#pragma unroll
                    for (int n = 0; n < 2; ++n) acc[a][b][m][n] = (f32x4){0.f, 0.f, 0.f, 0.f};
        cur = nxt; cA = nA; cB = nB; ++ui;
        if constexpr (ALIGN_EPI) { if (wr == 1) PG8_BAR; }
    }
    PG8_WAIT_V(0);
    if constexpr (!ALIGN_EPI) { if (wr == 0) PG8_BAR; }
    PG8_BAR;
#undef PG8_SA
#undef PG8_SB
#undef PG8_STAGE
#undef PG8_LDA
#undef PG8_LDB
#undef PG8_MMA
#undef PG8_WAIT_V
#undef PG8_WAIT_L
#undef PG8_BAR
#undef PG8_SCHED
}
}
using pg8::Unit;

DI void rope4(f32x4& v0, f32x4& v1, const f32x2* rp) {
#pragma unroll
    for (int j = 0; j < 4; ++j) { const f32x2 cs = rp[j]; const float x1 = v0[j], x2 = v1[j]; v0[j] = x1 * cs.x - x2 * cs.y; v1[j] = x2 * cs.x + x1 * cs.y; }
}
DI void store_bf16_pair(bf16_t* dst, int fq, const f32x4& v0, const f32x4& v1) {
    u32x2 w0, w1; w0.x = pk2(v0[0], v0[1]); w0.y = pk2(v0[2], v0[3]); w1.x = pk2(v1[0], v1[1]); w1.y = pk2(v1[2], v1[3]);
    *(u32x2*)(dst + 4 * fq) = w0; *(u32x2*)(dst + 16 + 4 * fq) = w1;
}

struct EpiIn {
    static constexpr bool PERM = false;
    bf16_t *qda, *kda, *vda, *cq, *ckv, *kr; float *ssq_q, *ssq_kv; const f32x2* rope; bool do_ssq;
    DI void operator()(const f32x4 (&acc)[2][2][4][2], const Unit& u, int wr, int wc, int fr, int fq) const {
        const bool latent = u.pm < 32;
#pragma unroll
        for (int bj = 0; bj < 2; ++bj) {
            const int cb = u.pn * 256 + bj * 128 + wc * 32;
            if (cb >= INW) continue;
            if (cb < 1024 && !latent) continue;
            const bool is_cq = (cb >= 3072 && cb < 3456), is_ckv = (cb >= 3456 && cb < 3712);
            if (is_cq && !latent) continue;
            const bool do_rope = latent && (cb < 2048 || cb >= 3712);
            const bool colpart = (cb >> 5) & 1;
#pragma unroll
            for (int ai = 0; ai < 2; ++ai)
#pragma unroll
                for (int m = 0; m < 4; ++m) {
                    const int row = u.pm * 256 + ai * 128 + wr * 64 + m * 16 + fr;
                    f32x4 v0 = acc[ai][bj][m][0], v1 = acc[ai][bj][m][1];
                    int b, t; if (latent) { b = row >> 11; t = row & 2047; } else { b = (row - ML) >> 8; t = (row - ML) & 255; }
                    const int keyrow = b * NKEY + (latent ? CTXL + t : t);
                    if (do_rope) { const int pos = colpart ? (t & 63) : (t >> 6); rope4(v0, v1, rope + pos * 16 + 4 * fq); }
                    if ((is_cq || is_ckv) && do_ssq) {
                        float s = (v0[0] * v0[0] + v0[1] * v0[1]) + (v0[2] * v0[2] + v0[3] * v0[3]) + (v1[0] * v1[0] + v1[1] * v1[1]) + (v1[2] * v1[2] + v1[3] * v1[3]);
                        s += __shfl_xor(s, 16); s += __shfl_xor(s, 32);
                        if (fq == 0) atomicAdd((is_cq ? ssq_q : ssq_kv) + row, s);
                    }
                    bf16_t* dst;
                    if (cb < 1024) dst = qda + (size_t)row * 1024 + cb;
                    else if (cb < 2048) dst = kda + (size_t)keyrow * 1024 + (cb - 1024);
                    else if (cb < 3072) dst = vda + (size_t)keyrow * 1024 + (cb - 2048);
                    else if (cb < 3456) dst = cq + (size_t)row * QRANK + (cb - 3072);
                    else if (cb < 3712) dst = ckv + (size_t)row * KVRANK + (cb - 3456);
                    else dst = kr + (size_t)keyrow * 64 + (cb - 3712);
                    store_bf16_pair(dst, fq, v0, v1);
                    asm volatile("" ::: "memory");
                }
        }
    }
};
struct EpiQmla {
    static constexpr bool PERM = false;
    bf16_t* qmla; const float* ssq_q; const f32x2* rope;
    DI void operator()(const f32x4 (&acc)[2][2][4][2], const Unit& u, int wr, int wc, int fr, int fq) const {
#pragma unroll
        for (int bj = 0; bj < 2; ++bj) {
            const int cb = u.pn * 256 + bj * 128 + wc * 32;
            const int gi = (cb >> 5) % 6;
#pragma unroll
            for (int ai = 0; ai < 2; ++ai)
#pragma unroll
                for (int m = 0; m < 4; ++m) {
                    const int row = u.pm * 256 + ai * 128 + wr * 64 + m * 16 + fr;
                    const float rstd = rsqrtf(ssq_q[row] * (1.0f / QRANK) + EPS);
                    f32x4 v0 = acc[ai][bj][m][0] * rstd, v1 = acc[ai][bj][m][1] * rstd;
                    if (gi >= 4) { const int t = row & 2047; const int pos = (gi == 5) ? (t & 63) : (t >> 6); rope4(v0, v1, rope + pos * 16 + 4 * fq); }
                    store_bf16_pair(qmla + (size_t)row * 1536 + cb, fq, v0, v1);
                    asm volatile("" ::: "memory");
                }
        }
    }
};
struct EpiKv {
    static constexpr bool PERM = false;
    bf16_t* kvm; const float* ssq_kv;
    DI void operator()(const f32x4 (&acc)[2][2][4][2], const Unit& u, int wr, int wc, int fr, int fq) const {
        const bool latent = u.pm < 32;
#pragma unroll
        for (int bj = 0; bj < 2; ++bj) {
            const int cb = u.pn * 256 + bj * 128 + wc * 32;
#pragma unroll
            for (int ai = 0; ai < 2; ++ai)
#pragma unroll
                for (int m = 0; m < 4; ++m) {
                    const int row = u.pm * 256 + ai * 128 + wr * 64 + m * 16 + fr;
                    const float rstd = rsqrtf(ssq_kv[row] * (1.0f / KVRANK) + EPS);
                    int b, t; if (latent) { b = row >> 11; t = row & 2047; } else { b = (row - ML) >> 8; t = (row - ML) & 255; }
                    const int keyrow = b * NKEY + (latent ? CTXL + t : t);
                    const f32x4 v0 = acc[ai][bj][m][0] * rstd, v1 = acc[ai][bj][m][1] * rstd;
                    store_bf16_pair(kvm + (size_t)keyrow * 2048 + cb, fq, v0, v1);
                    asm volatile("" ::: "memory");
                }
        }
    }
};
struct EpiRes {
    static constexpr bool PERM = false;
    const float* base; const float* gate; float* out;
    DI void operator()(const f32x4 (&acc)[2][2][4][2], const Unit& u, int wr, int wc, int fr, int fq) const {
        const int b = u.pm >> 3;
#pragma unroll
        for (int bj = 0; bj < 2; ++bj)
#pragma unroll
            for (int n = 0; n < 2; ++n) {
                const int col = u.pn * 256 + bj * 128 + wc * 32 + n * 16 + 4 * fq;
                const f32x4 gv = *(const f32x4*)(gate + (size_t)b * NMODC + col);
#pragma unroll
                for (int ai = 0; ai < 2; ++ai)
#pragma unroll
                    for (int m = 0; m < 4; ++m) {
                        const int row = u.pm * 256 + ai * 128 + wr * 64 + m * 16 + fr;
                        const size_t off = (size_t)row * DM + col;
                        const f32x4 bs = *(const f32x4*)(base + off);
                        *(f32x4*)(out + off) = bs + gv * acc[ai][bj][m][n];
                    }
            }
    }
};
struct EpiUp {
    static constexpr bool PERM = false;
    bf16_t *gbuf, *ubuf;
    DI void operator()(const f32x4 (&acc)[2][2][4][2], const Unit& u, int wr, int wc, int fr, int fq) const {
        const bool isg = u.pn < 22;
        bf16_t* basep = isg ? gbuf : ubuf;
        const int ct = (isg ? u.pn : u.pn - 22) * 256;
#pragma unroll
        for (int bj = 0; bj < 2; ++bj) {
            const int cb = ct + bj * 128 + wc * 32;
#pragma unroll
            for (int ai = 0; ai < 2; ++ai)
#pragma unroll
                for (int m = 0; m < 4; ++m) {
                    const int row = u.pm * 256 + ai * 128 + wr * 64 + m * 16 + fr;
                    store_bf16_pair(basep + (size_t)row * DFF + cb, fq, acc[ai][bj][m][0], acc[ai][bj][m][1]);
                }
        }
    }
};

DI s16x4 tr_read(LAS const unsigned char* p) { return __builtin_bit_cast(s16x4, __builtin_amdgcn_ds_read_tr16_b64_v4i16((LAS s16x4*)p)); }

template <int DQK>
DI void attn_pass(LAS unsigned char* lds, const bf16_t* qrow, const bf16_t* K0, int ldk0, const bf16_t* K1, int ldk1, const bf16_t* V, int ldv,
                  float cexp, f32x16 (&o)[4], float& lsum_out) {
    constexpr int KST = (DQK + 8) * 2, VST = 320, KBUF = 64 * KST, VBUF = 64 * VST, NKC = DQK / 8, KCH = (64 * NKC) / 512, NKK = DQK / 16, NT = NKEY / 64;
    const int tid = tid_fresh(), lane = tid & 63, r = lane & 31, h = lane >> 5;
    bf16x8 qf[NKK];
#pragma unroll
    for (int kk = 0; kk < NKK; ++kk) qf[kk] = *(const bf16x8*)(qrow + 16 * kk + 8 * h);
#pragma unroll
    for (int d = 0; d < 4; ++d)
#pragma unroll
        for (int i = 0; i < 16; ++i) o[d][i] = 0.f;
    float mrun = -INFINITY, lsum = 0.f;
    u32x4 kreg[KCH], vreg[2];
    constexpr int NC0 = (DQK == 64) ? 8 : 16, KCH0 = (64 * NC0) / 512;
    unsigned ksrc[KCH]; int kdst[KCH];
#pragma unroll
    for (int i = 0; i < KCH; ++i) {
        if (i < KCH0) { const int ci = tid + 512 * i, key = ci / NC0, c8 = ci % NC0; ksrc[i] = (unsigned)(key * ldk0 + 8 * c8); kdst[i] = key * KST + c8 * 16; }
        else { const int key = tid >> 3, c8 = tid & 7; ksrc[i] = (unsigned)(key * ldk1 + 8 * c8); kdst[i] = key * KST + (16 + c8) * 16; }
    }
    unsigned vsrc[2]; int vdst[2];
#pragma unroll
    for (int i = 0; i < 2; ++i) { const int ci = tid + 512 * i, key = ci >> 4, c8 = ci & 15; vsrc[i] = (unsigned)(key * ldv + 8 * c8); vdst[i] = 2 * KBUF + key * VST + c8 * 16; }
#define AT_GLOAD(t) do { const bf16_t* k0t = K0 + (size_t)(t) * 64 * ldk0; const bf16_t* k1t = K1 + (size_t)(t) * 64 * ldk1; const bf16_t* vt = V + (size_t)(t) * 64 * ldv; \
                         _Pragma("unroll") for (int i = 0; i < KCH; ++i) kreg[i] = *(const u32x4*)((i < KCH0 ? k0t : k1t) + ksrc[i]); \
                         _Pragma("unroll") for (int i = 0; i < 2; ++i) vreg[i] = *(const u32x4*)(vt + vsrc[i]); } while (0)
#define AT_LSTORE(kb_, vb_) do { _Pragma("unroll") for (int i = 0; i < KCH; ++i) *(LAS u32x4*)(lds + (kb_) * KBUF + kdst[i]) = kreg[i]; \
                          _Pragma("unroll") for (int i = 0; i < 2; ++i) *(LAS u32x4*)(lds + (vb_) * VBUF + vdst[i]) = vreg[i]; } while (0)
#define AT_PV(vb_) do { _Pragma("unroll") for (int ks = 0; ks < 4; ++ks) { const bf16x8 pf = __builtin_bit_cast(bf16x8, pprev[ks]); \
            _Pragma("unroll") for (int d = 0; d < 4; ++d) { LAS const unsigned char* ap = lds + (vb_) * VBUF + voff + (16 * ks) * VST + d * 64; \
                const s16x4 lo = tr_read(ap), hi = tr_read(ap + 8 * VST); const bf16x8 vf = __builtin_shufflevector(lo, hi, 0, 1, 2, 3, 4, 5, 6, 7); \
                o[d] = __builtin_amdgcn_mfma_f32_32x32x16_bf16(vf, pf, o[d], 0, 0, 0); } } } while (0)
    const int koff = r * KST + 16 * h;
    const int i16 = lane & 15, q4 = i16 >> 2, p4 = i16 & 3, blk = (lane >> 4) & 1;
    const int voff = 2 * KBUF + (4 * h + q4) * VST + 32 * blk + 8 * p4;
    u32x4 pprev[4];
#pragma unroll
    for (int ks = 0; ks < 4; ++ks) pprev[ks] = (u32x4){0u, 0u, 0u, 0u};
    AT_GLOAD(0); AT_LSTORE(0, 0); __syncthreads();
    int vb_prev = 2, vb_cur = 0, vb_next = 1;
#pragma unroll 1
    for (int t = 0; t < NT; ++t) {
        const int b = t & 1;
        f32x16 st[2];
#pragma unroll
        for (int kb = 0; kb < 2; ++kb) {
#pragma unroll
            for (int i = 0; i < 16; ++i) st[kb][i] = 0.f;
#pragma unroll
            for (int kk = 0; kk < NKK; ++kk) {
                const bf16x8 kf = *(const LAS bf16x8*)(lds + b * KBUF + kb * 32 * KST + koff + 32 * kk);
                st[kb] = __builtin_amdgcn_mfma_f32_32x32x16_bf16(kf, qf[kk], st[kb], 0, 0, 0);
            }
        }
        if (t + 1 < NT) AT_GLOAD(t + 1);
        if (t > 0) AT_PV(vb_prev);
        float mx = st[0][0];
#pragma unroll
        for (int kb = 0; kb < 2; ++kb)
#pragma unroll
            for (int i = 0; i < 16; ++i) mx = fmaxf(mx, st[kb][i]);
        mx = fmaxf(mx, __shfl_xor(mx, 32)) * cexp;
        if (__builtin_amdgcn_ballot_w64(mx > mrun + 8.0f) != 0ull) {
            const float mn = fmaxf(mrun, mx);
            const float alpha = __builtin_amdgcn_exp2f(mrun - mn);
            lsum *= alpha; mrun = mn;
#pragma unroll
            for (int d = 0; d < 4; ++d)
#pragma unroll
                for (int i = 0; i < 16; ++i) o[d][i] *= alpha;
        }
        float ps = 0.f;
#pragma unroll
        for (int kb = 0; kb < 2; ++kb)
#pragma unroll
            for (int i = 0; i < 16; ++i) { const float pv = __builtin_amdgcn_exp2f(st[kb][i] * cexp - mrun); st[kb][i] = pv; ps += pv; }
        lsum += ps;
#pragma unroll
        for (int ks = 0; ks < 4; ++ks) {
            const int kb = ks >> 1, s = ks & 1;
            pprev[ks].x = pk2(st[kb][8 * s + 0], st[kb][8 * s + 1]); pprev[ks].y = pk2(st[kb][8 * s + 2], st[kb][8 * s + 3]);
            pprev[ks].z = pk2(st[kb][8 * s + 4], st[kb][8 * s + 5]); pprev[ks].w = pk2(st[kb][8 * s + 6], st[kb][8 * s + 7]);
        }
        if (t + 1 < NT) AT_LSTORE(b ^ 1, vb_next);
        __syncthreads();
        { const int tmp = vb_prev; vb_prev = vb_cur; vb_cur = vb_next; vb_next = tmp; }
    }
    AT_PV(vb_prev);
    __syncthreads();
#undef AT_GLOAD
#undef AT_LSTORE
#undef AT_PV
    lsum += __shfl_xor(lsum, 32);
    lsum_out = lsum;
}

struct Ptrs {
    const float* in[24]; float* out; unsigned char* ws;
};

DI void attention_phase(LAS unsigned char* lds, const Ptrs& P) {
    const int tid = threadIdx.x, lane = tid & 63, wave = tid >> 6, r = lane & 31, h = lane >> 5;
    unsigned char* ws = P.ws;
    const bf16_t* QDA = (const bf16_t*)(ws + WS_QDA); const bf16_t* KDA = (const bf16_t*)(ws + WS_KDA); const bf16_t* VDA = (const bf16_t*)(ws + WS_VDA);
    const bf16_t* QMLA = (const bf16_t*)(ws + WS_QMLA); const bf16_t* KVM = (const bf16_t*)(ws + WS_KVM); const bf16_t* KR = (const bf16_t*)(ws + WS_KR);
    bf16_t* MRG = (bf16_t*)(ws + WS_MRG);
    float* O1 = (float*)(ws + WS_O1) + (size_t)blockIdx.x * (16 * 512 * 4);
    const float LOG2E = 1.4426950408889634f;
    float lam;
    { const float s1 = wave_sum(P.in[12][lane] * P.in[13][lane]), s2 = wave_sum(P.in[14][lane] * P.in[15][lane]); lam = expf(s1) - expf(s2) + 0.2f; }
    const float* subln = P.in[16];
    for (int it = blockIdx.x; it < 256; it += gridDim.x) {
        const int b = it >> 6, hd = (it >> 3) & 7, qb = it & 7;
        const int qr = b * SEQ + qb * 256 + wave * 32 + r;
        f32x16 o[4]; float l;
        const bf16_t* qrow = QDA + (size_t)qr * 1024 + hd * 128;
        const bf16_t* Kb = KDA + (size_t)b * NKEY * 1024 + hd * 128;
        const bf16_t* Vb = VDA + (size_t)b * NKEY * 1024 + hd * 128;
        const float c = 0.125f * LOG2E;
        attn_pass<64>(lds, qrow, Kb, 1024, Kb, 1024, Vb, 1024, c, o, l);
        { const float inv = 1.0f / l;
#pragma unroll
          for (int d = 0; d < 4; ++d)
#pragma unroll
              for (int g = 0; g < 4; ++g) { f32x4 v = {o[d][4 * g] * inv, o[d][4 * g + 1] * inv, o[d][4 * g + 2] * inv, o[d][4 * g + 3] * inv};
                  *(f32x4*)(O1 + ((size_t)(d * 4 + g) * 512 + tid) * 4) = v; } }
        attn_pass<64>(lds, qrow + 64, Kb + 64, 1024, Kb + 64, 1024, Vb, 1024, c, o, l);
        const float inv2 = lam / l;
        float ss = 0.f;
#pragma unroll
        for (int d = 0; d < 4; ++d) {
#pragma unroll
            for (int g = 0; g < 4; ++g) { const f32x4 v1 = *(const f32x4*)(O1 + ((size_t)(d * 4 + g) * 512 + tid) * 4);
#pragma unroll
                for (int j = 0; j < 4; ++j) { const float v = v1[j] - o[d][4 * g + j] * inv2; o[d][4 * g + j] = v; ss += v * v; } }
            asm volatile("" ::: "memory");
        }
        ss += __shfl_xor(ss, 32);
        const float rs = rsqrtf(ss * (1.0f / 128.0f) + EPS) * 0.8f;
        bf16_t* orow = MRG + (size_t)qr * 2048 + hd * 128;
#pragma unroll
        for (int d = 0; d < 4; ++d) {
#pragma unroll
            for (int g = 0; g < 4; ++g) { const int dv = 32 * d + 8 * g + 4 * h; const f32x4 w = *(const f32x4*)(subln + dv);
                u32x2 pw; pw.x = pk2(o[d][4 * g] * rs * w[0], o[d][4 * g + 1] * rs * w[1]); pw.y = pk2(o[d][4 * g + 2] * rs * w[2], o[d][4 * g + 3] * rs * w[3]);
                *(u32x2*)(orow + dv) = pw; }
            asm volatile("" ::: "memory");
        }
    }
}
DI void attention_mla_phase(LAS unsigned char* lds, const Ptrs& P) {
    const int tid = threadIdx.x, lane = tid & 63, wave = tid >> 6, r = lane & 31, h = lane >> 5;
    unsigned char* ws = P.ws;
    const bf16_t* QMLA = (const bf16_t*)(ws + WS_QMLA); const bf16_t* KVM = (const bf16_t*)(ws + WS_KVM); const bf16_t* KR = (const bf16_t*)(ws + WS_KR);
    bf16_t* MRG = (bf16_t*)(ws + WS_MRG);
    const float LOG2E = 1.4426950408889634f;
    (void)tid;
    for (int it = blockIdx.x; it < 256; it += gridDim.x) {
        const int b = it >> 6, hd = (it >> 3) & 7, qb = it & 7;
        const int qr = b * SEQ + qb * 256 + wave * 32 + r;
        f32x16 o[4]; float l;
        const bf16_t* qrow = QMLA + (size_t)qr * 1536 + hd * 192;
        const bf16_t* Kb = KVM + (size_t)b * NKEY * 2048 + hd * 256;
        const bf16_t* Krp = KR + (size_t)b * NKEY * 64;
        const float c = 0.07216878364870323f * LOG2E;
        attn_pass<192>(lds, qrow, Kb, 2048, Krp, 64, Kb + 128, 2048, c, o, l);
        const float inv = 1.0f / l;
        bf16_t* orow = MRG + (size_t)qr * 2048 + 1024 + hd * 128;
#pragma unroll
        for (int d = 0; d < 4; ++d)
#pragma unroll
            for (int g = 0; g < 4; ++g) { const int dv = 32 * d + 8 * g + 4 * h;
                u32x2 pw; pw.x = pk2(o[d][4 * g] * inv, o[d][4 * g + 1] * inv); pw.y = pk2(o[d][4 * g + 2] * inv, o[d][4 * g + 3] * inv);
                *(u32x2*)(orow + dv) = pw; }
    }
}

DI void ada_unit(LAS unsigned char* lds, const Ptrs& P, int u) {
    const int tid = threadIdx.x, lane = tid & 63, wave = tid >> 6;
    LAS float* sc = (LAS float*)lds; LAS float* red = (LAS float*)(lds + 40960);
    const float* c = P.in[1]; const float* cc = P.in[3]; const float* w_ada = P.in[4]; const float* b_ada = P.in[5];
    float* MOD = (float*)(P.ws + WS_MOD);
    for (int idx = tid; idx < 5 * DM; idx += 512) { const float v = idx < 4 * DM ? c[idx] : cc[idx - 4 * DM]; sc[idx] = v / (1.0f + __expf(-v)); }
    __syncthreads();
    const int cgp = tid & 15, rg = tid >> 4;
    float acc[5][4];
#pragma unroll
    for (int rr = 0; rr < 5; ++rr)
#pragma unroll
        for (int j = 0; j < 4; ++j) acc[rr][j] = 0.f;
    const float* wp = w_ada + (size_t)rg * NMODC + 64 * u + 4 * cgp;
#pragma unroll 8
    for (int i = 0; i < 64; ++i) {
        const f32x4 w = *(const f32x4*)(wp + (size_t)i * 32 * NMODC);
        const int k = rg + 32 * i;
#pragma unroll
        for (int rr = 0; rr < 5; ++rr) { const float s = sc[rr * DM + k];
#pragma unroll
            for (int j = 0; j < 4; ++j) acc[rr][j] += s * w[j]; }
    }
#pragma unroll
    for (int rr = 0; rr < 5; ++rr)
#pragma unroll
        for (int j = 0; j < 4; ++j) { float a = acc[rr][j]; a += __shfl_xor(a, 16); a += __shfl_xor(a, 32); if (lane < 16) red[(wave * 16 + lane) * 20 + rr * 4 + j] = a; }
    __syncthreads();
    if (tid < 320) { const int cg2 = tid / 20, rj = tid % 20, rr = rj >> 2, j = rj & 3; float s = 0.f;
#pragma unroll
        for (int w = 0; w < 8; ++w) s += red[(w * 16 + cg2) * 20 + rj];
        const int col = 64 * u + 4 * cg2 + j; MOD[(size_t)rr * NMODC + col] = s + b_ada[col]; }
    __syncthreads();
}

DI void transpose_unit(LAS unsigned char* lds, const float* W, int K, int N, bf16_t* Wt, int n0, int k0, const float* kscale) {
    const int tid = tid_fresh();
    LAS float* sf = (LAS float*)lds;
    if (n0 >= N) {
#pragma unroll
        for (int i = 0; i < 2; ++i) { const int idx = tid + 512 * i, kc = idx & 15, n = idx >> 4; *(u32x4*)(Wt + (size_t)(n0 + n) * K + k0 + 8 * kc) = (u32x4){0u, 0u, 0u, 0u}; }
        return;
    }
#pragma unroll
    for (int i = 0; i < 4; ++i) { const int idx = tid + 512 * i, kr = idx >> 4, c4 = idx & 15;
        f32x4 v = *(const f32x4*)(W + (size_t)(k0 + kr) * N + n0 + 4 * c4);
        if (kscale) v = v * kscale[k0 + kr];
#pragma unroll
        for (int j = 0; j < 4; ++j) sf[kr * 65 + 4 * c4 + j] = v[j]; }
    __syncthreads();
#pragma unroll
    for (int i = 0; i < 2; ++i) { const int idx = tid + 512 * i, kc = idx & 15, n = idx >> 4;
        float f[8];
#pragma unroll
        for (int j = 0; j < 8; ++j) f[j] = sf[(8 * kc + j) * 65 + n];
        u32x4 w; w.x = pk2(f[0], f[1]); w.y = pk2(f[2], f[3]); w.z = pk2(f[4], f[5]); w.w = pk2(f[6], f[7]);
        *(u32x4*)(Wt + (size_t)(n0 + n) * K + k0 + 8 * kc) = w; }
    __syncthreads();
}

DI void p0_phase(LAS unsigned char* lds, const Ptrs& P) {
    unsigned char* ws = P.ws;
    constexpr int U_ADA = 192, U_ROPE = 1;
    constexpr int T0 = 60 * 16, T1 = 24 * 3, T2 = 32 * 2;
    constexpr int NU = U_ADA + U_ROPE + T0 + T1 + T2;
    for (int u = blockIdx.x; u < NU; u += gridDim.x) {
        if (u < U_ADA) { ada_unit(lds, P, u); continue; }
        if (u == U_ADA) {
            f32x2* rope = (f32x2*)(ws + WS_ROPE);
            for (int idx = threadIdx.x; idx < 1024; idx += 512) { const int pos = idx >> 4, i = idx & 15;
                const double inv = pow(10000.0, -(double)i / 16.0); const double ang = (double)pos * (double)(float)inv;
                rope[idx] = (f32x2){(float)cos(ang), (float)sin(ang)}; }
            continue;
        }
        int v = u - U_ADA - U_ROPE;
        if (v < T0) { transpose_unit(lds, P.in[7], DM, INW, (bf16_t*)(ws + WS_WIN), (v % 60) * 64, (v / 60) * 128, nullptr); continue; } v -= T0;
        if (v < T1) { transpose_unit(lds, P.in[10], QRANK, 1536, (bf16_t*)(ws + WS_WUQ), (v % 24) * 64, (v / 24) * 128, P.in[8]); continue; } v -= T1;
        transpose_unit(lds, P.in[11], KVRANK, 2048, (bf16_t*)(ws + WS_WUKV), (v % 32) * 64, (v / 32) * 128, P.in[9]);
    }
}
DI void convert_wo_wup(LAS unsigned char* lds, const Ptrs& P, int idx, int nblk) {
    unsigned char* ws = P.ws;
    constexpr int T3 = 32 * 16, T4 = 176 * 16;
    for (int v = idx; v < T3 + T4; v += nblk) {
        if (v < T3) transpose_unit(lds, P.in[17], DM, DM, (bf16_t*)(ws + WS_WO), (v % 32) * 64, (v / 32) * 128, nullptr);
        else { const int w = v - T3; transpose_unit(lds, P.in[19], DM, 2 * DFF, (bf16_t*)(ws + WS_WUP), (w % 176) * 64, (w / 176) * 128, nullptr); }
    }
}
DI void convert_wdown(LAS unsigned char* lds, const Ptrs& P, int idx, int nblk) {
    constexpr int T5 = 32 * 44;
    for (int v = idx; v < T5; v += nblk) transpose_unit(lds, P.in[22], DFF, DM, (bf16_t*)(P.ws + WS_WDN), (v % 32) * 64, (v / 32) * 128, nullptr);
}

DI void norm_mod_phase(const float* X, const float* XC, int nrows, const float* nw, const float* MOD, int shift_idx, int scale_idx, bf16_t* H) {
    const int tf = tid_fresh(), lane = tf & 63, wave = tf >> 6;
    for (int row = blockIdx.x * 8 + wave; row < nrows; row += gridDim.x * 8) {
        const float* xr = row < ML ? X + (size_t)row * DM : XC + (size_t)(row - ML) * DM;
        const int mb = row < ML ? (row >> 11) : 4;
        const float* sh = MOD + (size_t)mb * NMODC + shift_idx * DM; const float* scl = MOD + (size_t)mb * NMODC + scale_idx * DM;
        f32x4 v[8]; float ss = 0.f;
#pragma unroll
        for (int i = 0; i < 8; ++i) { v[i] = *(const f32x4*)(xr + 4 * (lane + 64 * i)); ss += (v[i][0] * v[i][0] + v[i][1] * v[i][1]) + (v[i][2] * v[i][2] + v[i][3] * v[i][3]); }
        ss = wave_sum(ss);
        const float rstd = rsqrtf(ss * (1.0f / DM) + EPS);
#pragma unroll
        for (int i = 0; i < 8; ++i) { const int col = 4 * (lane + 64 * i);
            const f32x4 w = *(const f32x4*)(nw + col), s = *(const f32x4*)(scl + col), t = *(const f32x4*)(sh + col);
            const f32x4 y = (v[i] * rstd) * w * (s + 1.0f) + t;
            u32x2 pw; pw.x = pk2(y[0], y[1]); pw.y = pk2(y[2], y[3]);
            *(u32x2*)(H + (size_t)row * DM + col) = pw; }
    }
}
DI void final_norm_phase(const float* xin, float* out, const float* fw) {
    const int tf = tid_fresh(), lane = tf & 63, wave = tf >> 6;
    for (int row = blockIdx.x * 8 + wave; row < ML; row += gridDim.x * 8) {
        const float* xr = xin + (size_t)row * DM; float* orow = out + (size_t)row * DM;
        f32x4 v[8]; float ss = 0.f;
#pragma unroll
        for (int i = 0; i < 8; ++i) { v[i] = *(const f32x4*)(xr + 4 * (lane + 64 * i)); ss += (v[i][0] * v[i][0] + v[i][1] * v[i][1]) + (v[i][2] * v[i][2] + v[i][3] * v[i][3]); }
        ss = wave_sum(ss);
        const float rstd = rsqrtf(ss * (1.0f / DM) + EPS);
#pragma unroll
        for (int i = 0; i < 8; ++i) { const int col = 4 * (lane + 64 * i); const f32x4 w = *(const f32x4*)(fw + col); *(f32x4*)(orow + col) = (v[i] * rstd) * w; }
    }
}
DI void unpack8(const u32x4& w, float (&f)[8]) { f[0] = bflo(w.x); f[1] = bfhi(w.x); f[2] = bflo(w.y); f[3] = bfhi(w.y); f[4] = bflo(w.z); f[5] = bfhi(w.z); f[6] = bflo(w.w); f[7] = bfhi(w.w); }
DI void act_phase(const bf16_t* G, const bf16_t* U, bf16_t* OUT, int nrows, const float* conv_w, const float* conv_b) {
    constexpr int NCC = DFF / 8, RCH = 16; const int TOTAL = (nrows / RCH) * NCC;
    for (int item = blockIdx.x * 512 + tid_fresh(); item < TOTAL; item += gridDim.x * 512) {
        const int cc = item % NCC, rc = item / NCC, t0 = rc * RCH, f = cc * 8;
        float w0[8], w1[8], w2[8], bb[8];
#pragma unroll
        for (int j = 0; j < 8; j += 4) { const f32x4 a = *(const f32x4*)(conv_w + f + j), b = *(const f32x4*)(conv_w + DFF + f + j), c = *(const f32x4*)(conv_w + 2 * DFF + f + j), d = *(const f32x4*)(conv_b + f + j);
#pragma unroll
            for (int q = 0; q < 4; ++q) { w0[j + q] = a[q]; w1[j + q] = b[q]; w2[j + q] = c[q]; bb[j + q] = d[q]; } }
        float prev[8], cur[8], nxt[8], uu[8];
        const bf16_t* gp = G + (size_t)t0 * DFF + f; const bf16_t* up = U + (size_t)t0 * DFF + f; bf16_t* op = OUT + (size_t)t0 * DFF + f;
        if (t0 & 2047) unpack8(*(const u32x4*)(gp - DFF), prev); else {
#pragma unroll
            for (int j = 0; j < 8; ++j) prev[j] = 0.f; }
        unpack8(*(const u32x4*)gp, cur);
#pragma unroll 4
        for (int i = 0; i < RCH; ++i) {
            const int t = t0 + i;
            if ((t & 2047) != 2047) unpack8(*(const u32x4*)(gp + (size_t)(i + 1) * DFF), nxt); else {
#pragma unroll
                for (int j = 0; j < 8; ++j) nxt[j] = 0.f; }
            unpack8(*(const u32x4*)(up + (size_t)i * DFF), uu);
            float a[8];
#pragma unroll
            for (int j = 0; j < 8; ++j) { const float z = w0[j] * prev[j] + w1[j] * cur[j] + w2[j] * nxt[j] + bb[j]; a[j] = z / (1.0f + __expf(-z)) * uu[j]; prev[j] = cur[j]; cur[j] = nxt[j]; }
            u32x4 w; w.x = pk2(a[0], a[1]); w.y = pk2(a[2], a[3]); w.z = pk2(a[4], a[5]); w.w = pk2(a[6], a[7]);
            *(u32x4*)(op + (size_t)i * DFF) = w;
        }
    }
}


#define XB_TMO      128
#define XB_XCNT(j)  (256  + 64 * (j))
#define XB_XSUB(j)  (1280 + 64 * (j))
#define XB_XGEN(j)  (2304 + 64 * (j))
#define XB_TOP      3328
#define XB_TOPGEN   3392
#define XCD_BAR_WORDS 3456
#define XB_SPIN_CAP (1u << 22)
DI unsigned xb_ld(unsigned* p)              { return __hip_atomic_load(p, __ATOMIC_RELAXED, __HIP_MEMORY_SCOPE_AGENT); }
DI unsigned xb_add(unsigned* p, unsigned v) { return __hip_atomic_fetch_add(p, v, __ATOMIC_RELAXED, __HIP_MEMORY_SCOPE_AGENT); }
DI unsigned xb_xcc_id() { return (unsigned)__builtin_amdgcn_s_getreg((3 << 11) | 20) & 0xFu; }
#define XB_SPIN(cond, bar) do { unsigned _sp = 0; while (cond) { __builtin_amdgcn_s_sleep(1); \
    if ((++_sp & 255u) == 0u) { if (xb_ld(&(bar)[XB_TMO])) break; if (_sp > XB_SPIN_CAP) { atomicAdd(&(bar)[XB_TMO], 1u); break; } } } } while (0)
struct XcdBarrier { unsigned* bar; unsigned x; volatile LAS unsigned* st; };
DI XcdBarrier xcd_barrier_post(unsigned* bar, volatile LAS unsigned* st) {
    XcdBarrier b; b.bar = bar; b.x = xb_xcc_id(); b.st = st;
    if (threadIdx.x == 0) (void)xb_add(&bar[XB_XCNT(b.x)], 1u);
    return b;
}
DI void xcd_barrier_complete(unsigned* bar, unsigned x, unsigned& nloc, unsigned& nx) {
    const unsigned G = gridDim.x * gridDim.y * gridDim.z;
    unsigned sum, cnt, mine, sp = 0u;
    for (;;) {
        sum = 0u; cnt = 0u; mine = 0u;
#pragma unroll
        for (unsigned j = 0; j < 16; ++j) { const unsigned c = xb_ld(&bar[XB_XCNT(j)]); sum += c; cnt += (c > 0u) ? 1u : 0u; mine = (j == x) ? c : mine; }
        if (sum == G) break;
        __builtin_amdgcn_s_sleep(1);
        if ((++sp & 255u) == 0u) { if (xb_ld(&bar[XB_TMO])) break; if (sp > XB_SPIN_CAP) { atomicAdd(&bar[XB_TMO], 1u); break; } }
    }
    nloc = mine > 0u ? mine : 1u; nx = cnt > 0u ? cnt : 1u;
}
DI void xcd_barrier(const XcdBarrier& b) {
    asm volatile("s_waitcnt vmcnt(0)" ::: "memory");
    __syncthreads();
    if (threadIdx.x == 0) {
        unsigned* bar = b.bar;
        __builtin_amdgcn_s_waitcnt(0);
        unsigned nloc = b.st[0], nx = b.st[1];
        if (nloc == 0u) { xcd_barrier_complete(bar, b.x, nloc, nx); b.st[0] = nloc; b.st[1] = nx; }
        const unsigned old = xb_add(&bar[XB_XSUB(b.x)], 1u);
        const unsigned gen = old / nloc;
        if (old + 1u == (gen + 1u) * nloc) {
            __builtin_amdgcn_fence(__ATOMIC_RELEASE, "agent");
            asm volatile("s_waitcnt vmcnt(0)" ::: "memory");
            const unsigned og = xb_add(&bar[XB_TOP], 1u);
            const unsigned tg = og / nx;
            if (og + 1u == (tg + 1u) * nx) xb_add(&bar[XB_TOPGEN], 1u);
            else XB_SPIN(xb_ld(&bar[XB_TOPGEN]) == tg, bar);
            __builtin_amdgcn_fence(__ATOMIC_ACQUIRE, "agent");
            xb_add(&bar[XB_XGEN(b.x)], 1u);
            asm volatile("s_waitcnt vmcnt(0)" ::: "memory");
        } else {
            XB_SPIN(xb_ld(&bar[XB_XGEN(b.x)]) == gen, bar);
            __builtin_amdgcn_fence(__ATOMIC_ACQUIRE, "agent");
            asm volatile("s_waitcnt vmcnt(0)" ::: "memory");
        }
    }
    __syncthreads();
}

__global__ void __launch_bounds__(512, 2) fwd_megakernel(Ptrs P) {
    extern __shared__ __attribute__((aligned(16))) unsigned char lds_raw[];
    LAS unsigned char* lds = (LAS unsigned char*)lds_raw;
    cg::grid_group grid = cg::this_grid();
    if (gridDim.x == 0x7fffffffu) grid.sync();
    volatile LAS unsigned* bst = (volatile LAS unsigned*)(lds + LDS_MAIN);
    if (threadIdx.x < 4) bst[threadIdx.x] = 0u;
    __syncthreads();
    const XcdBarrier gbar = xcd_barrier_post((unsigned*)(P.ws + WS_BAR), bst);
#define GRID_SYNC() xcd_barrier(gbar)
    unsigned char* ws = P.ws;
    const int G = gridDim.x, cid = blockIdx.x;
    float* MOD = (float*)(ws + WS_MOD);
    const f32x2* ROPE = (const f32x2*)(ws + WS_ROPE);
    float* SSQQ = (float*)(ws + WS_SSQ); float* SSQKV = SSQQ + ML;
    bf16_t* H = (bf16_t*)(ws + WS_H);
    float* X1 = (float*)(ws + WS_X1);

    p0_phase(lds, P);
#if PROBE_DUP == 0
    p0_phase(lds, P);
#endif
    GRID_SYNC();
#if PROBE_DUP == 20
    for (int i_ = 0; i_ < 10; ++i_) GRID_SYNC();
#endif
    norm_mod_phase(P.in[0], P.in[2], MT, P.in[6], MOD, 0, 1, H);
#if PROBE_DUP == 1 || PROBE_DUP == 16
    norm_mod_phase(P.in[0], P.in[2], MT, P.in[6], MOD, 0, 1, H);
#endif
    GRID_SYNC();
    {
        pg8::Gemm g{H, (const bf16_t*)(ws + WS_WIN), MT, INWP, DM}; pg8::StaticOrder S; S.init(MT, INWP, G, cid);
        EpiIn E{(bf16_t*)(ws + WS_QDA), (bf16_t*)(ws + WS_KDA), (bf16_t*)(ws + WS_VDA), (bf16_t*)(ws + WS_CQ), (bf16_t*)(ws + WS_CKV), (bf16_t*)(ws + WS_KR), SSQQ, SSQKV, ROPE, true};
        pg8::gemm_phase<EpiIn, pg8::StaticOrder, true>(lds, g, S, E);
#if PROBE_DUP == 2
        E.do_ssq = false; pg8::gemm_phase<EpiIn, pg8::StaticOrder, true>(lds, g, S, E);
#endif
        { const int rem = S.nwg % G; if (rem == 0) convert_wo_wup(lds, P, cid, G); else if (cid >= rem) convert_wo_wup(lds, P, cid - rem, G - rem); }
    }
    GRID_SYNC();
    {
        pg8::Gemm g{(const bf16_t*)(ws + WS_CQ), (const bf16_t*)(ws + WS_WUQ), ML, 1536, QRANK}; pg8::StaticOrder S; S.init(ML, 1536, G, cid);
        EpiQmla E{(bf16_t*)(ws + WS_QMLA), SSQQ, ROPE};
        pg8::gemm_phase<EpiQmla, pg8::StaticOrder, true>(lds, g, S, E);
#if PROBE_DUP == 3 || PROBE_DUP == 35
        pg8::gemm_phase<EpiQmla, pg8::StaticOrder, true>(lds, g, S, E);
#endif
    }
    {
        pg8::Gemm g{(const bf16_t*)(ws + WS_CKV), (const bf16_t*)(ws + WS_WUKV), MT, 2048, KVRANK}; pg8::StaticOrder S; S.init(MT, 2048, G, (cid + 64) % G);
        EpiKv E{(bf16_t*)(ws + WS_KVM), SSQKV};
        pg8::gemm_phase<EpiKv, pg8::StaticOrder, true>(lds, g, S, E);
#if PROBE_DUP == 3 || PROBE_DUP == 35
        pg8::gemm_phase<EpiKv, pg8::StaticOrder, true>(lds, g, S, E);
#endif
    }
    GRID_SYNC();
    attention_phase(lds, P);
#if PROBE_DUP == 41
    attention_phase(lds, P);
#endif
    attention_mla_phase(lds, P);
#if PROBE_DUP == 42
    attention_mla_phase(lds, P);
#endif
    GRID_SYNC();
    {
        pg8::Gemm g{(const bf16_t*)(ws + WS_MRG), (const bf16_t*)(ws + WS_WO), ML, DM, DM}; pg8::StaticOrder S; S.init(ML, DM, G, cid);
        EpiRes E{P.in[0], MOD + 2 * DM, X1};
        pg8::gemm_phase<EpiRes, pg8::StaticOrder, true>(lds, g, S, E);
#if PROBE_DUP == 5 || PROBE_DUP == 35
        pg8::gemm_phase<EpiRes, pg8::StaticOrder, true>(lds, g, S, E);
#endif
    }
    GRID_SYNC();
    norm_mod_phase(X1, nullptr, ML, P.in[18], MOD, 3, 4, H);
#if PROBE_DUP == 6 || PROBE_DUP == 16
    norm_mod_phase(X1, nullptr, ML, P.in[18], MOD, 3, 4, H);
#endif
    GRID_SYNC();
    {
        pg8::Gemm g{H, (const bf16_t*)(ws + WS_WUP), ML, 2 * DFF, DM}; pg8::StaticOrder S; S.init(ML, 2 * DFF, G, cid);
        EpiUp E{(bf16_t*)(ws + WS_G), (bf16_t*)(ws + WS_U)};
        pg8::gemm_phase<EpiUp, pg8::StaticOrder, true>(lds, g, S, E);
#if PROBE_DUP == 7
        pg8::gemm_phase<EpiUp, pg8::StaticOrder, true>(lds, g, S, E);
#endif
        { const int rem = S.nwg % G; if (rem == 0) convert_wdown(lds, P, cid, G); else if (cid >= rem) convert_wdown(lds, P, cid - rem, G - rem); }
    }
    GRID_SYNC();
#if PROBE_DUP == 8
    act_phase((const bf16_t*)(ws + WS_G), (const bf16_t*)(ws + WS_U), (bf16_t*)ws, 6144, P.in[20], P.in[21]);
#endif
    act_phase((const bf16_t*)(ws + WS_G), (const bf16_t*)(ws + WS_U), (bf16_t*)(ws + WS_U), ML, P.in[20], P.in[21]);
    GRID_SYNC();
    {
        pg8::Gemm g{(const bf16_t*)(ws + WS_U), (const bf16_t*)(ws + WS_WDN), ML, DM, DFF}; pg8::StaticOrder S; S.init(ML, DM, G, cid);
        EpiRes E{X1, MOD + 5 * DM, P.out};
        pg8::gemm_phase<EpiRes, pg8::StaticOrder, true>(lds, g, S, E);
#if PROBE_DUP == 9
        pg8::gemm_phase<EpiRes, pg8::StaticOrder, true>(lds, g, S, E);
#endif
    }
    GRID_SYNC();
#if PROBE_DUP == 10
    final_norm_phase(P.out, (float*)ws, P.in[23]);
#endif
    final_norm_phase(P.out, P.out, P.in[23]);
}

extern "C" void kernel_launch(void* const* d_in, const int* in_sizes, int n_in, void* d_out, int out_size, void* d_ws, size_t ws_size, hipStream_t stream) {
    static int grid_blocks = 0;
    if (grid_blocks == 0) {
        if (n_in != 24 || out_size != ML * DM || ws_size < WS_END) { fprintf(stderr, "kernel_launch: unexpected shapes (n_in %d out %d ws %zu, need %zu)\n", n_in, out_size, ws_size, (size_t)WS_END); grid_blocks = -1; return; }
        int dev = 0, cus = 0, per_cu = 0;
        (void)hipGetDevice(&dev);
        (void)hipDeviceGetAttribute(&cus, hipDeviceAttributeMultiprocessorCount, dev);
        if (hipFuncSetAttribute((const void*)fwd_megakernel, hipFuncAttributeMaxDynamicSharedMemorySize, LDS_BYTES) != hipSuccess) { fprintf(stderr, "kernel_launch: hipFuncSetAttribute failed\n"); grid_blocks = -1; return; }
        if (hipOccupancyMaxActiveBlocksPerMultiprocessor(&per_cu, (const void*)fwd_megakernel, 512, LDS_BYTES) != hipSuccess || per_cu < 1) { fprintf(stderr, "kernel_launch: occupancy query failed (%d)\n", per_cu); grid_blocks = -1; return; }
        grid_blocks = cus;
    }
    if (grid_blocks < 0) return;
    (void)hipMemsetAsync((unsigned char*)d_ws + WS_SSQ, 0, (WS_BAR - WS_SSQ) + XCD_BAR_WORDS * 4, stream);
    Ptrs p{};
    for (int i = 0; i < 24; ++i) p.in[i] = (const float*)d_in[i];
    p.out = (float*)d_out; p.ws = (unsigned char*)d_ws;
    void* args[] = {&p};
    hipError_t e = hipLaunchCooperativeKernel((const void*)fwd_megakernel, dim3(grid_blocks), dim3(512), args, LDS_BYTES, stream);
    if (e != hipSuccess) fprintf(stderr, "cooperative launch failed: %s (grid %d)\n", hipGetErrorString(e), grid_blocks);
}
```

```cpp
#include <hip/hip_runtime.h>
#include <hip/hip_cooperative_groups.h>
#include <cstdio>
#include <cstdint>
namespace cg = cooperative_groups;

#define LAS __attribute__((address_space(3)))
#define DI __device__ __forceinline__
typedef unsigned short bf16_t;
typedef short bf16x8 __attribute__((ext_vector_type(8)));
typedef short s16x4 __attribute__((ext_vector_type(4)));
typedef float f32x2 __attribute__((ext_vector_type(2)));
typedef float f32x4 __attribute__((ext_vector_type(4)));
typedef float f32x16 __attribute__((ext_vector_type(16)));
typedef unsigned u32x4 __attribute__((ext_vector_type(4)));
typedef unsigned u32x2 __attribute__((ext_vector_type(2)));
typedef __bf16 bf2_t __attribute__((ext_vector_type(2)));

constexpr int DM = 2048, NBATCH = 4, SEQ = 2048, CTXL = 256, NKEY = SEQ + CTXL;
constexpr int ML = NBATCH * SEQ, MC = NBATCH * CTXL, MT = ML + MC;
constexpr int INW = 3776, INWP = 3840, QRANK = 384, KVRANK = 256, DFF = 5632, NMODC = 6 * DM;
constexpr float EPS = 1e-6f;
constexpr size_t MiB = 1024 * 1024;
constexpr size_t WS_WIN = 0, WS_WUQ = 15 * MiB, WS_WUKV = 17 * MiB, WS_WO = 18 * MiB, WS_WUP = 26 * MiB, WS_WDN = 70 * MiB;
constexpr size_t WS_SMALL = 92 * MiB, WS_MOD = WS_SMALL, WS_ROPE = WS_SMALL + 256 * 1024, WS_SSQ = WS_SMALL + 512 * 1024;
constexpr size_t SSQ_BYTES = (size_t)(ML + MT) * 4;
constexpr size_t WS_BAR = WS_SSQ + 72 * 1024;
constexpr size_t WS_X1 = 93 * MiB, WS_H = 157 * MiB, WS_O1 = WS_H, WS_T = 193 * MiB;
constexpr size_t WS_QDA = WS_T, WS_KDA = WS_T + 16 * MiB, WS_VDA = WS_T + 34 * MiB, WS_CQ = WS_T + 52 * MiB, WS_CKV = WS_T + 58 * MiB,
                 WS_KR = WS_T + 63 * MiB, WS_QMLA = WS_T + 65 * MiB, WS_KVM = WS_T + 89 * MiB, WS_MRG = WS_T + 125 * MiB;
constexpr size_t WS_GS = WS_T, WS_US = WS_T + 12 * MiB, WS_U = WS_T + 88 * MiB, WS_END = WS_T + 176 * MiB;
constexpr int LDS_MAIN = 131072, LDS_BYTES = LDS_MAIN + 64;
#ifndef PROBE_DUP
#define PROBE_DUP -1
#endif

DI unsigned pk2(float lo, float hi) { f32x2 v = {lo, hi}; bf2_t b = __builtin_convertvector(v, bf2_t); return __builtin_bit_cast(unsigned, b); }
DI float bflo(unsigned u) { return __builtin_bit_cast(float, u << 16); }
DI float bfhi(unsigned u) { return __builtin_bit_cast(float, u & 0xffff0000u); }
DI int tid_fresh() { int t = threadIdx.x; asm volatile("" : "+v"(t)); return t; }
DI float wave_sum(float v) {
#pragma unroll
    for (int o = 1; o < 64; o <<= 1) v += __shfl_xor(v, o);
    return v;
}

namespace pg8 {
constexpr int BM = 256, BK = 64, HALF = 128, HTB = HALF * BK * 2, STAGE_BYTES = 8 * HTB, NXCD = 8, WGM = 8;
DI int lds_byte(int r, int c) { const int st = (r >> 4) * 2 + (c >> 5), rr = r & 15, cc = c & 31, ob = rr * 64 + cc * 2; return st * 1024 + (ob ^ (((ob >> 9) & 1) << 5)); }
DI void stage_rc(int b, int& R, int& C) { const int st = b / 1024, sb = b % 1024, swz = sb ^ (((sb >> 9) & 1) << 5); R = (st >> 1) * 16 + swz / 64; C = (st & 1) * 32 + (swz % 64) / 2; }
DI int perm32(int rho) { const int n = rho >> 4, i = rho & 15; return 8 * (i >> 2) + 4 * n + (i & 3); }
struct Unit { int pm, pn; };
struct Gemm { const bf16_t* A; const bf16_t* Bt; int M, N, K; };
struct StaticOrder {
    int nM, nN, nwg, G, c;
    DI void init(int M, int N, int G_, int c_) { nM = M / BM; nN = N / BM; nwg = nM * nN; G = G_; c = c_; }
    DI bool next(int i, Unit& u) const {
        const long L = (long)i * G + c; if (L >= nwg) return false;
        int wgid = (int)L; { const int q = nwg / NXCD, r = nwg % NXCD, xcd = wgid % NXCD, off = wgid / NXCD; wgid = (xcd < r ? xcd * (q + 1) : r * (q + 1) + (xcd - r) * q) + off; }
        const int nig = WGM * nN, gid = wgid / nig, fm = gid * WGM, gsz = (nM - fm) < WGM ? (nM - fm) : WGM;
        u.pm = fm + ((wgid % nig) % gsz); u.pn = (wgid % nig) / gsz; return true;
    }
};

template <class Epi, class Sched, bool ALIGN_EPI>
DI void gemm_phase(LAS unsigned char* lds, const Gemm g, const Sched& S, const Epi& E) {
    const int tid = tid_fresh(), wid = __builtin_amdgcn_readfirstlane(tid >> 6), lane = tid & 63, wr = wid >> 2, wc = wid & 3, fr = lane & 15, fq = lane >> 4;
    const int K = g.K, nt = K / BK;
    unsigned voffA[2], voffB[2];
#pragma unroll
    for (int i = 0; i < 2; ++i) { int R, C; stage_rc(tid * 16 + i * 8192, R, C); const int Rb = Epi::PERM ? ((R & ~31) + perm32(R & 31)) : R;
        voffA[i] = (unsigned)(R * K + C) * 2u; voffB[i] = (unsigned)(Rb * K + C) * 2u; }
    const size_t kstep = (size_t)(BK * 2);
    const size_t hstep = (size_t)HALF * K * 2;
    const size_t tstep = 2 * hstep;
    const unsigned ldsw = (unsigned)wid * 1024u;
    const int aoff = lds_byte(wr * 64 + fr, fq * 8), boff = lds_byte(wc * 32 + fr, fq * 8);
#define PG8_SA(b, h) (((b) * 2 + (h)) * HTB)
#define PG8_SB(b, h) ((4 + (b) * 2 + (h)) * HTB)
#define PG8_STAGE(bufoff, gbase, voff) do { _Pragma("unroll") for (int _i = 0; _i < 2; ++_i) \
        __builtin_amdgcn_global_load_lds((const unsigned*)((const char*)(gbase) + (voff)[_i]), (LAS unsigned*)(lds + (bufoff) + ldsw + _i * 8192), 16, 0, 0); } while (0)
#define PG8_LDA(dst, b, h) do { _Pragma("unroll") for (int m = 0; m < 4; ++m) _Pragma("unroll") for (int k = 0; k < 2; ++k) dst[m][k] = *(const LAS bf16x8*)(lds + PG8_SA(b, h) + aoff + m * 2048 + k * 1024); } while (0)
#define PG8_LDB(dst, b, h) do { _Pragma("unroll") for (int n = 0; n < 2; ++n) _Pragma("unroll") for (int k = 0; k < 2; ++k) dst[n][k] = *(const LAS bf16x8*)(lds + PG8_SB(b, h) + boff + n * 2048 + k * 1024); } while (0)
#define PG8_MMA(ai, bj, At, Bt) do { __builtin_amdgcn_s_setprio(1); _Pragma("unroll") for (int m = 0; m < 4; ++m) _Pragma("unroll") for (int n = 0; n < 2; ++n) _Pragma("unroll") for (int k = 0; k < 2; ++k) \
        acc[ai][bj][m][n] = __builtin_amdgcn_mfma_f32_16x16x32_bf16(Bt[n][k], At[m][k], acc[ai][bj][m][n], 0, 0, 0); __builtin_amdgcn_s_setprio(0); } while (0)
#define PG8_WAIT_V(n) asm volatile("s_waitcnt vmcnt(" #n ")" ::: "memory")
#define PG8_WAIT_L(n) asm volatile("s_waitcnt lgkmcnt(" #n ")" ::: "memory")
#define PG8_BAR __builtin_amdgcn_s_barrier()
#define PG8_SCHED __builtin_amdgcn_sched_barrier(0)
    Unit cur, nxt; int ui = 0;
    if (!S.next(0, cur)) return;
    f32x4 acc[2][2][4][2];
#pragma unroll
    for (int a = 0; a < 2; ++a)
#pragma unroll
        for (int b = 0; b < 2; ++b)
#pragma unroll
            for (int m = 0; m < 4; ++m)
#pragma unroll
                for (int n = 0; n < 2; ++n) acc[a][b][m][n] = (f32x4){0.f, 0.f, 0.f, 0.f};
    bf16x8 At[4][2], B0[2][2], B1[2][2];
    const char* cA = (const char*)g.A + (size_t)cur.pm * tstep; const char* cB = (const char*)g.Bt + (size_t)cur.pn * tstep;
    PG8_STAGE(PG8_SB(0, 0), cB, voffB); PG8_STAGE(PG8_SB(0, 1), cB + hstep, voffB); PG8_STAGE(PG8_SA(0, 0), cA, voffA); PG8_STAGE(PG8_SA(0, 1), cA + hstep, voffA);
    if (wr == 1) PG8_BAR;
    PG8_WAIT_V(2); PG8_BAR;
    PG8_STAGE(PG8_SB(1, 0), cB + kstep, voffB); PG8_STAGE(PG8_SA(1, 0), cA + kstep, voffA); PG8_STAGE(PG8_SB(1, 1), cB + hstep + kstep, voffB);
    PG8_WAIT_V(6); PG8_BAR;
    for (;;) {
        const bool has_next = S.next(ui + 1, nxt);
        const char* nA = has_next ? (const char*)g.A + (size_t)nxt.pm * tstep : cA; const char* nB = has_next ? (const char*)g.Bt + (size_t)nxt.pn * tstep : cB;
#pragma unroll 1
        for (int t = 0; t < nt; t += 2) {
            const bool last = (t == nt - 2);
            const char* a1 = cA + (size_t)(t + 1) * kstep;
            const char* a2 = last ? nA : cA + (size_t)(t + 2) * kstep; const char* b2 = last ? nB : cB + (size_t)(t + 2) * kstep;
            const char* a3 = a2 + kstep; const char* b3 = b2 + kstep;
            PG8_LDB(B0, 0, 0); PG8_LDB(B1, 0, 1); PG8_SCHED; PG8_LDA(At, 0, 0); PG8_STAGE(PG8_SA(1, 1), a1 + hstep, voffA);
            PG8_WAIT_V(8); PG8_WAIT_L(0); PG8_BAR; PG8_MMA(0, 0, At, B0); PG8_MMA(0, 1, At, B1); PG8_BAR; PG8_SCHED;
            PG8_LDA(At, 0, 1); PG8_STAGE(PG8_SB(0, 0), b2, voffB); PG8_STAGE(PG8_SB(0, 1), b2 + hstep, voffB); PG8_STAGE(PG8_SA(0, 0), a2, voffA);
            PG8_WAIT_V(8); PG8_WAIT_L(0); PG8_BAR; PG8_MMA(1, 0, At, B0); PG8_MMA(1, 1, At, B1); PG8_BAR; PG8_SCHED;
            PG8_LDB(B0, 1, 0); PG8_LDB(B1, 1, 1); PG8_SCHED; PG8_LDA(At, 1, 0); PG8_STAGE(PG8_SA(0, 1), a2 + hstep, voffA);
            PG8_WAIT_V(8); PG8_WAIT_L(0); PG8_BAR; PG8_MMA(0, 0, At, B0); PG8_MMA(0, 1, At, B1); PG8_BAR; PG8_SCHED;
            PG8_LDA(At, 1, 1); PG8_STAGE(PG8_SB(1, 0), b3, voffB); PG8_STAGE(PG8_SB(1, 1), b3 + hstep, voffB); PG8_STAGE(PG8_SA(1, 0), a3, voffA);
            PG8_WAIT_V(8); PG8_WAIT_L(0); PG8_BAR; PG8_MMA(1, 0, At, B0); PG8_MMA(1, 1, At, B1); PG8_BAR; PG8_SCHED;
        }
        if constexpr (ALIGN_EPI) { if (wr == 0) PG8_BAR; }
        E(acc, cur, wr, wc, fr, fq);
        if (!has_next) break;
#pragma unroll
        for (int a = 0; a < 2; ++a)
#pragma unroll
            for (int b = 0; b < 2; ++b)
#pragma unroll
                for (int m = 0; m < 4; ++m)
#pragma unroll
                    for (int n = 0; n < 2; ++n) acc[a][b][m][n] = (f32x4){0.f, 0.f, 0.f, 0.f};
        cur = nxt; cA = nA; cB = nB; ++ui;
        if constexpr (ALIGN_EPI) { if (wr == 1) PG8_BAR; }
    }
    PG8_WAIT_V(0);
    if constexpr (!ALIGN_EPI) { if (wr == 0) PG8_BAR; }
    PG8_BAR;
#undef PG8_SA
#undef PG8_SB
#undef PG8_STAGE
#undef PG8_LDA
#undef PG8_LDB
#undef PG8_MMA
#undef PG8_WAIT_V
#undef PG8_WAIT_L
#undef PG8_BAR
#undef PG8_SCHED
}
}
using pg8::Unit;

DI void rope4(f32x4& v0, f32x4& v1, const f32x2* rp) {
#pragma unroll
    for (int j = 0; j < 4; ++j) { const f32x2 cs = rp[j]; const float x1 = v0[j], x2 = v1[j]; v0[j] = x1 * cs.x - x2 * cs.y; v1[j] = x2 * cs.x + x1 * cs.y; }
}
DI void store_bf16_pair(bf16_t* dst, int fq, const f32x4& v0, const f32x4& v1) {
    u32x2 w0, w1; w0.x = pk2(v0[0], v0[1]); w0.y = pk2(v0[2], v0[3]); w1.x = pk2(v1[0], v1[1]); w1.y = pk2(v1[2], v1[3]);
    *(u32x2*)(dst + 4 * fq) = w0; *(u32x2*)(dst + 16 + 4 * fq) = w1;
}

struct EpiIn {
    static constexpr bool PERM = false;
    bf16_t *qda, *kda, *vda, *cq, *ckv, *kr; float *ssq_q, *ssq_kv; const f32x2* rope; bool do_ssq;
    DI void operator()(const f32x4 (&acc)[2][2][4][2], const Unit& u, int wr, int wc, int fr, int fq) const {
        const bool latent = u.pm < 32;
#pragma unroll
        for (int bj = 0; bj < 2; ++bj) {
            const int cb = u.pn * 256 + bj * 128 + wc * 32;
            if (cb >= INW) continue;
            if (cb < 1024 && !latent) continue;
            const bool is_cq = (cb >= 3072 && cb < 3456), is_ckv = (cb >= 3456 && cb < 3712);
            if (is_cq && !latent) continue;
            const bool do_rope = latent && (cb < 2048 || cb >= 3712);
            const bool colpart = (cb >> 5) & 1;
#pragma unroll
            for (int ai = 0; ai < 2; ++ai)
#pragma unroll
                for (int m = 0; m < 4; ++m) {
                    const int row = u.pm * 256 + ai * 128 + wr * 64 + m * 16 + fr;
                    f32x4 v0 = acc[ai][bj][m][0], v1 = acc[ai][bj][m][1];
                    int b, t; if (latent) { b = row >> 11; t = row & 2047; } else { b = (row - ML) >> 8; t = (row - ML) & 255; }
                    const int keyrow = b * NKEY + (latent ? CTXL + t : t);
                    if (do_rope) { const int pos = colpart ? (t & 63) : (t >> 6); rope4(v0, v1, rope + pos * 16 + 4 * fq); }
                    if ((is_cq || is_ckv) && do_ssq) {
                        float s = (v0[0] * v0[0] + v0[1] * v0[1]) + (v0[2] * v0[2] + v0[3] * v0[3]) + (v1[0] * v1[0] + v1[1] * v1[1]) + (v1[2] * v1[2] + v1[3] * v1[3]);
                        s += __shfl_xor(s, 16); s += __shfl_xor(s, 32);
                        if (fq == 0) atomicAdd((is_cq ? ssq_q : ssq_kv) + row, s);
                    }
                    bf16_t* dst;
                    if (cb < 1024) dst = qda + (size_t)row * 1024 + cb;
                    else if (cb < 2048) dst = kda + (size_t)keyrow * 1024 + (cb - 1024);
                    else if (cb < 3072) dst = vda + (size_t)keyrow * 1024 + (cb - 2048);
                    else if (cb < 3456) dst = cq + (size_t)row * QRANK + (cb - 3072);
                    else if (cb < 3712) dst = ckv + (size_t)row * KVRANK + (cb - 3456);
                    else dst = kr + (size_t)keyrow * 64 + (cb - 3712);
                    store_bf16_pair(dst, fq, v0, v1);
                    asm volatile("" ::: "memory");
                }
        }
    }
};
struct EpiQmla {
    static constexpr bool PERM = false;
    bf16_t* qmla; const float* ssq_q; const f32x2* rope;
    DI void operator()(const f32x4 (&acc)[2][2][4][2], const Unit& u, int wr, int wc, int fr, int fq) const {
#pragma unroll
        for (int bj = 0; bj < 2; ++bj) {
            const int cb = u.pn * 256 + bj * 128 + wc * 32;
            const int gi = (cb >> 5) % 6;
#pragma unroll
            for (int ai = 0; ai < 2; ++ai)
#pragma unroll
                for (int m = 0; m < 4; ++m) {
                    const int row = u.pm * 256 + ai * 128 + wr * 64 + m * 16 + fr;
                    const float rstd = rsqrtf(ssq_q[row] * (1.0f / QRANK) + EPS);
                    f32x4 v0 = acc[ai][bj][m][0] * rstd, v1 = acc[ai][bj][m][1] * rstd;
                    if (gi >= 4) { const int t = row & 2047; const int pos = (gi == 5) ? (t & 63) : (t >> 6); rope4(v0, v1, rope + pos * 16 + 4 * fq); }
                    store_bf16_pair(qmla + (size_t)row * 1536 + cb, fq, v0, v1);
                    asm volatile("" ::: "memory");
                }
        }
    }
};
struct EpiKv {
    static constexpr bool PERM = false;
    bf16_t* kvm; const float* ssq_kv;
    DI void operator()(const f32x4 (&acc)[2][2][4][2], const Unit& u, int wr, int wc, int fr, int fq) const {
        const bool latent = u.pm < 32;
#pragma unroll
        for (int bj = 0; bj < 2; ++bj) {
            const int cb = u.pn * 256 + bj * 128 + wc * 32;
#pragma unroll
            for (int ai = 0; ai < 2; ++ai)
#pragma unroll
                for (int m = 0; m < 4; ++m) {
                    const int row = u.pm * 256 + ai * 128 + wr * 64 + m * 16 + fr;
                    const float rstd = rsqrtf(ssq_kv[row] * (1.0f / KVRANK) + EPS);
                    int b, t; if (latent) { b = row >> 11; t = row & 2047; } else { b = (row - ML) >> 8; t = (row - ML) & 255; }
                    const int keyrow = b * NKEY + (latent ? CTXL + t : t);
                    const f32x4 v0 = acc[ai][bj][m][0] * rstd, v1 = acc[ai][bj][m][1] * rstd;
                    store_bf16_pair(kvm + (size_t)keyrow * 2048 + cb, fq, v0, v1);
                    asm volatile("" ::: "memory");
                }
        }
    }
};
struct EpiRes {
    static constexpr bool PERM = false;
    const float* base; const float* gate; float* out;
    DI void operator()(const f32x4 (&acc)[2][2][4][2], const Unit& u, int wr, int wc, int fr, int fq) const {
        const int b = u.pm >> 3;
#pragma unroll
        for (int bj = 0; bj < 2; ++bj)
#pragma unroll
            for (int n = 0; n < 2; ++n) {
                const int col = u.pn * 256 + bj * 128 + wc * 32 + n * 16 + 4 * fq;
                const f32x4 gv = *(const f32x4*)(gate + (size_t)b * NMODC + col);
#pragma unroll
                for (int ai = 0; ai < 2; ++ai)
#pragma unroll
                    for (int m = 0; m < 4; ++m) {
                        const int row = u.pm * 256 + ai * 128 + wr * 64 + m * 16 + fr;
                        const size_t off = (size_t)row * DM + col;
                        const f32x4 bs = *(const f32x4*)(base + off);
                        *(f32x4*)(out + off) = bs + gv * acc[ai][bj][m][n];
                    }
            }
    }
};
struct EpiUpAct {
    static constexpr bool PERM = false;
    bf16_t* act; float* gs; float* us; const float* conv_w; const float* conv_b;
    DI void operator()(const f32x4 (&acc)[2][2][4][2], const Unit& u, int wr, int wc, int fr, int fq) const {
        const int lane = fq * 16 + fr;
        const int up_src = (fr > 0) ? lane - 1 : lane + 15, dn_src = (fr < 15) ? lane + 1 : lane - 15;
#pragma unroll
        for (int n = 0; n < 2; ++n) {
            const int f = u.pn * 128 + wc * 32 + n * 16 + 4 * fq;
            const f32x4 w0 = *(const f32x4*)(conv_w + f), w1 = *(const f32x4*)(conv_w + DFF + f), w2 = *(const f32x4*)(conv_w + 2 * DFF + f), bb = *(const f32x4*)(conv_b + f);
#pragma unroll
            for (int ai = 0; ai < 2; ++ai) {
                const int base = u.pm * 256 + ai * 128 + wr * 64, span = base >> 6;
                f32x4 tu[4], td[4];
#pragma unroll
                for (int m = 0; m < 4; ++m)
#pragma unroll
                    for (int j = 0; j < 4; ++j) { tu[m][j] = __shfl(acc[ai][0][m][n][j], up_src); td[m][j] = __shfl(acc[ai][0][m][n][j], dn_src); }
#pragma unroll
                for (int m = 0; m < 4; ++m) {
                    const f32x4 g = acc[ai][0][m][n], uu = acc[ai][1][m][n];
                    const f32x4 zero = {0.f, 0.f, 0.f, 0.f};
                    const f32x4 upv = (fr == 0) ? (m > 0 ? tu[m > 0 ? m - 1 : 0] : zero) : tu[m];
                    const f32x4 dnv = (fr == 15) ? (m < 3 ? td[m < 3 ? m + 1 : 3] : zero) : td[m];
                    const f32x4 z = w0 * upv + w1 * g + w2 * dnv + bb;
                    f32x4 a;
#pragma unroll
                    for (int j = 0; j < 4; ++j) a[j] = z[j] * __builtin_amdgcn_rcpf(1.0f + __expf(-z[j])) * uu[j];
                    const bool edge = (m == 0 && fr == 0) || (m == 3 && fr == 15);
                    if (!edge) { u32x2 pw; pw.x = pk2(a[0], a[1]); pw.y = pk2(a[2], a[3]); *(u32x2*)(act + (size_t)(base + 16 * m + fr) * DFF + f) = pw; }
                }
                if (fr < 2) *(f32x4*)(gs + (size_t)(span * 4 + fr) * DFF + f) = acc[ai][0][0][n];
                if (fr >= 14) *(f32x4*)(gs + (size_t)(span * 4 + 2 + (fr - 14)) * DFF + f) = acc[ai][0][3][n];
                if (fr == 0) *(f32x4*)(us + (size_t)(span * 2) * DFF + f) = acc[ai][1][0][n];
                if (fr == 15) *(f32x4*)(us + (size_t)(span * 2 + 1) * DFF + f) = acc[ai][1][3][n];
                asm volatile("" ::: "memory");
            }
        }
    }
};

DI s16x4 tr_read(LAS const unsigned char* p) { return __builtin_bit_cast(s16x4, __builtin_amdgcn_ds_read_tr16_b64_v4i16((LAS s16x4*)p)); }

template <int DQK>
DI void attn_pass(LAS unsigned char* lds, const bf16_t* qrow, const bf16_t* K0, int ldk0, const bf16_t* K1, int ldk1, const bf16_t* V, int ldv,
                  float cexp, f32x16 (&o)[4], float& lsum_out) {
    constexpr int KST = (DQK + 8) * 2, VST = 320, KBUF = 64 * KST, VBUF = 64 * VST, NKC = DQK / 8, KCH = (64 * NKC) / 512, NKK = DQK / 16, NT = NKEY / 64;
    const int tid = tid_fresh(), lane = tid & 63, r = lane & 31, h = lane >> 5;
    bf16x8 qf[NKK];
#pragma unroll
    for (int kk = 0; kk < NKK; ++kk) qf[kk] = *(const bf16x8*)(qrow + 16 * kk + 8 * h);
#pragma unroll
    for (int d = 0; d < 4; ++d)
#pragma unroll
        for (int i = 0; i < 16; ++i) o[d][i] = 0.f;
    float mrun = -INFINITY, lsum = 0.f;
    u32x4 kreg[KCH], vreg[2];
    constexpr int NC0 = (DQK == 64) ? 8 : 16, KCH0 = (64 * NC0) / 512;
    unsigned ksrc[KCH]; int kdst[KCH];
#pragma unroll
    for (int i = 0; i < KCH; ++i) {
        if (i < KCH0) { const int ci = tid + 512 * i, key = ci / NC0, c8 = ci % NC0; ksrc[i] = (unsigned)(key * ldk0 + 8 * c8); kdst[i] = key * KST + c8 * 16; }
        else { const int key = tid >> 3, c8 = tid & 7; ksrc[i] = (unsigned)(key * ldk1 + 8 * c8); kdst[i] = key * KST + (16 + c8) * 16; }
    }
    unsigned vsrc[2]; int vdst[2];
#pragma unroll
    for (int i = 0; i < 2; ++i) { const int ci = tid + 512 * i, key = ci >> 4, c8 = ci & 15; vsrc[i] = (unsigned)(key * ldv + 8 * c8); vdst[i] = 2 * KBUF + key * VST + c8 * 16; }
#define AT_GLOAD(t) do { const bf16_t* k0t = K0 + (size_t)(t) * 64 * ldk0; const bf16_t* k1t = K1 + (size_t)(t) * 64 * ldk1; const bf16_t* vt = V + (size_t)(t) * 64 * ldv; \
                         _Pragma("unroll") for (int i = 0; i < KCH; ++i) kreg[i] = *(const u32x4*)((i < KCH0 ? k0t : k1t) + ksrc[i]); \
                         _Pragma("unroll") for (int i = 0; i < 2; ++i) vreg[i] = *(const u32x4*)(vt + vsrc[i]); } while (0)
#define AT_LSTORE(kb_, vb_) do { _Pragma("unroll") for (int i = 0; i < KCH; ++i) *(LAS u32x4*)(lds + (kb_) * KBUF + kdst[i]) = kreg[i]; \
                          _Pragma("unroll") for (int i = 0; i < 2; ++i) *(LAS u32x4*)(lds + (vb_) * VBUF + vdst[i]) = vreg[i]; } while (0)
#define AT_PV(vb_) do { _Pragma("unroll") for (int ks = 0; ks < 4; ++ks) { const bf16x8 pf = __builtin_bit_cast(bf16x8, pprev[ks]); \
            _Pragma("unroll") for (int d = 0; d < 4; ++d) { LAS const unsigned char* ap = lds + (vb_) * VBUF + voff + (16 * ks) * VST + d * 64; \
                const s16x4 lo = tr_read(ap), hi = tr_read(ap + 8 * VST); const bf16x8 vf = __builtin_shufflevector(lo, hi, 0, 1, 2, 3, 4, 5, 6, 7); \
                o[d] = __builtin_amdgcn_mfma_f32_32x32x16_bf16(vf, pf, o[d], 0, 0, 0); } } } while (0)
    const int koff = r * KST + 16 * h;
    const int i16 = lane & 15, q4 = i16 >> 2, p4 = i16 & 3, blk = (lane >> 4) & 1;
    const int voff = 2 * KBUF + (4 * h + q4) * VST + 32 * blk + 8 * p4;
    u32x4 pprev[4];
#pragma unroll
    for (int ks = 0; ks < 4; ++ks) pprev[ks] = (u32x4){0u, 0u, 0u, 0u};
    AT_GLOAD(0); AT_LSTORE(0, 0); __syncthreads();
    int vb_prev = 2, vb_cur = 0, vb_next = 1;
#pragma unroll 1
    for (int t = 0; t < NT; ++t) {
        const int b = t & 1;
        f32x16 st[2];
#pragma unroll
        for (int kb = 0; kb < 2; ++kb) {
#pragma unroll
            for (int i = 0; i < 16; ++i) st[kb][i] = 0.f;
#pragma unroll
            for (int kk = 0; kk < NKK; ++kk) {
                const bf16x8 kf = *(const LAS bf16x8*)(lds + b * KBUF + kb * 32 * KST + koff + 32 * kk);
                st[kb] = __builtin_amdgcn_mfma_f32_32x32x16_bf16(kf, qf[kk], st[kb], 0, 0, 0);
            }
        }
        if (t + 1 < NT) AT_GLOAD(t + 1);
        if (t > 0) AT_PV(vb_prev);
        float mx = st[0][0];
#pragma unroll
        for (int kb = 0; kb < 2; ++kb)
#pragma unroll
            for (int i = 0; i < 16; ++i) mx = fmaxf(mx, st[kb][i]);
        mx = fmaxf(mx, __shfl_xor(mx, 32)) * cexp;
        if (__builtin_amdgcn_ballot_w64(mx > mrun + 8.0f) != 0ull) {
            const float mn = fmaxf(mrun, mx);
            const float alpha = __builtin_amdgcn_exp2f(mrun - mn);
            lsum *= alpha; mrun = mn;
#pragma unroll
            for (int d = 0; d < 4; ++d)
#pragma unroll
                for (int i = 0; i < 16; ++i) o[d][i] *= alpha;
        }
        float ps = 0.f;
#pragma unroll
        for (int kb = 0; kb < 2; ++kb)
#pragma unroll
            for (int i = 0; i < 16; ++i) { const float pv = __builtin_amdgcn_exp2f(st[kb][i] * cexp - mrun); st[kb][i] = pv; ps += pv; }
        lsum += ps;
#pragma unroll
        for (int ks = 0; ks < 4; ++ks) {
            const int kb = ks >> 1, s = ks & 1;
            pprev[ks].x = pk2(st[kb][8 * s + 0], st[kb][8 * s + 1]); pprev[ks].y = pk2(st[kb][8 * s + 2], st[kb][8 * s + 3]);
            pprev[ks].z = pk2(st[kb][8 * s + 4], st[kb][8 * s + 5]); pprev[ks].w = pk2(st[kb][8 * s + 6], st[kb][8 * s + 7]);
        }
        if (t + 1 < NT) AT_LSTORE(b ^ 1, vb_next);
        __syncthreads();
        { const int tmp = vb_prev; vb_prev = vb_cur; vb_cur = vb_next; vb_next = tmp; }
    }
    AT_PV(vb_prev);
    __syncthreads();
#undef AT_GLOAD
#undef AT_LSTORE
#undef AT_PV
    lsum += __shfl_xor(lsum, 32);
    lsum_out = lsum;
}

struct Ptrs {
    const float* in[24]; float* out; unsigned char* ws;
};

DI void attention_phase(LAS unsigned char* lds, const Ptrs& P) {
    const int tid = threadIdx.x, lane = tid & 63, wave = tid >> 6, r = lane & 31, h = lane >> 5;
    unsigned char* ws = P.ws;
    const bf16_t* QDA = (const bf16_t*)(ws + WS_QDA); const bf16_t* KDA = (const bf16_t*)(ws + WS_KDA); const bf16_t* VDA = (const bf16_t*)(ws + WS_VDA);
    const bf16_t* QMLA = (const bf16_t*)(ws + WS_QMLA); const bf16_t* KVM = (const bf16_t*)(ws + WS_KVM); const bf16_t* KR = (const bf16_t*)(ws + WS_KR);
    bf16_t* MRG = (bf16_t*)(ws + WS_MRG);
    float* O1 = (float*)(ws + WS_O1) + (size_t)blockIdx.x * (16 * 512 * 4);
    const float LOG2E = 1.4426950408889634f;
    float lam;
    { const float s1 = wave_sum(P.in[12][lane] * P.in[13][lane]), s2 = wave_sum(P.in[14][lane] * P.in[15][lane]); lam = expf(s1) - expf(s2) + 0.2f; }
    const float* subln = P.in[16];
    for (int it = blockIdx.x; it < 256; it += gridDim.x) {
        const int b = it >> 6, hd = (it >> 3) & 7, qb = it & 7;
        const int qr = b * SEQ + qb * 256 + wave * 32 + r;
        f32x16 o[4]; float l;
        const bf16_t* qrow = QDA + (size_t)qr * 1024 + hd * 128;
        const bf16_t* Kb = KDA + (size_t)b * NKEY * 1024 + hd * 128;
        const bf16_t* Vb = VDA + (size_t)b * NKEY * 1024 + hd * 128;
        const float c = 0.125f * LOG2E;
        attn_pass<64>(lds, qrow, Kb, 1024, Kb, 1024, Vb, 1024, c, o, l);
        { const float inv = 1.0f / l;
#pragma unroll
          for (int d = 0; d < 4; ++d)
#pragma unroll
              for (int g = 0; g < 4; ++g) { f32x4 v = {o[d][4 * g] * inv, o[d][4 * g + 1] * inv, o[d][4 * g + 2] * inv, o[d][4 * g + 3] * inv};
                  *(f32x4*)(O1 + ((size_t)(d * 4 + g) * 512 + tid) * 4) = v; } }
        attn_pass<64>(lds, qrow + 64, Kb + 64, 1024, Kb + 64, 1024, Vb, 1024, c, o, l);
        const float inv2 = lam / l;
        float ss = 0.f;
#pragma unroll
        for (int d = 0; d < 4; ++d) {
#pragma unroll
            for (int g = 0; g < 4; ++g) { const f32x4 v1 = *(const f32x4*)(O1 + ((size_t)(d * 4 + g) * 512 + tid) * 4);
#pragma unroll
                for (int j = 0; j < 4; ++j) { const float v = v1[j] - o[d][4 * g + j] * inv2; o[d][4 * g + j] = v; ss += v * v; } }
            asm volatile("" ::: "memory");
        }
        ss += __shfl_xor(ss, 32);
        const float rs = rsqrtf(ss * (1.0f / 128.0f) + EPS) * 0.8f;
        bf16_t* orow = MRG + (size_t)qr * 2048 + hd * 128;
#pragma unroll
        for (int d = 0; d < 4; ++d) {
#pragma unroll
            for (int g = 0; g < 4; ++g) { const int dv = 32 * d + 8 * g + 4 * h; const f32x4 w = *(const f32x4*)(subln + dv);
                u32x2 pw; pw.x = pk2(o[d][4 * g] * rs * w[0], o[d][4 * g + 1] * rs * w[1]); pw.y = pk2(o[d][4 * g + 2] * rs * w[2], o[d][4 * g + 3] * rs * w[3]);
                *(u32x2*)(orow + dv) = pw; }
            asm volatile("" ::: "memory");
        }
    }
}
DI void attention_mla_phase(LAS unsigned char* lds, const Ptrs& P) {
    const int tid = threadIdx.x, lane = tid & 63, wave = tid >> 6, r = lane & 31, h = lane >> 5;
    unsigned char* ws = P.ws;
    const bf16_t* QMLA = (const bf16_t*)(ws + WS_QMLA); const bf16_t* KVM = (const bf16_t*)(ws + WS_KVM); const bf16_t* KR = (const bf16_t*)(ws + WS_KR);
    bf16_t* MRG = (bf16_t*)(ws + WS_MRG);
    const float LOG2E = 1.4426950408889634f;
    (void)tid;
    for (int it = blockIdx.x; it < 256; it += gridDim.x) {
        const int b = it >> 6, hd = (it >> 3) & 7, qb = it & 7;
        const int qr = b * SEQ + qb * 256 + wave * 32 + r;
        f32x16 o[4]; float l;
        const bf16_t* qrow = QMLA + (size_t)qr * 1536 + hd * 192;
        const bf16_t* Kb = KVM + (size_t)b * NKEY * 2048 + hd * 256;
        const bf16_t* Krp = KR + (size_t)b * NKEY * 64;
        const float c = 0.07216878364870323f * LOG2E;
        attn_pass<192>(lds, qrow, Kb, 2048, Krp, 64, Kb + 128, 2048, c, o, l);
        const float inv = 1.0f / l;
        bf16_t* orow = MRG + (size_t)qr * 2048 + 1024 + hd * 128;
#pragma unroll
        for (int d = 0; d < 4; ++d)
#pragma unroll
            for (int g = 0; g < 4; ++g) { const int dv = 32 * d + 8 * g + 4 * h;
                u32x2 pw; pw.x = pk2(o[d][4 * g] * inv, o[d][4 * g + 1] * inv); pw.y = pk2(o[d][4 * g + 2] * inv, o[d][4 * g + 3] * inv);
                *(u32x2*)(orow + dv) = pw; }
    }
}

DI void ada_unit(LAS unsigned char* lds, const Ptrs& P, int u) {
    const int tid = threadIdx.x, lane = tid & 63, wave = tid >> 6;
    LAS float* sc = (LAS float*)lds; LAS float* red = (LAS float*)(lds + 40960);
    const float* c = P.in[1]; const float* cc = P.in[3]; const float* w_ada = P.in[4]; const float* b_ada = P.in[5];
    float* MOD = (float*)(P.ws + WS_MOD);
    for (int idx = tid; idx < 5 * DM; idx += 512) { const float v = idx < 4 * DM ? c[idx] : cc[idx - 4 * DM]; sc[idx] = v / (1.0f + __expf(-v)); }
    __syncthreads();
    const int cgp = tid & 15, rg = tid >> 4;
    float acc[5][4];
#pragma unroll
    for (int rr = 0; rr < 5; ++rr)
#pragma unroll
        for (int j = 0; j < 4; ++j) acc[rr][j] = 0.f;
    const float* wp = w_ada + (size_t)rg * NMODC + 64 * u + 4 * cgp;
#pragma unroll 8
    for (int i = 0; i < 64; ++i) {
        const f32x4 w = *(const f32x4*)(wp + (size_t)i * 32 * NMODC);
        const int k = rg + 32 * i;
#pragma unroll
        for (int rr = 0; rr < 5; ++rr) { const float s = sc[rr * DM + k];
#pragma unroll
            for (int j = 0; j < 4; ++j) acc[rr][j] += s * w[j]; }
    }
#pragma unroll
    for (int rr = 0; rr < 5; ++rr)
#pragma unroll
        for (int j = 0; j < 4; ++j) { float a = acc[rr][j]; a += __shfl_xor(a, 16); a += __shfl_xor(a, 32); if (lane < 16) red[(wave * 16 + lane) * 20 + rr * 4 + j] = a; }
    __syncthreads();
    if (tid < 320) { const int cg2 = tid / 20, rj = tid % 20, rr = rj >> 2, j = rj & 3; float s = 0.f;
#pragma unroll
        for (int w = 0; w < 8; ++w) s += red[(w * 16 + cg2) * 20 + rj];
        const int col = 64 * u + 4 * cg2 + j; MOD[(size_t)rr * NMODC + col] = s + b_ada[col]; }
    __syncthreads();
}

DI void transpose_unit(LAS unsigned char* lds, const float* W, int K, int N, bf16_t* Wt, int n0, int k0, const float* kscale, int n0d = -1) {
    if (n0d < 0) n0d = n0;
    const int tid = tid_fresh();
    LAS float* sf = (LAS float*)lds;
    if (n0 >= N) {
#pragma unroll
        for (int i = 0; i < 2; ++i) { const int idx = tid + 512 * i, kc = idx & 15, n = idx >> 4; *(u32x4*)(Wt + (size_t)(n0d + n) * K + k0 + 8 * kc) = (u32x4){0u, 0u, 0u, 0u}; }
        return;
    }
#pragma unroll
    for (int i = 0; i < 4; ++i) { const int idx = tid + 512 * i, kr = idx >> 4, c4 = idx & 15;
        f32x4 v = *(const f32x4*)(W + (size_t)(k0 + kr) * N + n0 + 4 * c4);
        if (kscale) v = v * kscale[k0 + kr];
#pragma unroll
        for (int j = 0; j < 4; ++j) sf[kr * 65 + 4 * c4 + j] = v[j]; }
    __syncthreads();
#pragma unroll
    for (int i = 0; i < 2; ++i) { const int idx = tid + 512 * i, kc = idx & 15, n = idx >> 4;
        float f[8];
#pragma unroll
        for (int j = 0; j < 8; ++j) f[j] = sf[(8 * kc + j) * 65 + n];
        u32x4 w; w.x = pk2(f[0], f[1]); w.y = pk2(f[2], f[3]); w.z = pk2(f[4], f[5]); w.w = pk2(f[6], f[7]);
        *(u32x4*)(Wt + (size_t)(n0d + n) * K + k0 + 8 * kc) = w; }
    __syncthreads();
}

DI void p0_phase(LAS unsigned char* lds, const Ptrs& P) {
    unsigned char* ws = P.ws;
    constexpr int U_ADA = 192, U_ROPE = 1;
    constexpr int T0 = 60 * 16, T1 = 24 * 3, T2 = 32 * 2;
    constexpr int NU = U_ADA + U_ROPE + T0 + T1 + T2;
    for (int u = blockIdx.x; u < NU; u += gridDim.x) {
        if (u < U_ADA) { ada_unit(lds, P, u); continue; }
        if (u == U_ADA) {
            f32x2* rope = (f32x2*)(ws + WS_ROPE);
            for (int idx = threadIdx.x; idx < 1024; idx += 512) { const int pos = idx >> 4, i = idx & 15;
                const double inv = pow(10000.0, -(double)i / 16.0); const double ang = (double)pos * (double)(float)inv;
                rope[idx] = (f32x2){(float)cos(ang), (float)sin(ang)}; }
            continue;
        }
        int v = u - U_ADA - U_ROPE;
        if (v < T0) { transpose_unit(lds, P.in[7], DM, INW, (bf16_t*)(ws + WS_WIN), (v % 60) * 64, (v / 60) * 128, nullptr); continue; } v -= T0;
        if (v < T1) { transpose_unit(lds, P.in[10], QRANK, 1536, (bf16_t*)(ws + WS_WUQ), (v % 24) * 64, (v / 24) * 128, P.in[8]); continue; } v -= T1;
        transpose_unit(lds, P.in[11], KVRANK, 2048, (bf16_t*)(ws + WS_WUKV), (v % 32) * 64, (v / 32) * 128, P.in[9]);
    }
}
DI void convert_wo_wup(LAS unsigned char* lds, const Ptrs& P, int idx, int nblk) {
    unsigned char* ws = P.ws;
    constexpr int T3 = 32 * 16, T4 = 176 * 16;
    for (int v = idx; v < T3 + T4; v += nblk) {
        if (v < T3) transpose_unit(lds, P.in[17], DM, DM, (bf16_t*)(ws + WS_WO), (v % 32) * 64, (v / 32) * 128, nullptr);
        else { const int w = v - T3; const int c = (w % 176) * 64; const int cc = c < DFF ? c : c - DFF; const int nd = 256 * (cc >> 7) + (cc & 127) + (c < DFF ? 0 : 128);
               transpose_unit(lds, P.in[19], DM, 2 * DFF, (bf16_t*)(ws + WS_WUP), c, (w / 176) * 128, nullptr, nd); }
    }
}
DI void convert_wdown(LAS unsigned char* lds, const Ptrs& P, int idx, int nblk) {
    constexpr int T5 = 32 * 44;
    for (int v = idx; v < T5; v += nblk) transpose_unit(lds, P.in[22], DFF, DM, (bf16_t*)(P.ws + WS_WDN), (v % 32) * 64, (v / 32) * 128, nullptr);
}

DI void norm_mod_phase(const float* X, const float* XC, int nrows, const float* nw, const float* MOD, int shift_idx, int scale_idx, bf16_t* H) {
    const int tf = tid_fresh(), lane = tf & 63, wave = tf >> 6;
    for (int row = blockIdx.x * 8 + wave; row < nrows; row += gridDim.x * 8) {
        const float* xr = row < ML ? X + (size_t)row * DM : XC + (size_t)(row - ML) * DM;
        const int mb = row < ML ? (row >> 11) : 4;
        const float* sh = MOD + (size_t)mb * NMODC + shift_idx * DM; const float* scl = MOD + (size_t)mb * NMODC + scale_idx * DM;
        f32x4 v[8]; float ss = 0.f;
#pragma unroll
        for (int i = 0; i < 8; ++i) { v[i] = *(const f32x4*)(xr + 4 * (lane + 64 * i)); ss += (v[i][0] * v[i][0] + v[i][1] * v[i][1]) + (v[i][2] * v[i][2] + v[i][3] * v[i][3]); }
        ss = wave_sum(ss);
        const float rstd = rsqrtf(ss * (1.0f / DM) + EPS);
#pragma unroll
        for (int i = 0; i < 8; ++i) { const int col = 4 * (lane + 64 * i);
            const f32x4 w = *(const f32x4*)(nw + col), s = *(const f32x4*)(scl + col), t = *(const f32x4*)(sh + col);
            const f32x4 y = (v[i] * rstd) * w * (s + 1.0f) + t;
            u32x2 pw; pw.x = pk2(y[0], y[1]); pw.y = pk2(y[2], y[3]);
            *(u32x2*)(H + (size_t)row * DM + col) = pw; }
    }
}
DI void final_norm_phase(const float* xin, float* out, const float* fw) {
    const int tf = tid_fresh(), lane = tf & 63, wave = tf >> 6;
    for (int row = blockIdx.x * 8 + wave; row < ML; row += gridDim.x * 8) {
        const float* xr = xin + (size_t)row * DM; float* orow = out + (size_t)row * DM;
        f32x4 v[8]; float ss = 0.f;
#pragma unroll
        for (int i = 0; i < 8; ++i) { v[i] = *(const f32x4*)(xr + 4 * (lane + 64 * i)); ss += (v[i][0] * v[i][0] + v[i][1] * v[i][1]) + (v[i][2] * v[i][2] + v[i][3] * v[i][3]); }
        ss = wave_sum(ss);
        const float rstd = rsqrtf(ss * (1.0f / DM) + EPS);
#pragma unroll
        for (int i = 0; i < 8; ++i) { const int col = 4 * (lane + 64 * i); const f32x4 w = *(const f32x4*)(fw + col); *(f32x4*)(orow + col) = (v[i] * rstd) * w; }
    }
}
DI void act_fixup_phase(const float* GS, const float* US, bf16_t* ACT, const float* conv_w, const float* conv_b) {
    constexpr int NF4 = DFF / 4, NSPAN = ML / 64, TOTAL = NSPAN * 2 * NF4;
    for (int item = blockIdx.x * 512 + tid_fresh(); item < TOTAL; item += gridDim.x * 512) {
        const int f = (item % NF4) * 4, sd = (item / NF4) & 1, span = item / (2 * NF4);
        const int row = span * 64 + (sd ? 63 : 0);
        const f32x4 zero = {0.f, 0.f, 0.f, 0.f};
        f32x4 up, cur, dn, uu;
        if (sd == 0) { up = (row & 2047) ? *(const f32x4*)(GS + (size_t)((span - 1) * 4 + 3) * DFF + f) : zero; cur = *(const f32x4*)(GS + (size_t)(span * 4) * DFF + f);
                       dn = *(const f32x4*)(GS + (size_t)(span * 4 + 1) * DFF + f); uu = *(const f32x4*)(US + (size_t)(span * 2) * DFF + f); }
        else { up = *(const f32x4*)(GS + (size_t)(span * 4 + 2) * DFF + f); cur = *(const f32x4*)(GS + (size_t)(span * 4 + 3) * DFF + f);
               dn = ((row & 2047) != 2047) ? *(const f32x4*)(GS + (size_t)((span + 1) * 4) * DFF + f) : zero; uu = *(const f32x4*)(US + (size_t)(span * 2 + 1) * DFF + f); }
        const f32x4 w0 = *(const f32x4*)(conv_w + f), w1 = *(const f32x4*)(conv_w + DFF + f), w2 = *(const f32x4*)(conv_w + 2 * DFF + f), bb = *(const f32x4*)(conv_b + f);
        const f32x4 z = w0 * up + w1 * cur + w2 * dn + bb;
        f32x4 a;
#pragma unroll
        for (int j = 0; j < 4; ++j) a[j] = z[j] / (1.0f + __expf(-z[j])) * uu[j];
        u32x2 pw; pw.x = pk2(a[0], a[1]); pw.y = pk2(a[2], a[3]);
        *(u32x2*)(ACT + (size_t)row * DFF + f) = pw;
    }
}

#define XB_TMO      128
#define XB_XCNT(j)  (256  + 64 * (j))
#define XB_XSUB(j)  (1280 + 64 * (j))
#define XB_XGEN(j)  (2304 + 64 * (j))
#define XB_TOP      3328
#define XB_TOPGEN   3392
#define XCD_BAR_WORDS 3456
#define XB_SPIN_CAP (1u << 22)
DI unsigned xb_ld(unsigned* p)              { return __hip_atomic_load(p, __ATOMIC_RELAXED, __HIP_MEMORY_SCOPE_AGENT); }
DI unsigned xb_add(unsigned* p, unsigned v) { return __hip_atomic_fetch_add(p, v, __ATOMIC_RELAXED, __HIP_MEMORY_SCOPE_AGENT); }
DI unsigned xb_xcc_id() { return (unsigned)__builtin_amdgcn_s_getreg((3 << 11) | 20) & 0xFu; }
#define XB_SPIN(cond, bar) do { unsigned _sp = 0; while (cond) { __builtin_amdgcn_s_sleep(1); \
    if ((++_sp & 255u) == 0u) { if (xb_ld(&(bar)[XB_TMO])) break; if (_sp > XB_SPIN_CAP) { atomicAdd(&(bar)[XB_TMO], 1u); break; } } } } while (0)
struct XcdBarrier { unsigned* bar; unsigned x; volatile LAS unsigned* st; };
DI XcdBarrier xcd_barrier_post(unsigned* bar, volatile LAS unsigned* st) {
    XcdBarrier b; b.bar = bar; b.x = xb_xcc_id(); b.st = st;
    if (threadIdx.x == 0) (void)xb_add(&bar[XB_XCNT(b.x)], 1u);
    return b;
}
DI void xcd_barrier_complete(unsigned* bar, unsigned x, unsigned& nloc, unsigned& nx) {
    const unsigned G = gridDim.x * gridDim.y * gridDim.z;
    unsigned sum, cnt, mine, sp = 0u;
    for (;;) {
        sum = 0u; cnt = 0u; mine = 0u;
#pragma unroll
        for (unsigned j = 0; j < 16; ++j) { const unsigned c = xb_ld(&bar[XB_XCNT(j)]); sum += c; cnt += (c > 0u) ? 1u : 0u; mine = (j == x) ? c : mine; }
        if (sum == G) break;
        __builtin_amdgcn_s_sleep(1);
        if ((++sp & 255u) == 0u) { if (xb_ld(&bar[XB_TMO])) break; if (sp > XB_SPIN_CAP) { atomicAdd(&bar[XB_TMO], 1u); break; } }
    }
    nloc = mine > 0u ? mine : 1u; nx = cnt > 0u ? cnt : 1u;
}
DI void xcd_barrier(const XcdBarrier& b) {
    asm volatile("s_waitcnt vmcnt(0)" ::: "memory");
    __syncthreads();
    if (threadIdx.x == 0) {
        unsigned* bar = b.bar;
        __builtin_amdgcn_s_waitcnt(0);
        unsigned nloc = b.st[0], nx = b.st[1];
        if (nloc == 0u) { xcd_barrier_complete(bar, b.x, nloc, nx); b.st[0] = nloc; b.st[1] = nx; }
        const unsigned old = xb_add(&bar[XB_XSUB(b.x)], 1u);
        const unsigned gen = old / nloc;
        if (old + 1u == (gen + 1u) * nloc) {
            __builtin_amdgcn_fence(__ATOMIC_RELEASE, "agent");
            asm volatile("s_waitcnt vmcnt(0)" ::: "memory");
            const unsigned og = xb_add(&bar[XB_TOP], 1u);
            const unsigned tg = og / nx;
            if (og + 1u == (tg + 1u) * nx) xb_add(&bar[XB_TOPGEN], 1u);
            else XB_SPIN(xb_ld(&bar[XB_TOPGEN]) == tg, bar);
            __builtin_amdgcn_fence(__ATOMIC_ACQUIRE, "agent");
            xb_add(&bar[XB_XGEN(b.x)], 1u);
            asm volatile("s_waitcnt vmcnt(0)" ::: "memory");
        } else {
            XB_SPIN(xb_ld(&bar[XB_XGEN(b.x)]) == gen, bar);
            __builtin_amdgcn_fence(__ATOMIC_ACQUIRE, "agent");
            asm volatile("s_waitcnt vmcnt(0)" ::: "memory");
        }
    }
    __syncthreads();
}

__global__ void __launch_bounds__(512, 2) fwd_megakernel(Ptrs P) {
    extern __shared__ __attribute__((aligned(16))) unsigned char lds_raw[];
    LAS unsigned char* lds = (LAS unsigned char*)lds_raw;
    cg::grid_group grid = cg::this_grid();
    if (gridDim.x == 0x7fffffffu) grid.sync();
    volatile LAS unsigned* bst = (volatile LAS unsigned*)(lds + LDS_MAIN);
    if (threadIdx.x < 4) bst[threadIdx.x] = 0u;
    __syncthreads();
    const XcdBarrier gbar = xcd_barrier_post((unsigned*)(P.ws + WS_BAR), bst);
#define GRID_SYNC() xcd_barrier(gbar)
    unsigned char* ws = P.ws;
    const int G = gridDim.x, cid = blockIdx.x;
    float* MOD = (float*)(ws + WS_MOD);
    const f32x2* ROPE = (const f32x2*)(ws + WS_ROPE);
    float* SSQQ = (float*)(ws + WS_SSQ); float* SSQKV = SSQQ + ML;
    bf16_t* H = (bf16_t*)(ws + WS_H);
    float* X1 = (float*)(ws + WS_X1);

    p0_phase(lds, P);
#if PROBE_DUP == 0
    p0_phase(lds, P);
#endif
    GRID_SYNC();
#if PROBE_DUP == 20
    for (int i_ = 0; i_ < 10; ++i_) GRID_SYNC();
#endif
    norm_mod_phase(P.in[0], P.in[2], MT, P.in[6], MOD, 0, 1, H);
#if PROBE_DUP == 1 || PROBE_DUP == 16
    norm_mod_phase(P.in[0], P.in[2], MT, P.in[6], MOD, 0, 1, H);
#endif
    GRID_SYNC();
    {
        pg8::Gemm g{H, (const bf16_t*)(ws + WS_WIN), MT, INWP, DM}; pg8::StaticOrder S; S.init(MT, INWP, G, cid);
        EpiIn E{(bf16_t*)(ws + WS_QDA), (bf16_t*)(ws + WS_KDA), (bf16_t*)(ws + WS_VDA), (bf16_t*)(ws + WS_CQ), (bf16_t*)(ws + WS_CKV), (bf16_t*)(ws + WS_KR), SSQQ, SSQKV, ROPE, true};
        pg8::gemm_phase<EpiIn, pg8::StaticOrder, true>(lds, g, S, E);
#if PROBE_DUP == 2
        E.do_ssq = false; pg8::gemm_phase<EpiIn, pg8::StaticOrder, true>(lds, g, S, E);
#endif
        { const int rem = S.nwg % G; if (rem == 0) convert_wo_wup(lds, P, cid, G); else if (cid >= rem) convert_wo_wup(lds, P, cid - rem, G - rem); }
    }
    GRID_SYNC();
    {
        pg8::Gemm g{(const bf16_t*)(ws + WS_CQ), (const bf16_t*)(ws + WS_WUQ), ML, 1536, QRANK}; pg8::StaticOrder S; S.init(ML, 1536, G, cid);
        EpiQmla E{(bf16_t*)(ws + WS_QMLA), SSQQ, ROPE};
        pg8::gemm_phase<EpiQmla, pg8::StaticOrder, true>(lds, g, S, E);
#if PROBE_DUP == 3 || PROBE_DUP == 35
        pg8::gemm_phase<EpiQmla, pg8::StaticOrder, true>(lds, g, S, E);
#endif
    }
    {
        pg8::Gemm g{(const bf16_t*)(ws + WS_CKV), (const bf16_t*)(ws + WS_WUKV), MT, 2048, KVRANK}; pg8::StaticOrder S; S.init(MT, 2048, G, (cid + 64) % G);
        EpiKv E{(bf16_t*)(ws + WS_KVM), SSQKV};
        pg8::gemm_phase<EpiKv, pg8::StaticOrder, true>(lds, g, S, E);
#if PROBE_DUP == 3 || PROBE_DUP == 35
        pg8::gemm_phase<EpiKv, pg8::StaticOrder, true>(lds, g, S, E);
#endif
    }
    GRID_SYNC();
    attention_phase(lds, P);
#if PROBE_DUP == 41
    attention_phase(lds, P);
#endif
    attention_mla_phase(lds, P);
#if PROBE_DUP == 42
    attention_mla_phase(lds, P);
#endif
    GRID_SYNC();
    {
        pg8::Gemm g{(const bf16_t*)(ws + WS_MRG), (const bf16_t*)(ws + WS_WO), ML, DM, DM}; pg8::StaticOrder S; S.init(ML, DM, G, cid);
        EpiRes E{P.in[0], MOD + 2 * DM, X1};
        pg8::gemm_phase<EpiRes, pg8::StaticOrder, true>(lds, g, S, E);
#if PROBE_DUP == 5 || PROBE_DUP == 35
        pg8::gemm_phase<EpiRes, pg8::StaticOrder, true>(lds, g, S, E);
#endif
    }
    GRID_SYNC();
    norm_mod_phase(X1, nullptr, ML, P.in[18], MOD, 3, 4, H);
#if PROBE_DUP == 6 || PROBE_DUP == 16
    norm_mod_phase(X1, nullptr, ML, P.in[18], MOD, 3, 4, H);
#endif
    GRID_SYNC();
    {
        pg8::Gemm g{H, (const bf16_t*)(ws + WS_WUP), ML, 2 * DFF, DM}; pg8::StaticOrder S; S.init(ML, 2 * DFF, G, cid);
        EpiUpAct E{(bf16_t*)(ws + WS_U), (float*)(ws + WS_GS), (float*)(ws + WS_US), P.in[20], P.in[21]};
        pg8::gemm_phase<EpiUpAct, pg8::StaticOrder, true>(lds, g, S, E);
#if PROBE_DUP == 7
        pg8::gemm_phase<EpiUpAct, pg8::StaticOrder, true>(lds, g, S, E);
#endif
        { const int rem = S.nwg % G; if (rem == 0) convert_wdown(lds, P, cid, G); else if (cid >= rem) convert_wdown(lds, P, cid - rem, G - rem); }
    }
    GRID_SYNC();
    act_fixup_phase((const float*)(ws + WS_GS), (const float*)(ws + WS_US), (bf16_t*)(ws + WS_U), P.in[20], P.in[21]);
    GRID_SYNC();
    {
        pg8::Gemm g{(const bf16_t*)(ws + WS_U), (const bf16_t*)(ws + WS_WDN), ML, DM, DFF}; pg8::StaticOrder S; S.init(ML, DM, G, cid);
        EpiRes E{X1, MOD + 5 * DM, P.out};
        pg8::gemm_phase<EpiRes, pg8::StaticOrder, true>(lds, g, S, E);
#if PROBE_DUP == 9
        pg8::gemm_phase<EpiRes, pg8::StaticOrder, true>(lds, g, S, E);
#endif
    }
    GRID_SYNC();
#if PROBE_DUP == 10
    final_norm_phase(P.out, (float*)ws, P.in[23]);
#endif
    final_norm_phase(P.out, P.out, P.in[23]);
}

extern "C" void kernel_launch(void* const* d_in, const int* in_sizes, int n_in, void* d_out, int out_size, void* d_ws, size_t ws_size, hipStream_t stream) {
    static int grid_blocks = 0;
    if (grid_blocks == 0) {
        if (n_in != 24 || out_size != ML * DM || ws_size < WS_END) { fprintf(stderr, "kernel_launch: unexpected shapes (n_in %d out %d ws %zu, need %zu)\n", n_in, out_size, ws_size, (size_t)WS_END); grid_blocks = -1; return; }
        int dev = 0, cus = 0, per_cu = 0;
        (void)hipGetDevice(&dev);
        (void)hipDeviceGetAttribute(&cus, hipDeviceAttributeMultiprocessorCount, dev);
        if (hipFuncSetAttribute((const void*)fwd_megakernel, hipFuncAttributeMaxDynamicSharedMemorySize, LDS_BYTES) != hipSuccess) { fprintf(stderr, "kernel_launch: hipFuncSetAttribute failed\n"); grid_blocks = -1; return; }
        if (hipOccupancyMaxActiveBlocksPerMultiprocessor(&per_cu, (const void*)fwd_megakernel, 512, LDS_BYTES) != hipSuccess || per_cu < 1) { fprintf(stderr, "kernel_launch: occupancy query failed (%d)\n", per_cu); grid_blocks = -1; return; }
        grid_blocks = cus;
    }
    if (grid_blocks < 0) return;
    (void)hipMemsetAsync((unsigned char*)d_ws + WS_SSQ, 0, (WS_BAR - WS_SSQ) + XCD_BAR_WORDS * 4, stream);
    Ptrs p{};
    for (int i = 0; i < 24; ++i) p.in[i] = (const float*)d_in[i];
    p.out = (float*)d_out; p.ws = (unsigned char*)d_ws;
    void* args[] = {&p};
    hipError_t e = hipLaunchCooperativeKernel((const void*)fwd_megakernel, dim3(grid_blocks), dim3(512), args, LDS_BYTES, stream);
    if (e != hipSuccess) fprintf(stderr, "cooperative launch failed: %s (grid %d)\n", hipGetErrorString(e), grid_blocks);
}
```

```cpp
#include <hip/hip_runtime.h>
#include <hip/hip_cooperative_groups.h>
#include <cstdio>
#include <cstdint>
namespace cg = cooperative_groups;

#define LAS __attribute__((address_space(3)))
#define DI __device__ __forceinline__
typedef unsigned short bf16_t;
typedef short bf16x8 __attribute__((ext_vector_type(8)));
typedef short s16x4 __attribute__((ext_vector_type(4)));
typedef float f32x2 __attribute__((ext_vector_type(2)));
typedef float f32x4 __attribute__((ext_vector_type(4)));
typedef float f32x16 __attribute__((ext_vector_type(16)));
typedef unsigned u32x4 __attribute__((ext_vector_type(4)));
typedef unsigned u32x2 __attribute__((ext_vector_type(2)));
typedef __bf16 bf2_t __attribute__((ext_vector_type(2)));

constexpr int DM = 2048, NBATCH = 4, SEQ = 2048, CTXL = 256, NKEY = SEQ + CTXL;
constexpr int ML = NBATCH * SEQ, MC = NBATCH * CTXL, MT = ML + MC;
constexpr int INW = 3776, INWP = 3840, QRANK = 384, KVRANK = 256, DFF = 5632, NMODC = 6 * DM;
constexpr float EPS = 1e-6f;
constexpr size_t MiB = 1024 * 1024;
constexpr size_t WS_WIN = 0, WS_WUQ = 15 * MiB, WS_WUKV = 17 * MiB, WS_WO = 18 * MiB, WS_WUP = 26 * MiB, WS_WDN = 70 * MiB;
constexpr size_t WS_SMALL = 92 * MiB, WS_MOD = WS_SMALL, WS_ROPE = WS_SMALL + 256 * 1024, WS_SSQ = WS_SMALL + 512 * 1024;
constexpr size_t SSQ_BYTES = (size_t)(ML + MT) * 4;
constexpr size_t WS_BAR = WS_SSQ + 72 * 1024;
constexpr size_t WS_X1 = 93 * MiB, WS_H = 157 * MiB, WS_O1 = WS_H, WS_T = 193 * MiB;
constexpr size_t WS_QDA = WS_T, WS_KDA = WS_T + 16 * MiB, WS_VDA = WS_T + 34 * MiB, WS_CQ = WS_T + 52 * MiB, WS_CKV = WS_T + 58 * MiB,
                 WS_KR = WS_T + 63 * MiB, WS_QMLA = WS_T + 65 * MiB, WS_KVM = WS_T + 89 * MiB, WS_MRG = WS_T + 125 * MiB;
constexpr size_t WS_GS = WS_T, WS_US = WS_T + 12 * MiB, WS_U = WS_T + 88 * MiB, WS_END = WS_T + 176 * MiB;
constexpr int LDS_MAIN = 139264, LDS_BYTES = LDS_MAIN + 64;
#ifndef PROBE_DUP
#define PROBE_DUP -1
#endif

DI unsigned pk2(float lo, float hi) { f32x2 v = {lo, hi}; bf2_t b = __builtin_convertvector(v, bf2_t); return __builtin_bit_cast(unsigned, b); }
DI float bflo(unsigned u) { return __builtin_bit_cast(float, u << 16); }
DI float bfhi(unsigned u) { return __builtin_bit_cast(float, u & 0xffff0000u); }
DI int tid_fresh() { int t = threadIdx.x; asm volatile("" : "+v"(t)); return t; }
DI float wave_sum(float v) {
#pragma unroll
    for (int o = 1; o < 64; o <<= 1) v += __shfl_xor(v, o);
    return v;
}

namespace pg8 {
constexpr int BM = 256, BK = 64, HALF = 128, HTB = HALF * BK * 2, STAGE_BYTES = 8 * HTB, NXCD = 8, WGM = 8;
DI int lds_byte(int r, int c) { const int st = (r >> 4) * 2 + (c >> 5), rr = r & 15, cc = c & 31, ob = rr * 64 + cc * 2; return st * 1024 + (ob ^ (((ob >> 9) & 1) << 5)); }
DI void stage_rc(int b, int& R, int& C) { const int st = b / 1024, sb = b % 1024, swz = sb ^ (((sb >> 9) & 1) << 5); R = (st >> 1) * 16 + swz / 64; C = (st & 1) * 32 + (swz % 64) / 2; }
DI int perm32(int rho) { const int n = rho >> 4, i = rho & 15; return 8 * (i >> 2) + 4 * n + (i & 3); }
struct Unit { int pm, pn; };
struct Gemm { const bf16_t* A; const bf16_t* Bt; int M, N, K; };
struct StaticOrder {
    int nM, nN, nwg, G, c;
    DI void init(int M, int N, int G_, int c_) { nM = M / BM; nN = N / BM; nwg = nM * nN; G = G_; c = c_; }
    DI bool next(int i, Unit& u) const {
        const long L = (long)i * G + c; if (L >= nwg) return false;
        int wgid = (int)L; { const int q = nwg / NXCD, r = nwg % NXCD, xcd = wgid % NXCD, off = wgid / NXCD; wgid = (xcd < r ? xcd * (q + 1) : r * (q + 1) + (xcd - r) * q) + off; }
        const int nig = WGM * nN, gid = wgid / nig, fm = gid * WGM, gsz = (nM - fm) < WGM ? (nM - fm) : WGM;
        u.pm = fm + ((wgid % nig) % gsz); u.pn = (wgid % nig) / gsz; return true;
    }
};

template <class Epi, class Sched, bool ALIGN_EPI>
DI void gemm_phase(LAS unsigned char* lds, const Gemm g, const Sched& S, const Epi& E) {
    const int tid = tid_fresh(), wid = __builtin_amdgcn_readfirstlane(tid >> 6), lane = tid & 63, wr = wid >> 2, wc = wid & 3, fr = lane & 15, fq = lane >> 4;
    const int K = g.K, nt = K / BK;
    unsigned voffA[2], voffB[2];
#pragma unroll
    for (int i = 0; i < 2; ++i) { int R, C; stage_rc(tid * 16 + i * 8192, R, C); const int Rb = Epi::PERM ? ((R & ~31) + perm32(R & 31)) : R;
        voffA[i] = (unsigned)(R * K + C) * 2u; voffB[i] = (unsigned)(Rb * K + C) * 2u; }
    const size_t kstep = (size_t)(BK * 2);
    const size_t hstep = (size_t)HALF * K * 2;
    const size_t tstep = 2 * hstep;
    const unsigned ldsw = (unsigned)wid * 1024u;
    const int aoff = lds_byte(wr * 64 + fr, fq * 8), boff = lds_byte(wc * 32 + fr, fq * 8);
#define PG8_SA(b, h) (((b) * 2 + (h)) * HTB)
#define PG8_SB(b, h) ((4 + (b) * 2 + (h)) * HTB)
#define PG8_STAGE(bufoff, gbase, voff) do { _Pragma("unroll") for (int _i = 0; _i < 2; ++_i) \
        __builtin_amdgcn_global_load_lds((const unsigned*)((const char*)(gbase) + (voff)[_i]), (LAS unsigned*)(lds + (bufoff) + ldsw + _i * 8192), 16, 0, 0); } while (0)
#define PG8_LDA(dst, b, h) do { _Pragma("unroll") for (int m = 0; m < 4; ++m) _Pragma("unroll") for (int k = 0; k < 2; ++k) dst[m][k] = *(const LAS bf16x8*)(lds + PG8_SA(b, h) + aoff + m * 2048 + k * 1024); } while (0)
#define PG8_LDB(dst, b, h) do { _Pragma("unroll") for (int n = 0; n < 2; ++n) _Pragma("unroll") for (int k = 0; k < 2; ++k) dst[n][k] = *(const LAS bf16x8*)(lds + PG8_SB(b, h) + boff + n * 2048 + k * 1024); } while (0)
#define PG8_MMA(ai, bj, At, Bt) do { __builtin_amdgcn_s_setprio(1); _Pragma("unroll") for (int m = 0; m < 4; ++m) _Pragma("unroll") for (int n = 0; n < 2; ++n) _Pragma("unroll") for (int k = 0; k < 2; ++k) \
        acc[ai][bj][m][n] = __builtin_amdgcn_mfma_f32_16x16x32_bf16(Bt[n][k], At[m][k], acc[ai][bj][m][n], 0, 0, 0); __builtin_amdgcn_s_setprio(0); } while (0)
#define PG8_WAIT_V(n) asm volatile("s_waitcnt vmcnt(" #n ")" ::: "memory")
#define PG8_WAIT_L(n) asm volatile("s_waitcnt lgkmcnt(" #n ")" ::: "memory")
#define PG8_BAR __builtin_amdgcn_s_barrier()
#define PG8_SCHED __builtin_amdgcn_sched_barrier(0)
    Unit cur, nxt; int ui = 0;
    if (!S.next(0, cur)) return;
    f32x4 acc[2][2][4][2];
#pragma unroll
    for (int a = 0; a < 2; ++a)
#pragma unroll
        for (int b = 0; b < 2; ++b)
#pragma unroll
            for (int m = 0; m < 4; ++m)
#pragma unroll
                for (int n = 0; n < 2; ++n) acc[a][b][m][n] = (f32x4){0.f, 0.f, 0.f, 0.f};
    bf16x8 At[4][2], B0[2][2], B1[2][2];
    const char* cA = (const char*)g.A + (size_t)cur.pm * tstep; const char* cB = (const char*)g.Bt + (size_t)cur.pn * tstep;
    PG8_STAGE(PG8_SB(0, 0), cB, voffB); PG8_STAGE(PG8_SB(0, 1), cB + hstep, voffB); PG8_STAGE(PG8_SA(0, 0), cA, voffA); PG8_STAGE(PG8_SA(0, 1), cA + hstep, voffA);
    if (wr == 1) PG8_BAR;
    PG8_WAIT_V(2); PG8_BAR;
    PG8_STAGE(PG8_SB(1, 0), cB + kstep, voffB); PG8_STAGE(PG8_SA(1, 0), cA + kstep, voffA); PG8_STAGE(PG8_SB(1, 1), cB + hstep + kstep, voffB);
    PG8_WAIT_V(6); PG8_BAR;
    for (;;) {
        const bool has_next = S.next(ui + 1, nxt);
        const char* nA = has_next ? (const char*)g.A + (size_t)nxt.pm * tstep : cA; const char* nB = has_next ? (const char*)g.Bt + (size_t)nxt.pn * tstep : cB;
#pragma unroll 1
        for (int t = 0; t < nt; t += 2) {
            const bool last = (t == nt - 2);
            const char* a1 = cA + (size_t)(t + 1) * kstep;
            const char* a2 = last ? nA : cA + (size_t)(t + 2) * kstep; const char* b2 = last ? nB : cB + (size_t)(t + 2) * kstep;
            const char* a3 = a2 + kstep; const char* b3 = b2 + kstep;
            PG8_LDB(B0, 0, 0); PG8_LDB(B1, 0, 1); PG8_SCHED; PG8_LDA(At, 0, 0); PG8_STAGE(PG8_SA(1, 1), a1 + hstep, voffA);
            PG8_WAIT_V(8); PG8_WAIT_L(0); PG8_BAR; PG8_MMA(0, 0, At, B0); PG8_MMA(0, 1, At, B1); PG8_BAR; PG8_SCHED;
            PG8_LDA(At, 0, 1); PG8_STAGE(PG8_SB(0, 0), b2, voffB); PG8_STAGE(PG8_SB(0, 1), b2 + hstep, voffB); PG8_STAGE(PG8_SA(0, 0), a2, voffA);
            PG8_WAIT_V(8); PG8_WAIT_L(0); PG8_BAR; PG8_MMA(1, 0, At, B0); PG8_MMA(1, 1, At, B1); PG8_BAR; PG8_SCHED;
            PG8_LDB(B0, 1, 0); PG8_LDB(B1, 1, 1); PG8_SCHED; PG8_LDA(At, 1, 0); PG8_STAGE(PG8_SA(0, 1), a2 + hstep, voffA);
            PG8_WAIT_V(8); PG8_WAIT_L(0); PG8_BAR; PG8_MMA(0, 0, At, B0); PG8_MMA(0, 1, At, B1); PG8_BAR; PG8_SCHED;
            PG8_LDA(At, 1, 1); PG8_STAGE(PG8_SB(1, 0), b3, voffB); PG8_STAGE(PG8_SB(1, 1), b3 + hstep, voffB); PG8_STAGE(PG8_SA(1, 0), a3, voffA);
            PG8_WAIT_V(8); PG8_WAIT_L(0); PG8_BAR; PG8_MMA(1, 0, At, B0); PG8_MMA(1, 1, At, B1); PG8_BAR; PG8_SCHED;
        }
        if constexpr (ALIGN_EPI) { if (wr == 0) PG8_BAR; }
        E(acc, cur, wr, wc, fr, fq);
        if (!has_next) break;
#pragma unroll
        for (int a = 0; a < 2; ++a)
#pragma unroll
            for (int b = 0; b < 2; ++b)
#pragma unroll
                for (int m = 0; m < 4; ++m)
#pragma unroll
                    for (int n = 0; n < 2; ++n) acc[a][b][m][n] = (f32x4){0.f, 0.f, 0.f, 0.f};
        cur = nxt; cA = nA; cB = nB; ++ui;
        if constexpr (ALIGN_EPI) { if (wr == 1) PG8_BAR; }
    }
    PG8_WAIT_V(0);
    if constexpr (!ALIGN_EPI) { if (wr == 0) PG8_BAR; }
    PG8_BAR;
#undef PG8_SA
#undef PG8_SB
#undef PG8_STAGE
#undef PG8_LDA
#undef PG8_LDB
#undef PG8_MMA
#undef PG8_WAIT_V
#undef PG8_WAIT_L
#undef PG8_BAR
#undef PG8_SCHED
}
}
using pg8::Unit;

DI void rope4(f32x4& v0, f32x4& v1, const f32x2* rp) {
#pragma unroll
    for (int j = 0; j < 4; ++j) { const f32x2 cs = rp[j]; const float x1 = v0[j], x2 = v1[j]; v0[j] = x1 * cs.x - x2 * cs.y; v1[j] = x2 * cs.x + x1 * cs.y; }
}
DI void store_bf16_pair(bf16_t* dst, int fq, const f32x4& v0, const f32x4& v1) {
    u32x2 w0, w1; w0.x = pk2(v0[0], v0[1]); w0.y = pk2(v0[2], v0[3]); w1.x = pk2(v1[0], v1[1]); w1.y = pk2(v1[2], v1[3]);
    *(u32x2*)(dst + 4 * fq) = w0; *(u32x2*)(dst + 16 + 4 * fq) = w1;
}

struct EpiIn {
    static constexpr bool PERM = false;
    bf16_t *qda, *kda, *vda, *cq, *ckv, *kr; float *ssq_q, *ssq_kv; const f32x2* rope; bool do_ssq;
    DI void operator()(const f32x4 (&acc)[2][2][4][2], const Unit& u, int wr, int wc, int fr, int fq) const {
        const bool latent = u.pm < 32;
#pragma unroll
        for (int bj = 0; bj < 2; ++bj) {
            const int cb = u.pn * 256 + bj * 128 + wc * 32;
            if (cb >= INW) continue;
            if (cb < 1024 && !latent) continue;
            const bool is_cq = (cb >= 3072 && cb < 3456), is_ckv = (cb >= 3456 && cb < 3712);
            if (is_cq && !latent) continue;
            const bool do_rope = latent && (cb < 2048 || cb >= 3712);
            const bool colpart = (cb >> 5) & 1;
#pragma unroll
            for (int ai = 0; ai < 2; ++ai)
#pragma unroll
                for (int m = 0; m < 4; ++m) {
                    const int row = u.pm * 256 + ai * 128 + wr * 64 + m * 16 + fr;
                    f32x4 v0 = acc[ai][bj][m][0], v1 = acc[ai][bj][m][1];
                    int b, t; if (latent) { b = row >> 11; t = row & 2047; } else { b = (row - ML) >> 8; t = (row - ML) & 255; }
                    const int keyrow = b * NKEY + (latent ? CTXL + t : t);
                    if (do_rope) { const int pos = colpart ? (t & 63) : (t >> 6); rope4(v0, v1, rope + pos * 16 + 4 * fq); }
                    if ((is_cq || is_ckv) && do_ssq) {
                        float s = (v0[0] * v0[0] + v0[1] * v0[1]) + (v0[2] * v0[2] + v0[3] * v0[3]) + (v1[0] * v1[0] + v1[1] * v1[1]) + (v1[2] * v1[2] + v1[3] * v1[3]);
                        s += __shfl_xor(s, 16); s += __shfl_xor(s, 32);
                        if (fq == 0) atomicAdd((is_cq ? ssq_q : ssq_kv) + row, s);
                    }
                    bf16_t* dst;
                    if (cb < 1024) dst = qda + (size_t)row * 1024 + cb;
                    else if (cb < 2048) dst = kda + (size_t)keyrow * 1024 + (cb - 1024);
                    else if (cb < 3072) dst = vda + (size_t)keyrow * 1024 + (cb - 2048);
                    else if (cb < 3456) dst = cq + (size_t)row * QRANK + (cb - 3072);
                    else if (cb < 3712) dst = ckv + (size_t)row * KVRANK + (cb - 3456);
                    else dst = kr + (size_t)keyrow * 64 + (cb - 3712);
                    store_bf16_pair(dst, fq, v0, v1);
                    asm volatile("" ::: "memory");
                }
        }
    }
};
struct EpiQmla {
    static constexpr bool PERM = false;
    bf16_t* qmla; const float* ssq_q; const f32x2* rope;
    DI void operator()(const f32x4 (&acc)[2][2][4][2], const Unit& u, int wr, int wc, int fr, int fq) const {
#pragma unroll
        for (int bj = 0; bj < 2; ++bj) {
            const int cb = u.pn * 256 + bj * 128 + wc * 32;
            const int gi = (cb >> 5) % 6;
#pragma unroll
            for (int ai = 0; ai < 2; ++ai)
#pragma unroll
                for (int m = 0; m < 4; ++m) {
                    const int row = u.pm * 256 + ai * 128 + wr * 64 + m * 16 + fr;
                    const float rstd = rsqrtf(ssq_q[row] * (1.0f / QRANK) + EPS);
                    f32x4 v0 = acc[ai][bj][m][0] * rstd, v1 = acc[ai][bj][m][1] * rstd;
                    if (gi >= 4) { const int t = row & 2047; const int pos = (gi == 5) ? (t & 63) : (t >> 6); rope4(v0, v1, rope + pos * 16 + 4 * fq); }
                    store_bf16_pair(qmla + (size_t)row * 1536 + cb, fq, v0, v1);
                    asm volatile("" ::: "memory");
                }
        }
    }
};
struct EpiKv {
    static constexpr bool PERM = false;
    bf16_t* kvm; const float* ssq_kv;
    DI void operator()(const f32x4 (&acc)[2][2][4][2], const Unit& u, int wr, int wc, int fr, int fq) const {
        const bool latent = u.pm < 32;
#pragma unroll
        for (int bj = 0; bj < 2; ++bj) {
            const int cb = u.pn * 256 + bj * 128 + wc * 32;
#pragma unroll
            for (int ai = 0; ai < 2; ++ai)
#pragma unroll
                for (int m = 0; m < 4; ++m) {
                    const int row = u.pm * 256 + ai * 128 + wr * 64 + m * 16 + fr;
                    const float rstd = rsqrtf(ssq_kv[row] * (1.0f / KVRANK) + EPS);
                    int b, t; if (latent) { b = row >> 11; t = row & 2047; } else { b = (row - ML) >> 8; t = (row - ML) & 255; }
                    const int keyrow = b * NKEY + (latent ? CTXL + t : t);
                    const f32x4 v0 = acc[ai][bj][m][0] * rstd, v1 = acc[ai][bj][m][1] * rstd;
                    store_bf16_pair(kvm + (size_t)keyrow * 2048 + cb, fq, v0, v1);
                    asm volatile("" ::: "memory");
                }
        }
    }
};
struct EpiRes {
    static constexpr bool PERM = false;
    const float* base; const float* gate; float* out;
    DI void operator()(const f32x4 (&acc)[2][2][4][2], const Unit& u, int wr, int wc, int fr, int fq) const {
        const int b = u.pm >> 3;
#pragma unroll
        for (int bj = 0; bj < 2; ++bj)
#pragma unroll
            for (int n = 0; n < 2; ++n) {
                const int col = u.pn * 256 + bj * 128 + wc * 32 + n * 16 + 4 * fq;
                const f32x4 gv = *(const f32x4*)(gate + (size_t)b * NMODC + col);
#pragma unroll
                for (int ai = 0; ai < 2; ++ai)
#pragma unroll
                    for (int m = 0; m < 4; ++m) {
                        const int row = u.pm * 256 + ai * 128 + wr * 64 + m * 16 + fr;
                        const size_t off = (size_t)row * DM + col;
                        const f32x4 bs = *(const f32x4*)(base + off);
                        *(f32x4*)(out + off) = bs + gv * acc[ai][bj][m][n];
                    }
            }
    }
};
struct EpiUpAct {
    static constexpr bool PERM = false;
    bf16_t* act; float* gs; float* us; const float* conv_w; const float* conv_b;
    DI void operator()(const f32x4 (&acc)[2][2][4][2], const Unit& u, int wr, int wc, int fr, int fq) const {
        const int lane = fq * 16 + fr;
        const int up_src = (fr > 0) ? lane - 1 : lane + 15, dn_src = (fr < 15) ? lane + 1 : lane - 15;
#pragma unroll
        for (int n = 0; n < 2; ++n) {
            const int f = u.pn * 128 + wc * 32 + n * 16 + 4 * fq;
            const f32x4 w0 = *(const f32x4*)(conv_w + f), w1 = *(const f32x4*)(conv_w + DFF + f), w2 = *(const f32x4*)(conv_w + 2 * DFF + f), bb = *(const f32x4*)(conv_b + f);
#pragma unroll
            for (int ai = 0; ai < 2; ++ai) {
                const int base = u.pm * 256 + ai * 128 + wr * 64, span = base >> 6;
                f32x4 tu[4], td[4];
#pragma unroll
                for (int m = 0; m < 4; ++m)
#pragma unroll
                    for (int j = 0; j < 4; ++j) { tu[m][j] = __shfl(acc[ai][0][m][n][j], up_src); td[m][j] = __shfl(acc[ai][0][m][n][j], dn_src); }
#pragma unroll
                for (int m = 0; m < 4; ++m) {
                    const f32x4 g = acc[ai][0][m][n], uu = acc[ai][1][m][n];
                    const f32x4 zero = {0.f, 0.f, 0.f, 0.f};
                    const f32x4 upv = (fr == 0) ? (m > 0 ? tu[m > 0 ? m - 1 : 0] : zero) : tu[m];
                    const f32x4 dnv = (fr == 15) ? (m < 3 ? td[m < 3 ? m + 1 : 3] : zero) : td[m];
                    const f32x4 z = w0 * upv + w1 * g + w2 * dnv + bb;
                    f32x4 a;
#pragma unroll
                    for (int j = 0; j < 4; ++j) a[j] = z[j] * __builtin_amdgcn_rcpf(1.0f + __expf(-z[j])) * uu[j];
                    const bool edge = (m == 0 && fr == 0) || (m == 3 && fr == 15);
                    if (!edge) { u32x2 pw; pw.x = pk2(a[0], a[1]); pw.y = pk2(a[2], a[3]); *(u32x2*)(act + (size_t)(base + 16 * m + fr) * DFF + f) = pw; }
                }
                if (fr < 2) *(f32x4*)(gs + (size_t)(span * 4 + fr) * DFF + f) = acc[ai][0][0][n];
                if (fr >= 14) *(f32x4*)(gs + (size_t)(span * 4 + 2 + (fr - 14)) * DFF + f) = acc[ai][0][3][n];
                if (fr == 0) *(f32x4*)(us + (size_t)(span * 2) * DFF + f) = acc[ai][1][0][n];
                if (fr == 15) *(f32x4*)(us + (size_t)(span * 2 + 1) * DFF + f) = acc[ai][1][3][n];
                asm volatile("" ::: "memory");
            }
        }
    }
};

DI s16x4 tr_read(LAS const unsigned char* p) { return __builtin_bit_cast(s16x4, __builtin_amdgcn_ds_read_tr16_b64_v4i16((LAS s16x4*)p)); }

template <int DQK>
DI void attn_pass(LAS unsigned char* lds, const bf16_t* qrow, const bf16_t* K0, int ldk0, const bf16_t* K1, int ldk1, const bf16_t* V, int ldv,
                  float cexp, f32x16 (&o)[4], float& lsum_out) {
    constexpr int KST = (DQK + 8) * 2, VST = 320, KBUF = 64 * KST, VBUF = 64 * VST, NKC = DQK / 8, KCH = (64 * NKC) / 512, NKK = DQK / 16, NT = NKEY / 64;
    const int tid = tid_fresh(), lane = tid & 63, r = lane & 31, h = lane >> 5;
    bf16x8 qf[NKK];
#pragma unroll
    for (int kk = 0; kk < NKK; ++kk) qf[kk] = *(const bf16x8*)(qrow + 16 * kk + 8 * h);
#pragma unroll
    for (int d = 0; d < 4; ++d)
#pragma unroll
        for (int i = 0; i < 16; ++i) o[d][i] = 0.f;
    float mrun = -INFINITY, lsum = 0.f;
    u32x4 kreg[KCH], vreg[2];
    constexpr int NC0 = (DQK == 64) ? 8 : 16, KCH0 = (64 * NC0) / 512;
    unsigned ksrc[KCH]; int kdst[KCH];
#pragma unroll
    for (int i = 0; i < KCH; ++i) {
        if (i < KCH0) { const int ci = tid + 512 * i, key = ci / NC0, c8 = ci % NC0; ksrc[i] = (unsigned)(key * ldk0 + 8 * c8); kdst[i] = key * KST + c8 * 16; }
        else { const int key = tid >> 3, c8 = tid & 7; ksrc[i] = (unsigned)(key * ldk1 + 8 * c8); kdst[i] = key * KST + (16 + c8) * 16; }
    }
    unsigned vsrc[2]; int vdst[2];
#pragma unroll
    for (int i = 0; i < 2; ++i) { const int ci = tid + 512 * i, key = ci >> 4, c8 = ci & 15; vsrc[i] = (unsigned)(key * ldv + 8 * c8); vdst[i] = 3 * KBUF + key * VST + c8 * 16; }
#define AT_GLOAD(t) do { const bf16_t* k0t = K0 + (size_t)(t) * 64 * ldk0; const bf16_t* k1t = K1 + (size_t)(t) * 64 * ldk1; const bf16_t* vt = V + (size_t)(t) * 64 * ldv; \
                         _Pragma("unroll") for (int i = 0; i < KCH; ++i) kreg[i] = *(const u32x4*)((i < KCH0 ? k0t : k1t) + ksrc[i]); \
                         _Pragma("unroll") for (int i = 0; i < 2; ++i) vreg[i] = *(const u32x4*)(vt + vsrc[i]); } while (0)
#define AT_LSTORE(kb_, vb_) do { _Pragma("unroll") for (int i = 0; i < KCH; ++i) *(LAS u32x4*)(lds + (kb_) * KBUF + kdst[i]) = kreg[i]; \
                          _Pragma("unroll") for (int i = 0; i < 2; ++i) *(LAS u32x4*)(lds + (vb_) * VBUF + vdst[i]) = vreg[i]; } while (0)
#define AT_PV(vb_) do { _Pragma("unroll") for (int ks = 0; ks < 4; ++ks) { const bf16x8 pf = __builtin_bit_cast(bf16x8, pprev[ks]); \
            _Pragma("unroll") for (int d = 0; d < 4; ++d) { LAS const unsigned char* ap = lds + (vb_) * VBUF + voff + (16 * ks) * VST + d * 64; \
                const s16x4 lo = tr_read(ap), hi = tr_read(ap + 8 * VST); const bf16x8 vf = __builtin_shufflevector(lo, hi, 0, 1, 2, 3, 4, 5, 6, 7); \
                o[d] = __builtin_amdgcn_mfma_f32_32x32x16_bf16(vf, pf, o[d], 0, 0, 0); } } } while (0)
    const int koff = r * KST + 16 * h;
    const int i16 = lane & 15, q4 = i16 >> 2, p4 = i16 & 3, blk = (lane >> 4) & 1;
    const int voff = 3 * KBUF + (4 * h + q4) * VST + 32 * blk + 8 * p4;
    u32x4 pprev[4];
#pragma unroll
    for (int ks = 0; ks < 4; ++ks) pprev[ks] = (u32x4){0u, 0u, 0u, 0u};
    AT_GLOAD(0); AT_LSTORE(0, 0);
#pragma unroll
    for (int kk = 0; kk < NKK; ++kk) asm volatile("" :: "v"(qf[kk]));
    AT_GLOAD(1); __syncthreads();
    int vb_prev = 2, vb_cur = 0, vb_next = 1;
#pragma unroll 1
    for (int t = 0; t < NT; ++t) {
        const int b = vb_cur;
        if (t + 1 < NT) AT_LSTORE(vb_next, vb_next);
        if (t + 2 < NT) AT_GLOAD(t + 2);
        f32x16 st[2];
#pragma unroll
        for (int kb = 0; kb < 2; ++kb) {
#pragma unroll
            for (int i = 0; i < 16; ++i) st[kb][i] = 0.f;
#pragma unroll
            for (int kk = 0; kk < NKK; ++kk) {
                const bf16x8 kf = *(const LAS bf16x8*)(lds + b * KBUF + kb * 32 * KST + koff + 32 * kk);
                st[kb] = __builtin_amdgcn_mfma_f32_32x32x16_bf16(kf, qf[kk], st[kb], 0, 0, 0);
            }
        }
#pragma unroll
        for (int i = 0; i < 4; ++i) __builtin_amdgcn_sched_group_barrier(0x100, 1, 0);
#pragma unroll
        for (int i = 0; i < 2 * NKK - 4; ++i) { __builtin_amdgcn_sched_group_barrier(0x008, 1, 0); __builtin_amdgcn_sched_group_barrier(0x100, 1, 0); }
#pragma unroll
        for (int i = 0; i < 4; ++i) __builtin_amdgcn_sched_group_barrier(0x008, 1, 0);
        __builtin_amdgcn_sched_barrier(0);
        { const int vslot = (t == 0) ? 0 : vb_prev; AT_PV(vslot); }
        __builtin_amdgcn_sched_group_barrier(0x100, 8, 1);
#pragma unroll
        for (int i = 0; i < 12; ++i) { __builtin_amdgcn_sched_group_barrier(0x008, 1, 1); __builtin_amdgcn_sched_group_barrier(0x100, 2, 1); }
        __builtin_amdgcn_sched_group_barrier(0x008, 4, 1);
        __builtin_amdgcn_sched_barrier(0);
        float mx = st[0][0];
#pragma unroll
        for (int kb = 0; kb < 2; ++kb)
#pragma unroll
            for (int i = 0; i < 16; ++i) mx = fmaxf(mx, st[kb][i]);
        mx = fmaxf(mx, __shfl_xor(mx, 32)) * cexp;
        if (__builtin_amdgcn_ballot_w64(mx > mrun + 8.0f) != 0ull) {
            const float mn = fmaxf(mrun, mx);
            const float alpha = __builtin_amdgcn_exp2f(mrun - mn);
            lsum *= alpha; mrun = mn;
#pragma unroll
            for (int d = 0; d < 4; ++d)
#pragma unroll
                for (int i = 0; i < 16; ++i) o[d][i] *= alpha;
        }
        float ps = 0.f;
#pragma unroll
        for (int kb = 0; kb < 2; ++kb)
#pragma unroll
            for (int i = 0; i < 16; ++i) { const float pv = __builtin_amdgcn_exp2f(st[kb][i] * cexp - mrun); st[kb][i] = pv; ps += pv; }
        lsum += ps;
#pragma unroll
        for (int ks = 0; ks < 4; ++ks) {
            const int kb = ks >> 1, s = ks & 1;
            pprev[ks].x = pk2(st[kb][8 * s + 0], st[kb][8 * s + 1]); pprev[ks].y = pk2(st[kb][8 * s + 2], st[kb][8 * s + 3]);
            pprev[ks].z = pk2(st[kb][8 * s + 4], st[kb][8 * s + 5]); pprev[ks].w = pk2(st[kb][8 * s + 6], st[kb][8 * s + 7]);
        }
        __syncthreads();
        { const int tmp = vb_prev; vb_prev = vb_cur; vb_cur = vb_next; vb_next = tmp; }
    }
    AT_PV(vb_prev);
    __syncthreads();
#undef AT_GLOAD
#undef AT_LSTORE
#undef AT_PV
    lsum += __shfl_xor(lsum, 32);
    lsum_out = lsum;
}

struct Ptrs {
    const float* in[24]; float* out; unsigned char* ws;
};

DI void attention_phase(LAS unsigned char* lds, const Ptrs& P) {
    const int tid = threadIdx.x, lane = tid & 63, wave = tid >> 6, r = lane & 31, h = lane >> 5;
    unsigned char* ws = P.ws;
    const bf16_t* QDA = (const bf16_t*)(ws + WS_QDA); const bf16_t* KDA = (const bf16_t*)(ws + WS_KDA); const bf16_t* VDA = (const bf16_t*)(ws + WS_VDA);
    const bf16_t* QMLA = (const bf16_t*)(ws + WS_QMLA); const bf16_t* KVM = (const bf16_t*)(ws + WS_KVM); const bf16_t* KR = (const bf16_t*)(ws + WS_KR);
    bf16_t* MRG = (bf16_t*)(ws + WS_MRG);
    float* O1 = (float*)(ws + WS_O1) + (size_t)blockIdx.x * (16 * 512 * 4);
    const float LOG2E = 1.4426950408889634f;
    float lam;
    { const float s1 = wave_sum(P.in[12][lane] * P.in[13][lane]), s2 = wave_sum(P.in[14][lane] * P.in[15][lane]); lam = expf(s1) - expf(s2) + 0.2f; }
    const float* subln = P.in[16];
    for (int it = blockIdx.x; it < 256; it += gridDim.x) {
        const int b = it >> 6, hd = (it >> 3) & 7, qb = it & 7;
        const int qr = b * SEQ + qb * 256 + wave * 32 + r;
        f32x16 o[4]; float l;
        const bf16_t* qrow = QDA + (size_t)qr * 1024 + hd * 128;
        const bf16_t* Kb = KDA + (size_t)b * NKEY * 1024 + hd * 128;
        const bf16_t* Vb = VDA + (size_t)b * NKEY * 1024 + hd * 128;
        const float c = 0.125f * LOG2E;
        attn_pass<64>(lds, qrow, Kb, 1024, Kb, 1024, Vb, 1024, c, o, l);
        { const float inv = 1.0f / l;
#pragma unroll
          for (int d = 0; d < 4; ++d)
#pragma unroll
              for (int g = 0; g < 4; ++g) { f32x4 v = {o[d][4 * g] * inv, o[d][4 * g + 1] * inv, o[d][4 * g + 2] * inv, o[d][4 * g + 3] * inv};
                  *(f32x4*)(O1 + ((size_t)(d * 4 + g) * 512 + tid) * 4) = v; } }
        attn_pass<64>(lds, qrow + 64, Kb + 64, 1024, Kb + 64, 1024, Vb, 1024, c, o, l);
        const float inv2 = lam / l;
        float ss = 0.f;
#pragma unroll
        for (int d = 0; d < 4; ++d) {
#pragma unroll
            for (int g = 0; g < 4; ++g) { const f32x4 v1 = *(const f32x4*)(O1 + ((size_t)(d * 4 + g) * 512 + tid) * 4);
#pragma unroll
                for (int j = 0; j < 4; ++j) { const float v = v1[j] - o[d][4 * g + j] * inv2; o[d][4 * g + j] = v; ss += v * v; } }
            asm volatile("" ::: "memory");
        }
        ss += __shfl_xor(ss, 32);
        const float rs = rsqrtf(ss * (1.0f / 128.0f) + EPS) * 0.8f;
        bf16_t* orow = MRG + (size_t)qr * 2048 + hd * 128;
#pragma unroll
        for (int d = 0; d < 4; ++d) {
#pragma unroll
            for (int g = 0; g < 4; ++g) { const int dv = 32 * d + 8 * g + 4 * h; const f32x4 w = *(const f32x4*)(subln + dv);
                u32x2 pw; pw.x = pk2(o[d][4 * g] * rs * w[0], o[d][4 * g + 1] * rs * w[1]); pw.y = pk2(o[d][4 * g + 2] * rs * w[2], o[d][4 * g + 3] * rs * w[3]);
                *(u32x2*)(orow + dv) = pw; }
            asm volatile("" ::: "memory");
        }
    }
}
DI void attention_mla_phase(LAS unsigned char* lds, const Ptrs& P) {
    const int tid = threadIdx.x, lane = tid & 63, wave = tid >> 6, r = lane & 31, h = lane >> 5;
    unsigned char* ws = P.ws;
    const bf16_t* QMLA = (const bf16_t*)(ws + WS_QMLA); const bf16_t* KVM = (const bf16_t*)(ws + WS_KVM); const bf16_t* KR = (const bf16_t*)(ws + WS_KR);
    bf16_t* MRG = (bf16_t*)(ws + WS_MRG);
    const float LOG2E = 1.4426950408889634f;
    (void)tid;
    for (int it = blockIdx.x; it < 256; it += gridDim.x) {
        const int b = it >> 6, hd = (it >> 3) & 7, qb = it & 7;
        const int qr = b * SEQ + qb * 256 + wave * 32 + r;
        f32x16 o[4]; float l;
        const bf16_t* qrow = QMLA + (size_t)qr * 1536 + hd * 192;
        const bf16_t* Kb = KVM + (size_t)b * NKEY * 2048 + hd * 256;
        const bf16_t* Krp = KR + (size_t)b * NKEY * 64;
        const float c = 0.07216878364870323f * LOG2E;
        attn_pass<192>(lds, qrow, Kb, 2048, Krp, 64, Kb + 128, 2048, c, o, l);
        const float inv = 1.0f / l;
        bf16_t* orow = MRG + (size_t)qr * 2048 + 1024 + hd * 128;
#pragma unroll
        for (int d = 0; d < 4; ++d)
#pragma unroll
            for (int g = 0; g < 4; ++g) { const int dv = 32 * d + 8 * g + 4 * h;
                u32x2 pw; pw.x = pk2(o[d][4 * g] * inv, o[d][4 * g + 1] * inv); pw.y = pk2(o[d][4 * g + 2] * inv, o[d][4 * g + 3] * inv);
                *(u32x2*)(orow + dv) = pw; }
    }
}

DI void ada_unit(LAS unsigned char* lds, const Ptrs& P, int u) {
    const int tid = threadIdx.x, lane = tid & 63, wave = tid >> 6;
    LAS float* sc = (LAS float*)lds; LAS float* red = (LAS float*)(lds + 40960);
    const float* c = P.in[1]; const float* cc = P.in[3]; const float* w_ada = P.in[4]; const float* b_ada = P.in[5];
    float* MOD = (float*)(P.ws + WS_MOD);
    for (int idx = tid; idx < 5 * DM; idx += 512) { const float v = idx < 4 * DM ? c[idx] : cc[idx - 4 * DM]; sc[idx] = v / (1.0f + __expf(-v)); }
    __syncthreads();
    const int cgp = tid & 15, rg = tid >> 4;
    float acc[5][4];
#pragma unroll
    for (int rr = 0; rr < 5; ++rr)
#pragma unroll
        for (int j = 0; j < 4; ++j) acc[rr][j] = 0.f;
    const float* wp = w_ada + (size_t)rg * NMODC + 64 * u + 4 * cgp;
#pragma unroll 8
    for (int i = 0; i < 64; ++i) {
        const f32x4 w = *(const f32x4*)(wp + (size_t)i * 32 * NMODC);
        const int k = rg + 32 * i;
#pragma unroll
        for (int rr = 0; rr < 5; ++rr) { const float s = sc[rr * DM + k];
#pragma unroll
            for (int j = 0; j < 4; ++j) acc[rr][j] += s * w[j]; }
    }
#pragma unroll
    for (int rr = 0; rr < 5; ++rr)
#pragma unroll
        for (int j = 0; j < 4; ++j) { float a = acc[rr][j]; a += __shfl_xor(a, 16); a += __shfl_xor(a, 32); if (lane < 16) red[(wave * 16 + lane) * 20 + rr * 4 + j] = a; }
    __syncthreads();
    if (tid < 320) { const int cg2 = tid / 20, rj = tid % 20, rr = rj >> 2, j = rj & 3; float s = 0.f;
#pragma unroll
        for (int w = 0; w < 8; ++w) s += red[(w * 16 + cg2) * 20 + rj];
        const int col = 64 * u + 4 * cg2 + j; MOD[(size_t)rr * NMODC + col] = s + b_ada[col]; }
    __syncthreads();
}

DI void transpose_unit(LAS unsigned char* lds, const float* W, int K, int N, bf16_t* Wt, int n0, int k0, const float* kscale, int n0d = -1) {
    if (n0d < 0) n0d = n0;
    const int tid = tid_fresh();
    LAS float* sf = (LAS float*)lds;
    if (n0 >= N) {
#pragma unroll
        for (int i = 0; i < 2; ++i) { const int idx = tid + 512 * i, kc = idx & 15, n = idx >> 4; *(u32x4*)(Wt + (size_t)(n0d + n) * K + k0 + 8 * kc) = (u32x4){0u, 0u, 0u, 0u}; }
        return;
    }
#pragma unroll
    for (int i = 0; i < 4; ++i) { const int idx = tid + 512 * i, kr = idx >> 4, c4 = idx & 15;
        f32x4 v = *(const f32x4*)(W + (size_t)(k0 + kr) * N + n0 + 4 * c4);
        if (kscale) v = v * kscale[k0 + kr];
#pragma unroll
        for (int j = 0; j < 4; ++j) sf[kr * 65 + 4 * c4 + j] = v[j]; }
    __syncthreads();
#pragma unroll
    for (int i = 0; i < 2; ++i) { const int idx = tid + 512 * i, kc = idx & 15, n = idx >> 4;
        float f[8];
#pragma unroll
        for (int j = 0; j < 8; ++j) f[j] = sf[(8 * kc + j) * 65 + n];
        u32x4 w; w.x = pk2(f[0], f[1]); w.y = pk2(f[2], f[3]); w.z = pk2(f[4], f[5]); w.w = pk2(f[6], f[7]);
        *(u32x4*)(Wt + (size_t)(n0d + n) * K + k0 + 8 * kc) = w; }
    __syncthreads();
}

DI void p0_phase(LAS unsigned char* lds, const Ptrs& P) {
    unsigned char* ws = P.ws;
    constexpr int U_ADA = 192, U_ROPE = 1;
    constexpr int T0 = 60 * 16, T1 = 24 * 3, T2 = 32 * 2;
    constexpr int NU = U_ADA + U_ROPE + T0 + T1 + T2;
    for (int u = blockIdx.x; u < NU; u += gridDim.x) {
        if (u < U_ADA) { ada_unit(lds, P, u); continue; }
        if (u == U_ADA) {
            f32x2* rope = (f32x2*)(ws + WS_ROPE);
            for (int idx = threadIdx.x; idx < 1024; idx += 512) { const int pos = idx >> 4, i = idx & 15;
                const double inv = pow(10000.0, -(double)i / 16.0); const double ang = (double)pos * (double)(float)inv;
                rope[idx] = (f32x2){(float)cos(ang), (float)sin(ang)}; }
            continue;
        }
        int v = u - U_ADA - U_ROPE;
        if (v < T0) { transpose_unit(lds, P.in[7], DM, INW, (bf16_t*)(ws + WS_WIN), (v % 60) * 64, (v / 60) * 128, nullptr); continue; } v -= T0;
        if (v < T1) { transpose_unit(lds, P.in[10], QRANK, 1536, (bf16_t*)(ws + WS_WUQ), (v % 24) * 64, (v / 24) * 128, P.in[8]); continue; } v -= T1;
        transpose_unit(lds, P.in[11], KVRANK, 2048, (bf16_t*)(ws + WS_WUKV), (v % 32) * 64, (v / 32) * 128, P.in[9]);
    }
}
DI void convert_wo_wup(LAS unsigned char* lds, const Ptrs& P, int idx, int nblk) {
    unsigned char* ws = P.ws;
    constexpr int T3 = 32 * 16, T4 = 176 * 16;
    for (int v = idx; v < T3 + T4; v += nblk) {
        if (v < T3) transpose_unit(lds, P.in[17], DM, DM, (bf16_t*)(ws + WS_WO), (v % 32) * 64, (v / 32) * 128, nullptr);
        else { const int w = v - T3; const int c = (w % 176) * 64; const int cc = c < DFF ? c : c - DFF; const int nd = 256 * (cc >> 7) + (cc & 127) + (c < DFF ? 0 : 128);
               transpose_unit(lds, P.in[19], DM, 2 * DFF, (bf16_t*)(ws + WS_WUP), c, (w / 176) * 128, nullptr, nd); }
    }
}
DI void convert_wdown(LAS unsigned char* lds, const Ptrs& P, int idx, int nblk) {
    constexpr int T5 = 32 * 44;
    for (int v = idx; v < T5; v += nblk) transpose_unit(lds, P.in[22], DFF, DM, (bf16_t*)(P.ws + WS_WDN), (v % 32) * 64, (v / 32) * 128, nullptr);
}

DI void norm_mod_phase(const float* X, const float* XC, int nrows, const float* nw, const float* MOD, int shift_idx, int scale_idx, bf16_t* H) {
    const int tf = tid_fresh(), lane = tf & 63, wave = tf >> 6;
    for (int row = blockIdx.x * 8 + wave; row < nrows; row += gridDim.x * 8) {
        const float* xr = row < ML ? X + (size_t)row * DM : XC + (size_t)(row - ML) * DM;
        const int mb = row < ML ? (row >> 11) : 4;
        const float* sh = MOD + (size_t)mb * NMODC + shift_idx * DM; const float* scl = MOD + (size_t)mb * NMODC + scale_idx * DM;
        f32x4 v[8]; float ss = 0.f;
#pragma unroll
        for (int i = 0; i < 8; ++i) { v[i] = *(const f32x4*)(xr + 4 * (lane + 64 * i)); ss += (v[i][0] * v[i][0] + v[i][1] * v[i][1]) + (v[i][2] * v[i][2] + v[i][3] * v[i][3]); }
        ss = wave_sum(ss);
        const float rstd = rsqrtf(ss * (1.0f / DM) + EPS);
#pragma unroll
        for (int i = 0; i < 8; ++i) { const int col = 4 * (lane + 64 * i);
            const f32x4 w = *(const f32x4*)(nw + col), s = *(const f32x4*)(scl + col), t = *(const f32x4*)(sh + col);
            const f32x4 y = (v[i] * rstd) * w * (s + 1.0f) + t;
            u32x2 pw; pw.x = pk2(y[0], y[1]); pw.y = pk2(y[2], y[3]);
            *(u32x2*)(H + (size_t)row * DM + col) = pw; }
    }
}
DI void final_norm_phase(const float* xin, float* out, const float* fw) {
    const int tf = tid_fresh(), lane = tf & 63, wave = tf >> 6;
    for (int row = blockIdx.x * 8 + wave; row < ML; row += gridDim.x * 8) {
        const float* xr = xin + (size_t)row * DM; float* orow = out + (size_t)row * DM;
        f32x4 v[8]; float ss = 0.f;
#pragma unroll
        for (int i = 0; i < 8; ++i) { v[i] = *(const f32x4*)(xr + 4 * (lane + 64 * i)); ss += (v[i][0] * v[i][0] + v[i][1] * v[i][1]) + (v[i][2] * v[i][2] + v[i][3] * v[i][3]); }
        ss = wave_sum(ss);
        const float rstd = rsqrtf(ss * (1.0f / DM) + EPS);
#pragma unroll
        for (int i = 0; i < 8; ++i) { const int col = 4 * (lane + 64 * i); const f32x4 w = *(const f32x4*)(fw + col); *(f32x4*)(orow + col) = (v[i] * rstd) * w; }
    }
}
DI void act_fixup_phase(const float* GS, const float* US, bf16_t* ACT, const float* conv_w, const float* conv_b) {
    constexpr int NF4 = DFF / 4, NSPAN = ML / 64, TOTAL = NSPAN * 2 * NF4;
    for (int item = blockIdx.x * 512 + tid_fresh(); item < TOTAL; item += gridDim.x * 512) {
        const int f = (item % NF4) * 4, sd = (item / NF4) & 1, span = item / (2 * NF4);
        const int row = span * 64 + (sd ? 63 : 0);
        const f32x4 zero = {0.f, 0.f, 0.f, 0.f};
        f32x4 up, cur, dn, uu;
        if (sd == 0) { up = (row & 2047) ? *(const f32x4*)(GS + (size_t)((span - 1) * 4 + 3) * DFF + f) : zero; cur = *(const f32x4*)(GS + (size_t)(span * 4) * DFF + f);
                       dn = *(const f32x4*)(GS + (size_t)(span * 4 + 1) * DFF + f); uu = *(const f32x4*)(US + (size_t)(span * 2) * DFF + f); }
        else { up = *(const f32x4*)(GS + (size_t)(span * 4 + 2) * DFF + f); cur = *(const f32x4*)(GS + (size_t)(span * 4 + 3) * DFF + f);
               dn = ((row & 2047) != 2047) ? *(const f32x4*)(GS + (size_t)((span + 1) * 4) * DFF + f) : zero; uu = *(const f32x4*)(US + (size_t)(span * 2 + 1) * DFF + f); }
        const f32x4 w0 = *(const f32x4*)(conv_w + f), w1 = *(const f32x4*)(conv_w + DFF + f), w2 = *(const f32x4*)(conv_w + 2 * DFF + f), bb = *(const f32x4*)(conv_b + f);
        const f32x4 z = w0 * up + w1 * cur + w2 * dn + bb;
        f32x4 a;
#pragma unroll
        for (int j = 0; j < 4; ++j) a[j] = z[j] / (1.0f + __expf(-z[j])) * uu[j];
        u32x2 pw; pw.x = pk2(a[0], a[1]); pw.y = pk2(a[2], a[3]);
        *(u32x2*)(ACT + (size_t)row * DFF + f) = pw;
    }
}

#define XB_TMO      128
#define XB_XCNT(j)  (256  + 64 * (j))
#define XB_XSUB(j)  (1280 + 64 * (j))
#define XB_XGEN(j)  (2304 + 64 * (j))
#define XB_TOP      3328
#define XB_TOPGEN   3392
#define XCD_BAR_WORDS 3456
#define XB_SPIN_CAP (1u << 22)
DI unsigned xb_ld(unsigned* p)              { return __hip_atomic_load(p, __ATOMIC_RELAXED, __HIP_MEMORY_SCOPE_AGENT); }
DI unsigned xb_add(unsigned* p, unsigned v) { return __hip_atomic_fetch_add(p, v, __ATOMIC_RELAXED, __HIP_MEMORY_SCOPE_AGENT); }
DI unsigned xb_xcc_id() { return (unsigned)__builtin_amdgcn_s_getreg((3 << 11) | 20) & 0xFu; }
#define XB_SPIN(cond, bar) do { unsigned _sp = 0; while (cond) { __builtin_amdgcn_s_sleep(1); \
    if ((++_sp & 255u) == 0u) { if (xb_ld(&(bar)[XB_TMO])) break; if (_sp > XB_SPIN_CAP) { atomicAdd(&(bar)[XB_TMO], 1u); break; } } } } while (0)
struct XcdBarrier { unsigned* bar; unsigned x; volatile LAS unsigned* st; };
DI XcdBarrier xcd_barrier_post(unsigned* bar, volatile LAS unsigned* st) {
    XcdBarrier b; b.bar = bar; b.x = xb_xcc_id(); b.st = st;
    if (threadIdx.x == 0) (void)xb_add(&bar[XB_XCNT(b.x)], 1u);
    return b;
}
DI void xcd_barrier_complete(unsigned* bar, unsigned x, unsigned& nloc, unsigned& nx) {
    const unsigned G = gridDim.x * gridDim.y * gridDim.z;
    unsigned sum, cnt, mine, sp = 0u;
    for (;;) {
        sum = 0u; cnt = 0u; mine = 0u;
#pragma unroll
        for (unsigned j = 0; j < 16; ++j) { const unsigned c = xb_ld(&bar[XB_XCNT(j)]); sum += c; cnt += (c > 0u) ? 1u : 0u; mine = (j == x) ? c : mine; }
        if (sum == G) break;
        __builtin_amdgcn_s_sleep(1);
        if ((++sp & 255u) == 0u) { if (xb_ld(&bar[XB_TMO])) break; if (sp > XB_SPIN_CAP) { atomicAdd(&bar[XB_TMO], 1u); break; } }
    }
    nloc = mine > 0u ? mine : 1u; nx = cnt > 0u ? cnt : 1u;
}
DI void xcd_barrier(const XcdBarrier& b) {
    asm volatile("s_waitcnt vmcnt(0)" ::: "memory");
    __syncthreads();
    if (threadIdx.x == 0) {
        unsigned* bar = b.bar;
        __builtin_amdgcn_s_waitcnt(0);
        unsigned nloc = b.st[0], nx = b.st[1];
        if (nloc == 0u) { xcd_barrier_complete(bar, b.x, nloc, nx); b.st[0] = nloc; b.st[1] = nx; }
        const unsigned old = xb_add(&bar[XB_XSUB(b.x)], 1u);
        const unsigned gen = old / nloc;
        if (old + 1u == (gen + 1u) * nloc) {
            __builtin_amdgcn_fence(__ATOMIC_RELEASE, "agent");
            asm volatile("s_waitcnt vmcnt(0)" ::: "memory");
            const unsigned og = xb_add(&bar[XB_TOP], 1u);
            const unsigned tg = og / nx;
            if (og + 1u == (tg + 1u) * nx) xb_add(&bar[XB_TOPGEN], 1u);
            else XB_SPIN(xb_ld(&bar[XB_TOPGEN]) == tg, bar);
            __builtin_amdgcn_fence(__ATOMIC_ACQUIRE, "agent");
            xb_add(&bar[XB_XGEN(b.x)], 1u);
            asm volatile("s_waitcnt vmcnt(0)" ::: "memory");
        } else {
            XB_SPIN(xb_ld(&bar[XB_XGEN(b.x)]) == gen, bar);
            __builtin_amdgcn_fence(__ATOMIC_ACQUIRE, "agent");
            asm volatile("s_waitcnt vmcnt(0)" ::: "memory");
        }
    }
    __syncthreads();
}

__global__ void __launch_bounds__(512, 2) fwd_megakernel(Ptrs P) {
    extern __shared__ __attribute__((aligned(16))) unsigned char lds_raw[];
    LAS unsigned char* lds = (LAS unsigned char*)lds_raw;
    cg::grid_group grid = cg::this_grid();
    if (gridDim.x == 0x7fffffffu) grid.sync();
    volatile LAS unsigned* bst = (volatile LAS unsigned*)(lds + LDS_MAIN);
    if (threadIdx.x < 4) bst[threadIdx.x] = 0u;
    __syncthreads();
    const XcdBarrier gbar = xcd_barrier_post((unsigned*)(P.ws + WS_BAR), bst);
#define GRID_SYNC() xcd_barrier(gbar)
    unsigned char* ws = P.ws;
    const int G = gridDim.x, cid = blockIdx.x;
    float* MOD = (float*)(ws + WS_MOD);
    const f32x2* ROPE = (const f32x2*)(ws + WS_ROPE);
    float* SSQQ = (float*)(ws + WS_SSQ); float* SSQKV = SSQQ + ML;
    bf16_t* H = (bf16_t*)(ws + WS_H);
    float* X1 = (float*)(ws + WS_X1);

    p0_phase(lds, P);
#if PROBE_DUP == 0
    p0_phase(lds, P);
#endif
    GRID_SYNC();
#if PROBE_DUP == 20
    for (int i_ = 0; i_ < 10; ++i_) GRID_SYNC();
#endif
    norm_mod_phase(P.in[0], P.in[2], MT, P.in[6], MOD, 0, 1, H);
#if PROBE_DUP == 1 || PROBE_DUP == 16
    norm_mod_phase(P.in[0], P.in[2], MT, P.in[6], MOD, 0, 1, H);
#endif
    GRID_SYNC();
    {
        pg8::Gemm g{H, (const bf16_t*)(ws + WS_WIN), MT, INWP, DM}; pg8::StaticOrder S; S.init(MT, INWP, G, cid);
        EpiIn E{(bf16_t*)(ws + WS_QDA), (bf16_t*)(ws + WS_KDA), (bf16_t*)(ws + WS_VDA), (bf16_t*)(ws + WS_CQ), (bf16_t*)(ws + WS_CKV), (bf16_t*)(ws + WS_KR), SSQQ, SSQKV, ROPE, true};
        pg8::gemm_phase<EpiIn, pg8::StaticOrder, true>(lds, g, S, E);
#if PROBE_DUP == 2
        E.do_ssq = false; pg8::gemm_phase<EpiIn, pg8::StaticOrder, true>(lds, g, S, E);
#endif
        { const int rem = S.nwg % G; if (rem == 0) convert_wo_wup(lds, P, cid, G); else if (cid >= rem) convert_wo_wup(lds, P, cid - rem, G - rem); }
    }
    GRID_SYNC();
    {
        pg8::Gemm g{(const bf16_t*)(ws + WS_CQ), (const bf16_t*)(ws + WS_WUQ), ML, 1536, QRANK}; pg8::StaticOrder S; S.init(ML, 1536, G, cid);
        EpiQmla E{(bf16_t*)(ws + WS_QMLA), SSQQ, ROPE};
        pg8::gemm_phase<EpiQmla, pg8::StaticOrder, true>(lds, g, S, E);
#if PROBE_DUP == 3 || PROBE_DUP == 35
        pg8::gemm_phase<EpiQmla, pg8::StaticOrder, true>(lds, g, S, E);
#endif
    }
    {
        pg8::Gemm g{(const bf16_t*)(ws + WS_CKV), (const bf16_t*)(ws + WS_WUKV), MT, 2048, KVRANK}; pg8::StaticOrder S; S.init(MT, 2048, G, (cid + 64) % G);
        EpiKv E{(bf16_t*)(ws + WS_KVM), SSQKV};
        pg8::gemm_phase<EpiKv, pg8::StaticOrder, true>(lds, g, S, E);
#if PROBE_DUP == 3 || PROBE_DUP == 35
        pg8::gemm_phase<EpiKv, pg8::StaticOrder, true>(lds, g, S, E);
#endif
    }
    GRID_SYNC();
    attention_phase(lds, P);
#if PROBE_DUP == 41
    attention_phase(lds, P);
#endif
    attention_mla_phase(lds, P);
#if PROBE_DUP == 42
    attention_mla_phase(lds, P);
#endif
    GRID_SYNC();
    {
        pg8::Gemm g{(const bf16_t*)(ws + WS_MRG), (const bf16_t*)(ws + WS_WO), ML, DM, DM}; pg8::StaticOrder S; S.init(ML, DM, G, cid);
        EpiRes E{P.in[0], MOD + 2 * DM, X1};
        pg8::gemm_phase<EpiRes, pg8::StaticOrder, true>(lds, g, S, E);
#if PROBE_DUP == 5 || PROBE_DUP == 35
        pg8::gemm_phase<EpiRes, pg8::StaticOrder, true>(lds, g, S, E);
#endif
    }
    GRID_SYNC();
    norm_mod_phase(X1, nullptr, ML, P.in[18], MOD, 3, 4, H);
#if PROBE_DUP == 6 || PROBE_DUP == 16
    norm_mod_phase(X1, nullptr, ML, P.in[18], MOD, 3, 4, H);
#endif
    GRID_SYNC();
    {
        pg8::Gemm g{H, (const bf16_t*)(ws + WS_WUP), ML, 2 * DFF, DM}; pg8::StaticOrder S; S.init(ML, 2 * DFF, G, cid);
        EpiUpAct E{(bf16_t*)(ws + WS_U), (float*)(ws + WS_GS), (float*)(ws + WS_US), P.in[20], P.in[21]};
        pg8::gemm_phase<EpiUpAct, pg8::StaticOrder, true>(lds, g, S, E);
#if PROBE_DUP == 7
        pg8::gemm_phase<EpiUpAct, pg8::StaticOrder, true>(lds, g, S, E);
#endif
        { const int rem = S.nwg % G; if (rem == 0) convert_wdown(lds, P, cid, G); else if (cid >= rem) convert_wdown(lds, P, cid - rem, G - rem); }
    }
    GRID_SYNC();
    act_fixup_phase((const float*)(ws + WS_GS), (const float*)(ws + WS_US), (bf16_t*)(ws + WS_U), P.in[20], P.in[21]);
    GRID_SYNC();
    {
        pg8::Gemm g{(const bf16_t*)(ws + WS_U), (const bf16_t*)(ws + WS_WDN), ML, DM, DFF}; pg8::StaticOrder S; S.init(ML, DM, G, cid);
        EpiRes E{X1, MOD + 5 * DM, P.out};
        pg8::gemm_phase<EpiRes, pg8::StaticOrder, true>(lds, g, S, E);
#if PROBE_DUP == 9
        pg8::gemm_phase<EpiRes, pg8::StaticOrder, true>(lds, g, S, E);
#endif
    }
    GRID_SYNC();
#if PROBE_DUP == 10
    final_norm_phase(P.out, (float*)ws, P.in[23]);
#endif
    final_norm_phase(P.out, P.out, P.in[23]);
}

extern "C" void kernel_launch(void* const* d_in, const int* in_sizes, int n_in, void* d_out, int out_size, void* d_ws, size_t ws_size, hipStream_t stream) {
    static int grid_blocks = 0;
    if (grid_blocks == 0) {
        if (n_in != 24 || out_size != ML * DM || ws_size < WS_END) { fprintf(stderr, "kernel_launch: unexpected shapes (n_in %d out %d ws %zu, need %zu)\n", n_in, out_size, ws_size, (size_t)WS_END); grid_blocks = -1; return; }
        int dev = 0, cus = 0, per_cu = 0;
        (void)hipGetDevice(&dev);
        (void)hipDeviceGetAttribute(&cus, hipDeviceAttributeMultiprocessorCount, dev);
        if (hipFuncSetAttribute((const void*)fwd_megakernel, hipFuncAttributeMaxDynamicSharedMemorySize, LDS_BYTES) != hipSuccess) { fprintf(stderr, "kernel_launch: hipFuncSetAttribute failed\n"); grid_blocks = -1; return; }
        if (hipOccupancyMaxActiveBlocksPerMultiprocessor(&per_cu, (const void*)fwd_megakernel, 512, LDS_BYTES) != hipSuccess || per_cu < 1) { fprintf(stderr, "kernel_launch: occupancy query failed (%d)\n", per_cu); grid_blocks = -1; return; }
        grid_blocks = cus;
    }
    if (grid_blocks < 0) return;
    (void)hipMemsetAsync((unsigned char*)d_ws + WS_SSQ, 0, (WS_BAR - WS_SSQ) + XCD_BAR_WORDS * 4, stream);
    Ptrs p{};
    for (int i = 0; i < 24; ++i) p.in[i] = (const float*)d_in[i];
    p.out = (float*)d_out; p.ws = (unsigned char*)d_ws;
    void* args[] = {&p};
    hipError_t e = hipLaunchCooperativeKernel((const void*)fwd_megakernel, dim3(grid_blocks), dim3(512), args, LDS_BYTES, stream);
    if (e != hipSuccess) fprintf(stderr, "cooperative launch failed: %s (grid %d)\n", hipGetErrorString(e), grid_blocks);
}
```

```cpp
#include <hip/hip_runtime.h>
#include <hip/hip_cooperative_groups.h>
#include <cstdio>
#include <cstdint>
namespace cg = cooperative_groups;

#define LAS __attribute__((address_space(3)))
#define DI __device__ __forceinline__
typedef unsigned short bf16_t;
typedef short bf16x8 __attribute__((ext_vector_type(8)));
typedef short s16x4 __attribute__((ext_vector_type(4)));
typedef float f32x2 __attribute__((ext_vector_type(2)));
typedef float f32x4 __attribute__((ext_vector_type(4)));
typedef float f32x16 __attribute__((ext_vector_type(16)));
typedef unsigned u32x4 __attribute__((ext_vector_type(4)));
typedef unsigned u32x2 __attribute__((ext_vector_type(2)));
typedef __bf16 bf2_t __attribute__((ext_vector_type(2)));

constexpr int DM = 2048, NBATCH = 4, SEQ = 2048, CTXL = 256, NKEY = SEQ + CTXL;
constexpr int ML = NBATCH * SEQ, MC = NBATCH * CTXL, MT = ML + MC;
constexpr int INW = 3776, INWP = 3840, QRANK = 384, KVRANK = 256, DFF = 5632, NMODC = 6 * DM;
constexpr float EPS = 1e-6f;
constexpr float QSCALE_DA = 0.125f * 1.4426950408889634f, QSCALE_MLA = 0.07216878364870323f * 1.4426950408889634f;
constexpr size_t MiB = 1024 * 1024;
constexpr size_t WS_WIN = 0, WS_WUQ = 15 * MiB, WS_WUKV = 17 * MiB, WS_WO = 18 * MiB, WS_WUP = 26 * MiB, WS_WDN = 70 * MiB;
constexpr size_t WS_SMALL = 92 * MiB, WS_MOD = WS_SMALL, WS_ROPE = WS_SMALL + 256 * 1024, WS_SSQ = WS_SMALL + 512 * 1024;
constexpr size_t SSQ_BYTES = (size_t)(ML + MT) * 4;
constexpr size_t WS_BAR = WS_SSQ + 72 * 1024;
constexpr size_t WS_X1 = 93 * MiB, WS_H = 157 * MiB, WS_O1 = WS_H, WS_T = 193 * MiB;
constexpr size_t WS_QDA = WS_T, WS_KDA = WS_T + 16 * MiB, WS_VDA = WS_T + 34 * MiB, WS_CQ = WS_T + 52 * MiB, WS_CKV = WS_T + 58 * MiB,
                 WS_KR = WS_T + 63 * MiB, WS_QMLA = WS_T + 65 * MiB, WS_KVM = WS_T + 89 * MiB, WS_MRG = WS_T + 125 * MiB;
constexpr size_t WS_GS = WS_T, WS_US = WS_T + 12 * MiB, WS_U = WS_T + 88 * MiB, WS_END = WS_T + 176 * MiB;
constexpr int LDS_MAIN = 139264, LDS_BYTES = LDS_MAIN + 64;
#ifndef PROBE_DUP
#define PROBE_DUP -1
#endif

DI unsigned pk2(float lo, float hi) { f32x2 v = {lo, hi}; bf2_t b = __builtin_convertvector(v, bf2_t); return __builtin_bit_cast(unsigned, b); }
DI float bflo(unsigned u) { return __builtin_bit_cast(float, u << 16); }
DI float bfhi(unsigned u) { return __builtin_bit_cast(float, u & 0xffff0000u); }
DI int tid_fresh() { int t = threadIdx.x; asm volatile("" : "+v"(t)); return t; }
DI float wave_sum(float v) {
#pragma unroll
    for (int o = 1; o < 64; o <<= 1) v += __shfl_xor(v, o);
    return v;
}

namespace pg8 {
constexpr int BM = 256, BK = 64, HALF = 128, HTB = HALF * BK * 2, STAGE_BYTES = 8 * HTB, NXCD = 8, WGM = 8;
DI int lds_byte(int r, int c) { const int st = (r >> 4) * 2 + (c >> 5), rr = r & 15, cc = c & 31, ob = rr * 64 + cc * 2; return st * 1024 + (ob ^ (((ob >> 9) & 1) << 5)); }
DI void stage_rc(int b, int& R, int& C) { const int st = b / 1024, sb = b % 1024, swz = sb ^ (((sb >> 9) & 1) << 5); R = (st >> 1) * 16 + swz / 64; C = (st & 1) * 32 + (swz % 64) / 2; }
DI int perm32(int rho) { const int n = rho >> 4, i = rho & 15; return 8 * (i >> 2) + 4 * n + (i & 3); }
struct Unit { int pm, pn; };
struct Gemm { const bf16_t* A; const bf16_t* Bt; int M, N, K; };
struct StaticOrder {
    int nM, nN, nwg, G, c;
    DI void init(int M, int N, int G_, int c_) { nM = M / BM; nN = N / BM; nwg = nM * nN; G = G_; c = c_; }
    DI bool next(int i, Unit& u) const {
        const long L = (long)i * G + c; if (L >= nwg) return false;
        int wgid = (int)L; { const int q = nwg / NXCD, r = nwg % NXCD, xcd = wgid % NXCD, off = wgid / NXCD; wgid = (xcd < r ? xcd * (q + 1) : r * (q + 1) + (xcd - r) * q) + off; }
        const int nig = WGM * nN, gid = wgid / nig, fm = gid * WGM, gsz = (nM - fm) < WGM ? (nM - fm) : WGM;
        u.pm = fm + ((wgid % nig) % gsz); u.pn = (wgid % nig) / gsz; return true;
    }
};

template <class Epi, class Sched, bool ALIGN_EPI>
DI void gemm_phase(LAS unsigned char* lds, const Gemm g, const Sched& S, const Epi& E) {
    const int tid = tid_fresh(), wid = __builtin_amdgcn_readfirstlane(tid >> 6), lane = tid & 63, wr = wid >> 2, wc = wid & 3, fr = lane & 15, fq = lane >> 4;
    const int K = g.K, nt = K / BK;
    unsigned voffA[2], voffB[2];
#pragma unroll
    for (int i = 0; i < 2; ++i) { int R, C; stage_rc(tid * 16 + i * 8192, R, C); const int Rb = Epi::PERM ? ((R & ~31) + perm32(R & 31)) : R;
        voffA[i] = (unsigned)(R * K + C) * 2u; voffB[i] = (unsigned)(Rb * K + C) * 2u; }
    const size_t kstep = (size_t)(BK * 2);
    const size_t hstep = (size_t)HALF * K * 2;
    const size_t tstep = 2 * hstep;
    const unsigned ldsw = (unsigned)wid * 1024u;
    const int aoff = lds_byte(wr * 64 + fr, fq * 8), boff = lds_byte(wc * 32 + fr, fq * 8);
#define PG8_SA(b, h) (((b) * 2 + (h)) * HTB)
#define PG8_SB(b, h) ((4 + (b) * 2 + (h)) * HTB)
#define PG8_STAGE(bufoff, gbase, voff) do { _Pragma("unroll") for (int _i = 0; _i < 2; ++_i) \
        __builtin_amdgcn_global_load_lds((const unsigned*)((const char*)(gbase) + (voff)[_i]), (LAS unsigned*)(lds + (bufoff) + ldsw + _i * 8192), 16, 0, 0); } while (0)
#define PG8_LDA(dst, b, h) do { _Pragma("unroll") for (int m = 0; m < 4; ++m) _Pragma("unroll") for (int k = 0; k < 2; ++k) dst[m][k] = *(const LAS bf16x8*)(lds + PG8_SA(b, h) + aoff + m * 2048 + k * 1024); } while (0)
#define PG8_LDB(dst, b, h) do { _Pragma("unroll") for (int n = 0; n < 2; ++n) _Pragma("unroll") for (int k = 0; k < 2; ++k) dst[n][k] = *(const LAS bf16x8*)(lds + PG8_SB(b, h) + boff + n * 2048 + k * 1024); } while (0)
#define PG8_MMA(ai, bj, At, Bt) do { __builtin_amdgcn_s_setprio(1); _Pragma("unroll") for (int m = 0; m < 4; ++m) _Pragma("unroll") for (int n = 0; n < 2; ++n) _Pragma("unroll") for (int k = 0; k < 2; ++k) \
        acc[ai][bj][m][n] = __builtin_amdgcn_mfma_f32_16x16x32_bf16(Bt[n][k], At[m][k], acc[ai][bj][m][n], 0, 0, 0); __builtin_amdgcn_s_setprio(0); } while (0)
#define PG8_WAIT_V(n) asm volatile("s_waitcnt vmcnt(" #n ")" ::: "memory")
#define PG8_WAIT_L(n) asm volatile("s_waitcnt lgkmcnt(" #n ")" ::: "memory")
#define PG8_BAR __builtin_amdgcn_s_barrier()
#define PG8_SCHED __builtin_amdgcn_sched_barrier(0)
    Unit cur, nxt; int ui = 0;
    if (!S.next(0, cur)) return;
    f32x4 acc[2][2][4][2];
#pragma unroll
    for (int a = 0; a < 2; ++a)
#pragma unroll
        for (int b = 0; b < 2; ++b)
#pragma unroll
            for (int m = 0; m < 4; ++m)
#pragma unroll
                for (int n = 0; n < 2; ++n) acc[a][b][m][n] = (f32x4){0.f, 0.f, 0.f, 0.f};
    bf16x8 At[4][2], B0[2][2], B1[2][2];
    const char* cA = (const char*)g.A + (size_t)cur.pm * tstep; const char* cB = (const char*)g.Bt + (size_t)cur.pn * tstep;
    PG8_STAGE(PG8_SB(0, 0), cB, voffB); PG8_STAGE(PG8_SB(0, 1), cB + hstep, voffB); PG8_STAGE(PG8_SA(0, 0), cA, voffA); PG8_STAGE(PG8_SA(0, 1), cA + hstep, voffA);
    if (wr == 1) PG8_BAR;
    PG8_WAIT_V(2); PG8_BAR;
    PG8_STAGE(PG8_SB(1, 0), cB + kstep, voffB); PG8_STAGE(PG8_SA(1, 0), cA + kstep, voffA); PG8_STAGE(PG8_SB(1, 1), cB + hstep + kstep, voffB);
    PG8_WAIT_V(6); PG8_BAR;
    for (;;) {
        const bool has_next = S.next(ui + 1, nxt);
        const char* nA = has_next ? (const char*)g.A + (size_t)nxt.pm * tstep : cA; const char* nB = has_next ? (const char*)g.Bt + (size_t)nxt.pn * tstep : cB;
#pragma unroll 1
        for (int t = 0; t < nt; t += 2) {
            const bool last = (t == nt - 2);
            const char* a1 = cA + (size_t)(t + 1) * kstep;
            const char* a2 = last ? nA : cA + (size_t)(t + 2) * kstep; const char* b2 = last ? nB : cB + (size_t)(t + 2) * kstep;
            const char* a3 = a2 + kstep; const char* b3 = b2 + kstep;
            PG8_LDB(B0, 0, 0); PG8_LDB(B1, 0, 1); PG8_SCHED; PG8_LDA(At, 0, 0); PG8_STAGE(PG8_SA(1, 1), a1 + hstep, voffA);
            PG8_WAIT_V(8); PG8_WAIT_L(0); PG8_BAR; PG8_MMA(0, 0, At, B0); PG8_MMA(0, 1, At, B1); PG8_BAR; PG8_SCHED;
            PG8_LDA(At, 0, 1); PG8_STAGE(PG8_SB(0, 0), b2, voffB); PG8_STAGE(PG8_SB(0, 1), b2 + hstep, voffB); PG8_STAGE(PG8_SA(0, 0), a2, voffA);
            PG8_WAIT_V(8); PG8_WAIT_L(0); PG8_BAR; PG8_MMA(1, 0, At, B0); PG8_MMA(1, 1, At, B1); PG8_BAR; PG8_SCHED;
            PG8_LDB(B0, 1, 0); PG8_LDB(B1, 1, 1); PG8_SCHED; PG8_LDA(At, 1, 0); PG8_STAGE(PG8_SA(0, 1), a2 + hstep, voffA);
            PG8_WAIT_V(8); PG8_WAIT_L(0); PG8_BAR; PG8_MMA(0, 0, At, B0); PG8_MMA(0, 1, At, B1); PG8_BAR; PG8_SCHED;
            PG8_LDA(At, 1, 1); PG8_STAGE(PG8_SB(1, 0), b3, voffB); PG8_STAGE(PG8_SB(1, 1), b3 + hstep, voffB); PG8_STAGE(PG8_SA(1, 0), a3, voffA);
            PG8_WAIT_V(8); PG8_WAIT_L(0); PG8_BAR; PG8_MMA(1, 0, At, B0); PG8_MMA(1, 1, At, B1); PG8_BAR; PG8_SCHED;
        }
        if constexpr (ALIGN_EPI) { if (wr == 0) PG8_BAR; }
        E(acc, cur, wr, wc, fr, fq);
        if (!has_next) break;
#pragma unroll
        for (int a = 0; a < 2; ++a)
#pragma unroll
            for (int b = 0; b < 2; ++b)
#pragma unroll
                for (int m = 0; m < 4; ++m)
#pragma unroll
                    for (int n = 0; n < 2; ++n) acc[a][b][m][n] = (f32x4){0.f, 0.f, 0.f, 0.f};
        cur = nxt; cA = nA; cB = nB; ++ui;
        if constexpr (ALIGN_EPI) { if (wr == 1) PG8_BAR; }
    }
    PG8_WAIT_V(0);
    if constexpr (!ALIGN_EPI) { if (wr == 0) PG8_BAR; }
    PG8_BAR;
#undef PG8_SA
#undef PG8_SB
#undef PG8_STAGE
#undef PG8_LDA
#undef PG8_LDB
#undef PG8_MMA
#undef PG8_WAIT_V
#undef PG8_WAIT_L
#undef PG8_BAR
#undef PG8_SCHED
}
}
using pg8::Unit;

DI void rope4(f32x4& v0, f32x4& v1, const f32x2* rp) {
#pragma unroll
    for (int j = 0; j < 4; ++j) { const f32x2 cs = rp[j]; const float x1 = v0[j], x2 = v1[j]; v0[j] = x1 * cs.x - x2 * cs.y; v1[j] = x2 * cs.x + x1 * cs.y; }
}
DI void store_bf16_pair(bf16_t* dst, int fq, const f32x4& v0, const f32x4& v1) {
    u32x2 w0, w1; w0.x = pk2(v0[0], v0[1]); w0.y = pk2(v0[2], v0[3]); w1.x = pk2(v1[0], v1[1]); w1.y = pk2(v1[2], v1[3]);
    *(u32x2*)(dst + 4 * fq) = w0; *(u32x2*)(dst + 16 + 4 * fq) = w1;
}

struct EpiIn {
    static constexpr bool PERM = false;
    bf16_t *qda, *kda, *vda, *cq, *ckv, *kr; float *ssq_q, *ssq_kv; const f32x2* rope; bool do_ssq;
    DI void operator()(const f32x4 (&acc)[2][2][4][2], const Unit& u, int wr, int wc, int fr, int fq) const {
        const bool latent = u.pm < 32;
#pragma unroll
        for (int bj = 0; bj < 2; ++bj) {
            const int cb = u.pn * 256 + bj * 128 + wc * 32;
            if (cb >= INW) continue;
            if (cb < 1024 && !latent) continue;
            const bool is_cq = (cb >= 3072 && cb < 3456), is_ckv = (cb >= 3456 && cb < 3712);
            if (is_cq && !latent) continue;
            const bool do_rope = latent && (cb < 2048 || cb >= 3712);
            const bool colpart = (cb >> 5) & 1;
#pragma unroll
            for (int ai = 0; ai < 2; ++ai)
#pragma unroll
                for (int m = 0; m < 4; ++m) {
                    const int row = u.pm * 256 + ai * 128 + wr * 64 + m * 16 + fr;
                    f32x4 v0 = acc[ai][bj][m][0], v1 = acc[ai][bj][m][1];
                    int b, t; if (latent) { b = row >> 11; t = row & 2047; } else { b = (row - ML) >> 8; t = (row - ML) & 255; }
                    const int keyrow = b * NKEY + (latent ? CTXL + t : t);
                    if (do_rope) { const int pos = colpart ? (t & 63) : (t >> 6); rope4(v0, v1, rope + pos * 16 + 4 * fq); }
                    if (cb < 1024) { v0 = v0 * QSCALE_DA; v1 = v1 * QSCALE_DA; }
                    if ((is_cq || is_ckv) && do_ssq) {
                        float s = (v0[0] * v0[0] + v0[1] * v0[1]) + (v0[2] * v0[2] + v0[3] * v0[3]) + (v1[0] * v1[0] + v1[1] * v1[1]) + (v1[2] * v1[2] + v1[3] * v1[3]);
                        s += __shfl_xor(s, 16); s += __shfl_xor(s, 32);
                        if (fq == 0) atomicAdd((is_cq ? ssq_q : ssq_kv) + row, s);
                    }
                    bf16_t* dst;
                    if (cb < 1024) dst = qda + (size_t)row * 1024 + cb;
                    else if (cb < 2048) dst = kda + (size_t)keyrow * 1024 + (cb - 1024);
                    else if (cb < 3072) dst = vda + (size_t)keyrow * 1024 + (cb - 2048);
                    else if (cb < 3456) dst = cq + (size_t)row * QRANK + (cb - 3072);
                    else if (cb < 3712) dst = ckv + (size_t)row * KVRANK + (cb - 3456);
                    else dst = kr + (size_t)keyrow * 64 + (cb - 3712);
                    store_bf16_pair(dst, fq, v0, v1);
                    asm volatile("" ::: "memory");
                }
        }
    }
};
struct EpiQmla {
    static constexpr bool PERM = false;
    bf16_t* qmla; const float* ssq_q; const f32x2* rope;
    DI void operator()(const f32x4 (&acc)[2][2][4][2], const Unit& u, int wr, int wc, int fr, int fq) const {
#pragma unroll
        for (int bj = 0; bj < 2; ++bj) {
            const int cb = u.pn * 256 + bj * 128 + wc * 32;
            const int gi = (cb >> 5) % 6;
#pragma unroll
            for (int ai = 0; ai < 2; ++ai)
#pragma unroll
                for (int m = 0; m < 4; ++m) {
                    const int row = u.pm * 256 + ai * 128 + wr * 64 + m * 16 + fr;
                    const float rstd = rsqrtf(ssq_q[row] * (1.0f / QRANK) + EPS) * QSCALE_MLA;
                    f32x4 v0 = acc[ai][bj][m][0] * rstd, v1 = acc[ai][bj][m][1] * rstd;
                    if (gi >= 4) { const int t = row & 2047; const int pos = (gi == 5) ? (t & 63) : (t >> 6); rope4(v0, v1, rope + pos * 16 + 4 * fq); }
                    store_bf16_pair(qmla + (size_t)row * 1536 + cb, fq, v0, v1);
                    asm volatile("" ::: "memory");
                }
        }
    }
};
struct EpiKv {
    static constexpr bool PERM = false;
    bf16_t* kvm; const float* ssq_kv;
    DI void operator()(const f32x4 (&acc)[2][2][4][2], const Unit& u, int wr, int wc, int fr, int fq) const {
        const bool latent = u.pm < 32;
#pragma unroll
        for (int bj = 0; bj < 2; ++bj) {
            const int cb = u.pn * 256 + bj * 128 + wc * 32;
#pragma unroll
            for (int ai = 0; ai < 2; ++ai)
#pragma unroll
                for (int m = 0; m < 4; ++m) {
                    const int row = u.pm * 256 + ai * 128 + wr * 64 + m * 16 + fr;
                    const float rstd = rsqrtf(ssq_kv[row] * (1.0f / KVRANK) + EPS);
                    int b, t; if (latent) { b = row >> 11; t = row & 2047; } else { b = (row - ML) >> 8; t = (row - ML) & 255; }
                    const int keyrow = b * NKEY + (latent ? CTXL + t : t);
                    const f32x4 v0 = acc[ai][bj][m][0] * rstd, v1 = acc[ai][bj][m][1] * rstd;
                    store_bf16_pair(kvm + (size_t)keyrow * 2048 + cb, fq, v0, v1);
                    asm volatile("" ::: "memory");
                }
        }
    }
};
struct EpiRes {
    static constexpr bool PERM = false;
    const float* base; const float* gate; float* out;
    DI void operator()(const f32x4 (&acc)[2][2][4][2], const Unit& u, int wr, int wc, int fr, int fq) const {
        const int b = u.pm >> 3;
#pragma unroll
        for (int bj = 0; bj < 2; ++bj)
#pragma unroll
            for (int n = 0; n < 2; ++n) {
                const int col = u.pn * 256 + bj * 128 + wc * 32 + n * 16 + 4 * fq;
                const f32x4 gv = *(const f32x4*)(gate + (size_t)b * NMODC + col);
#pragma unroll
                for (int ai = 0; ai < 2; ++ai)
#pragma unroll
                    for (int m = 0; m < 4; ++m) {
                        const int row = u.pm * 256 + ai * 128 + wr * 64 + m * 16 + fr;
                        const size_t off = (size_t)row * DM + col;
                        const f32x4 bs = *(const f32x4*)(base + off);
                        *(f32x4*)(out + off) = bs + gv * acc[ai][bj][m][n];
                    }
            }
    }
};
struct EpiUpAct {
    static constexpr bool PERM = false;
    bf16_t* act; float* gs; float* us; const float* conv_w; const float* conv_b;
    DI void operator()(const f32x4 (&acc)[2][2][4][2], const Unit& u, int wr, int wc, int fr, int fq) const {
        const int lane = fq * 16 + fr;
        const int up_src = (fr > 0) ? lane - 1 : lane + 15, dn_src = (fr < 15) ? lane + 1 : lane - 15;
#pragma unroll
        for (int n = 0; n < 2; ++n) {
            const int f = u.pn * 128 + wc * 32 + n * 16 + 4 * fq;
            const f32x4 w0 = *(const f32x4*)(conv_w + f), w1 = *(const f32x4*)(conv_w + DFF + f), w2 = *(const f32x4*)(conv_w + 2 * DFF + f), bb = *(const f32x4*)(conv_b + f);
#pragma unroll
            for (int ai = 0; ai < 2; ++ai) {
                const int base = u.pm * 256 + ai * 128 + wr * 64, span = base >> 6;
                f32x4 tu[4], td[4];
#pragma unroll
                for (int m = 0; m < 4; ++m)
#pragma unroll
                    for (int j = 0; j < 4; ++j) { tu[m][j] = __shfl(acc[ai][0][m][n][j], up_src); td[m][j] = __shfl(acc[ai][0][m][n][j], dn_src); }
#pragma unroll
                for (int m = 0; m < 4; ++m) {
                    const f32x4 g = acc[ai][0][m][n], uu = acc[ai][1][m][n];
                    const f32x4 zero = {0.f, 0.f, 0.f, 0.f};
                    const f32x4 upv = (fr == 0) ? (m > 0 ? tu[m > 0 ? m - 1 : 0] : zero) : tu[m];
                    const f32x4 dnv = (fr == 15) ? (m < 3 ? td[m < 3 ? m + 1 : 3] : zero) : td[m];
                    const f32x4 z = w0 * upv + w1 * g + w2 * dnv + bb;
                    f32x4 a;
#pragma unroll
                    for (int j = 0; j < 4; ++j) a[j] = z[j] * __builtin_amdgcn_rcpf(1.0f + __expf(-z[j])) * uu[j];
                    const bool edge = (m == 0 && fr == 0) || (m == 3 && fr == 15);
                    if (!edge) { u32x2 pw; pw.x = pk2(a[0], a[1]); pw.y = pk2(a[2], a[3]); *(u32x2*)(act + (size_t)(base + 16 * m + fr) * DFF + f) = pw; }
                }
                if (fr < 2) *(f32x4*)(gs + (size_t)(span * 4 + fr) * DFF + f) = acc[ai][0][0][n];
                if (fr >= 14) *(f32x4*)(gs + (size_t)(span * 4 + 2 + (fr - 14)) * DFF + f) = acc[ai][0][3][n];
                if (fr == 0) *(f32x4*)(us + (size_t)(span * 2) * DFF + f) = acc[ai][1][0][n];
                if (fr == 15) *(f32x4*)(us + (size_t)(span * 2 + 1) * DFF + f) = acc[ai][1][3][n];
                asm volatile("" ::: "memory");
            }
        }
    }
};

DI s16x4 tr_read(LAS const unsigned char* p) { return __builtin_bit_cast(s16x4, __builtin_amdgcn_ds_read_tr16_b64_v4i16((LAS s16x4*)p)); }

template <int DQK>
DI void attn_pass(LAS unsigned char* lds, const bf16_t* qrow, const bf16_t* K0, int ldk0, const bf16_t* K1, int ldk1, const bf16_t* V, int ldv,
                  f32x16 (&o)[4], float& lsum_out) {
    constexpr int KST = (DQK + 8) * 2, VST = 320, KBUF = 64 * KST, VBUF = 64 * VST, NKC = DQK / 8, KCH = (64 * NKC) / 512, NKK = DQK / 16, NT = NKEY / 64;
    const int tid = tid_fresh(), lane = tid & 63, r = lane & 31, h = lane >> 5;
    bf16x8 qf[NKK];
#pragma unroll
    for (int kk = 0; kk < NKK; ++kk) qf[kk] = *(const bf16x8*)(qrow + 16 * kk + 8 * h);
#pragma unroll
    for (int d = 0; d < 4; ++d)
#pragma unroll
        for (int i = 0; i < 16; ++i) o[d][i] = 0.f;
    float mrun = 0.f, lsum = 0.f;
    u32x4 kreg[KCH], vreg[2];
    constexpr int NC0 = (DQK == 64) ? 8 : 16, KCH0 = (64 * NC0) / 512;
    unsigned ksrc[KCH]; int kdst[KCH];
#pragma unroll
    for (int i = 0; i < KCH; ++i) {
        if (i < KCH0) { const int ci = tid + 512 * i, key = ci / NC0, c8 = ci % NC0; ksrc[i] = (unsigned)(key * ldk0 + 8 * c8); kdst[i] = key * KST + c8 * 16; }
        else { const int key = tid >> 3, c8 = tid & 7; ksrc[i] = (unsigned)(key * ldk1 + 8 * c8); kdst[i] = key * KST + (16 + c8) * 16; }
    }
    unsigned vsrc[2]; int vdst[2];
#pragma unroll
    for (int i = 0; i < 2; ++i) { const int ci = tid + 512 * i, key = ci >> 4, c8 = ci & 15; vsrc[i] = (unsigned)(key * ldv + 8 * c8); vdst[i] = 3 * KBUF + key * VST + c8 * 16; }
#define AT_GLOAD(t) do { const bf16_t* k0t = K0 + (size_t)(t) * 64 * ldk0; const bf16_t* k1t = K1 + (size_t)(t) * 64 * ldk1; const bf16_t* vt = V + (size_t)(t) * 64 * ldv; \
                         _Pragma("unroll") for (int i = 0; i < KCH; ++i) kreg[i] = *(const u32x4*)((i < KCH0 ? k0t : k1t) + ksrc[i]); \
                         _Pragma("unroll") for (int i = 0; i < 2; ++i) vreg[i] = *(const u32x4*)(vt + vsrc[i]); } while (0)
#define AT_LSTORE(kb_, vb_) do { _Pragma("unroll") for (int i = 0; i < KCH; ++i) *(LAS u32x4*)(lds + (kb_) * KBUF + kdst[i]) = kreg[i]; \
                          _Pragma("unroll") for (int i = 0; i < 2; ++i) *(LAS u32x4*)(lds + (vb_) * VBUF + vdst[i]) = vreg[i]; } while (0)
#define AT_PV(vb_) do { _Pragma("unroll") for (int ks = 0; ks < 4; ++ks) { const bf16x8 pf = __builtin_bit_cast(bf16x8, pprev[ks]); \
            _Pragma("unroll") for (int d = 0; d < 4; ++d) { LAS const unsigned char* ap = lds + (vb_) * VBUF + voff + (16 * ks) * VST + d * 64; \
                const s16x4 lo = tr_read(ap), hi = tr_read(ap + 8 * VST); const bf16x8 vf = __builtin_shufflevector(lo, hi, 0, 1, 2, 3, 4, 5, 6, 7); \
                o[d] = __builtin_amdgcn_mfma_f32_32x32x16_bf16(vf, pf, o[d], 0, 0, 0); } } } while (0)
    const int koff = r * KST + 16 * h;
    const int i16 = lane & 15, q4 = i16 >> 2, p4 = i16 & 3, blk = (lane >> 4) & 1;
    const int voff = 3 * KBUF + (4 * h + q4) * VST + 32 * blk + 8 * p4;
    u32x4 pprev[4];
#pragma unroll
    for (int ks = 0; ks < 4; ++ks) pprev[ks] = (u32x4){0u, 0u, 0u, 0u};
    AT_GLOAD(0); AT_LSTORE(0, 0);
#pragma unroll
    for (int kk = 0; kk < NKK; ++kk) asm volatile("" :: "v"(qf[kk]));
    AT_GLOAD(1); __syncthreads();
    int vb_prev = 2, vb_cur = 0, vb_next = 1;
#pragma unroll 1
    for (int t = 0; t < NT; ++t) {
        const int b = vb_cur;
        if (t + 1 < NT) AT_LSTORE(vb_next, vb_next);
        if (t + 2 < NT) AT_GLOAD(t + 2);
        f32x16 st[2];
#pragma unroll
        for (int kb = 0; kb < 2; ++kb) {
#pragma unroll
            for (int i = 0; i < 16; ++i) st[kb][i] = -mrun;
#pragma unroll
            for (int kk = 0; kk < NKK; ++kk) {
                const bf16x8 kf = *(const LAS bf16x8*)(lds + b * KBUF + kb * 32 * KST + koff + 32 * kk);
                st[kb] = __builtin_amdgcn_mfma_f32_32x32x16_bf16(kf, qf[kk], st[kb], 0, 0, 0);
            }
        }
#pragma unroll
        for (int i = 0; i < 4; ++i) __builtin_amdgcn_sched_group_barrier(0x100, 1, 0);
#pragma unroll
        for (int i = 0; i < 2 * NKK - 4; ++i) { __builtin_amdgcn_sched_group_barrier(0x008, 1, 0); __builtin_amdgcn_sched_group_barrier(0x100, 1, 0); }
#pragma unroll
        for (int i = 0; i < 4; ++i) __builtin_amdgcn_sched_group_barrier(0x008, 1, 0);
        __builtin_amdgcn_sched_barrier(0);
        { const int vslot = (t == 0) ? 0 : vb_prev; AT_PV(vslot); }
        __builtin_amdgcn_sched_group_barrier(0x100, 8, 1);
#pragma unroll
        for (int i = 0; i < 12; ++i) { __builtin_amdgcn_sched_group_barrier(0x008, 1, 1); __builtin_amdgcn_sched_group_barrier(0x100, 2, 1); }
        __builtin_amdgcn_sched_group_barrier(0x008, 4, 1);
        __builtin_amdgcn_sched_barrier(0);
        float mx = st[0][0];
#pragma unroll
        for (int kb = 0; kb < 2; ++kb)
#pragma unroll
            for (int i = 0; i < 16; ++i) mx = fmaxf(mx, st[kb][i]);
        mx = fmaxf(mx, __shfl_xor(mx, 32));
        if (t == 0 || __builtin_amdgcn_ballot_w64(mx > 8.0f) != 0ull) {
            const float delta = (t == 0) ? mx : fmaxf(mx, 0.f);
            const float alpha = (t == 0) ? 1.f : __builtin_amdgcn_exp2f(-delta);
            lsum *= alpha; mrun += delta;
#pragma unroll
            for (int d = 0; d < 4; ++d)
#pragma unroll
                for (int i = 0; i < 16; ++i) o[d][i] *= alpha;
#pragma unroll
            for (int kb = 0; kb < 2; ++kb)
#pragma unroll
                for (int i = 0; i < 16; ++i) st[kb][i] -= delta;
        }
        float ps = 0.f;
#pragma unroll
        for (int kb = 0; kb < 2; ++kb)
#pragma unroll
            for (int i = 0; i < 16; ++i) { const float pv = __builtin_amdgcn_exp2f(st[kb][i]); st[kb][i] = pv; ps += pv; }
        lsum += ps;
#pragma unroll
        for (int ks = 0; ks < 4; ++ks) {
            const int kb = ks >> 1, s = ks & 1;
            pprev[ks].x = pk2(st[kb][8 * s + 0], st[kb][8 * s + 1]); pprev[ks].y = pk2(st[kb][8 * s + 2], st[kb][8 * s + 3]);
            pprev[ks].z = pk2(st[kb][8 * s + 4], st[kb][8 * s + 5]); pprev[ks].w = pk2(st[kb][8 * s + 6], st[kb][8 * s + 7]);
        }
        __syncthreads();
        { const int tmp = vb_prev; vb_prev = vb_cur; vb_cur = vb_next; vb_next = tmp; }
    }
    AT_PV(vb_prev);
    __syncthreads();
#undef AT_GLOAD
#undef AT_LSTORE
#undef AT_PV
    lsum += __shfl_xor(lsum, 32);
    lsum_out = lsum;
}

struct Ptrs {
    const float* in[24]; float* out; unsigned char* ws;
};

DI void attention_phase(LAS unsigned char* lds, const Ptrs& P) {
    const int tid = threadIdx.x, lane = tid & 63, wave = tid >> 6, r = lane & 31, h = lane >> 5;
    unsigned char* ws = P.ws;
    const bf16_t* QDA = (const bf16_t*)(ws + WS_QDA); const bf16_t* KDA = (const bf16_t*)(ws + WS_KDA); const bf16_t* VDA = (const bf16_t*)(ws + WS_VDA);
    const bf16_t* QMLA = (const bf16_t*)(ws + WS_QMLA); const bf16_t* KVM = (const bf16_t*)(ws + WS_KVM); const bf16_t* KR = (const bf16_t*)(ws + WS_KR);
    bf16_t* MRG = (bf16_t*)(ws + WS_MRG);
    float* O1 = (float*)(ws + WS_O1) + (size_t)blockIdx.x * (16 * 512 * 4);
    const float LOG2E = 1.4426950408889634f;
    float lam;
    { const float s1 = wave_sum(P.in[12][lane] * P.in[13][lane]), s2 = wave_sum(P.in[14][lane] * P.in[15][lane]); lam = expf(s1) - expf(s2) + 0.2f; }
    const float* subln = P.in[16];
    for (int it = blockIdx.x; it < 256; it += gridDim.x) {
        const int b = it >> 6, hd = (it >> 3) & 7, qb = it & 7;
        const int qr = b * SEQ + qb * 256 + wave * 32 + r;
        f32x16 o[4]; float l;
        const bf16_t* qrow = QDA + (size_t)qr * 1024 + hd * 128;
        const bf16_t* Kb = KDA + (size_t)b * NKEY * 1024 + hd * 128;
        const bf16_t* Vb = VDA + (size_t)b * NKEY * 1024 + hd * 128;
        attn_pass<64>(lds, qrow, Kb, 1024, Kb, 1024, Vb, 1024, o, l);
        { const float inv = 1.0f / l;
#pragma unroll
          for (int d = 0; d < 4; ++d)
#pragma unroll
              for (int g = 0; g < 4; ++g) { f32x4 v = {o[d][4 * g] * inv, o[d][4 * g + 1] * inv, o[d][4 * g + 2] * inv, o[d][4 * g + 3] * inv};
                  *(f32x4*)(O1 + ((size_t)(d * 4 + g) * 512 + tid) * 4) = v; } }
        attn_pass<64>(lds, qrow + 64, Kb + 64, 1024, Kb + 64, 1024, Vb, 1024, o, l);
        const float inv2 = lam / l;
        float ss = 0.f;
#pragma unroll
        for (int d = 0; d < 4; ++d) {
#pragma unroll
            for (int g = 0; g < 4; ++g) { const f32x4 v1 = *(const f32x4*)(O1 + ((size_t)(d * 4 + g) * 512 + tid) * 4);
#pragma unroll
                for (int j = 0; j < 4; ++j) { const float v = v1[j] - o[d][4 * g + j] * inv2; o[d][4 * g + j] = v; ss += v * v; } }
            asm volatile("" ::: "memory");
        }
        ss += __shfl_xor(ss, 32);
        const float rs = rsqrtf(ss * (1.0f / 128.0f) + EPS) * 0.8f;
        bf16_t* orow = MRG + (size_t)qr * 2048 + hd * 128;
#pragma unroll
        for (int d = 0; d < 4; ++d) {
#pragma unroll
            for (int g = 0; g < 4; ++g) { const int dv = 32 * d + 8 * g + 4 * h; const f32x4 w = *(const f32x4*)(subln + dv);
                u32x2 pw; pw.x = pk2(o[d][4 * g] * rs * w[0], o[d][4 * g + 1] * rs * w[1]); pw.y = pk2(o[d][4 * g + 2] * rs * w[2], o[d][4 * g + 3] * rs * w[3]);
                *(u32x2*)(orow + dv) = pw; }
            asm volatile("" ::: "memory");
        }
    }
}
DI void attention_mla_phase(LAS unsigned char* lds, const Ptrs& P) {
    const int tid = threadIdx.x, lane = tid & 63, wave = tid >> 6, r = lane & 31, h = lane >> 5;
    unsigned char* ws = P.ws;
    const bf16_t* QMLA = (const bf16_t*)(ws + WS_QMLA); const bf16_t* KVM = (const bf16_t*)(ws + WS_KVM); const bf16_t* KR = (const bf16_t*)(ws + WS_KR);
    bf16_t* MRG = (bf16_t*)(ws + WS_MRG);
    const float LOG2E = 1.4426950408889634f;
    (void)tid;
    for (int it = blockIdx.x; it < 256; it += gridDim.x) {
        const int b = it >> 6, hd = (it >> 3) & 7, qb = it & 7;
        const int qr = b * SEQ + qb * 256 + wave * 32 + r;
        f32x16 o[4]; float l;
        const bf16_t* qrow = QMLA + (size_t)qr * 1536 + hd * 192;
        const bf16_t* Kb = KVM + (size_t)b * NKEY * 2048 + hd * 256;
        const bf16_t* Krp = KR + (size_t)b * NKEY * 64;
        attn_pass<192>(lds, qrow, Kb, 2048, Krp, 64, Kb + 128, 2048, o, l);
        const float inv = 1.0f / l;
        bf16_t* orow = MRG + (size_t)qr * 2048 + 1024 + hd * 128;
#pragma unroll
        for (int d = 0; d < 4; ++d)
#pragma unroll
            for (int g = 0; g < 4; ++g) { const int dv = 32 * d + 8 * g + 4 * h;
                u32x2 pw; pw.x = pk2(o[d][4 * g] * inv, o[d][4 * g + 1] * inv); pw.y = pk2(o[d][4 * g + 2] * inv, o[d][4 * g + 3] * inv);
                *(u32x2*)(orow + dv) = pw; }
    }
}

DI void ada_unit(LAS unsigned char* lds, const Ptrs& P, int u) {
    const int tid = threadIdx.x, lane = tid & 63, wave = tid >> 6;
    LAS float* sc = (LAS float*)lds; LAS float* red = (LAS float*)(lds + 40960);
    const float* c = P.in[1]; const float* cc = P.in[3]; const float* w_ada = P.in[4]; const float* b_ada = P.in[5];
    float* MOD = (float*)(P.ws + WS_MOD);
    for (int idx = tid; idx < 5 * DM; idx += 512) { const float v = idx < 4 * DM ? c[idx] : cc[idx - 4 * DM]; sc[idx] = v / (1.0f + __expf(-v)); }
    __syncthreads();
    const int cgp = tid & 15, rg = tid >> 4;
    float acc[5][4];
#pragma unroll
    for (int rr = 0; rr < 5; ++rr)
#pragma unroll
        for (int j = 0; j < 4; ++j) acc[rr][j] = 0.f;
    const float* wp = w_ada + (size_t)rg * NMODC + 64 * u + 4 * cgp;
#pragma unroll 8
    for (int i = 0; i < 64; ++i) {
        const f32x4 w = *(const f32x4*)(wp + (size_t)i * 32 * NMODC);
        const int k = rg + 32 * i;
#pragma unroll
        for (int rr = 0; rr < 5; ++rr) { const float s = sc[rr * DM + k];
#pragma unroll
            for (int j = 0; j < 4; ++j) acc[rr][j] += s * w[j]; }
    }
#pragma unroll
    for (int rr = 0; rr < 5; ++rr)
#pragma unroll
        for (int j = 0; j < 4; ++j) { float a = acc[rr][j]; a += __shfl_xor(a, 16); a += __shfl_xor(a, 32); if (lane < 16) red[(wave * 16 + lane) * 20 + rr * 4 + j] = a; }
    __syncthreads();
    if (tid < 320) { const int cg2 = tid / 20, rj = tid % 20, rr = rj >> 2, j = rj & 3; float s = 0.f;
#pragma unroll
        for (int w = 0; w < 8; ++w) s += red[(w * 16 + cg2) * 20 + rj];
        const int col = 64 * u + 4 * cg2 + j; MOD[(size_t)rr * NMODC + col] = s + b_ada[col]; }
    __syncthreads();
}

DI void transpose_unit(LAS unsigned char* lds, const float* W, int K, int N, bf16_t* Wt, int n0, int k0, const float* kscale, int n0d = -1) {
    if (n0d < 0) n0d = n0;
    const int tid = tid_fresh();
    LAS float* sf = (LAS float*)lds;
    if (n0 >= N) {
#pragma unroll
        for (int i = 0; i < 2; ++i) { const int idx = tid + 512 * i, kc = idx & 15, n = idx >> 4; *(u32x4*)(Wt + (size_t)(n0d + n) * K + k0 + 8 * kc) = (u32x4){0u, 0u, 0u, 0u}; }
        return;
    }
#pragma unroll
    for (int i = 0; i < 4; ++i) { const int idx = tid + 512 * i, kr = idx >> 4, c4 = idx & 15;
        f32x4 v = *(const f32x4*)(W + (size_t)(k0 + kr) * N + n0 + 4 * c4);
        if (kscale) v = v * kscale[k0 + kr];
#pragma unroll
        for (int j = 0; j < 4; ++j) sf[kr * 65 + 4 * c4 + j] = v[j]; }
    __syncthreads();
#pragma unroll
    for (int i = 0; i < 2; ++i) { const int idx = tid + 512 * i, kc = idx & 15, n = idx >> 4;
        float f[8];
#pragma unroll
        for (int j = 0; j < 8; ++j) f[j] = sf[(8 * kc + j) * 65 + n];
        u32x4 w; w.x = pk2(f[0], f[1]); w.y = pk2(f[2], f[3]); w.z = pk2(f[4], f[5]); w.w = pk2(f[6], f[7]);
        *(u32x4*)(Wt + (size_t)(n0d + n) * K + k0 + 8 * kc) = w; }
    __syncthreads();
}

DI void p0_phase(LAS unsigned char* lds, const Ptrs& P) {
    unsigned char* ws = P.ws;
    constexpr int U_ADA = 192, U_ROPE = 1;
    constexpr int T0 = 60 * 16, T1 = 24 * 3, T2 = 32 * 2;
    constexpr int NU = U_ADA + U_ROPE + T0 + T1 + T2;
    for (int u = blockIdx.x; u < NU; u += gridDim.x) {
        if (u < U_ADA) { ada_unit(lds, P, u); continue; }
        if (u == U_ADA) {
            f32x2* rope = (f32x2*)(ws + WS_ROPE);
            for (int idx = threadIdx.x; idx < 1024; idx += 512) { const int pos = idx >> 4, i = idx & 15;
                const double inv = pow(10000.0, -(double)i / 16.0); const double ang = (double)pos * (double)(float)inv;
                rope[idx] = (f32x2){(float)cos(ang), (float)sin(ang)}; }
            continue;
        }
        int v = u - U_ADA - U_ROPE;
        if (v < T0) { transpose_unit(lds, P.in[7], DM, INW, (bf16_t*)(ws + WS_WIN), (v % 60) * 64, (v / 60) * 128, nullptr); continue; } v -= T0;
        if (v < T1) { transpose_unit(lds, P.in[10], QRANK, 1536, (bf16_t*)(ws + WS_WUQ), (v % 24) * 64, (v / 24) * 128, P.in[8]); continue; } v -= T1;
        transpose_unit(lds, P.in[11], KVRANK, 2048, (bf16_t*)(ws + WS_WUKV), (v % 32) * 64, (v / 32) * 128, P.in[9]);
    }
}
DI void convert_wo_wup(LAS unsigned char* lds, const Ptrs& P, int idx, int nblk) {
    unsigned char* ws = P.ws;
    constexpr int T3 = 32 * 16, T4 = 176 * 16;
    for (int v = idx; v < T3 + T4; v += nblk) {
        if (v < T3) transpose_unit(lds, P.in[17], DM, DM, (bf16_t*)(ws + WS_WO), (v % 32) * 64, (v / 32) * 128, nullptr);
        else { const int w = v - T3; const int c = (w % 176) * 64; const int cc = c < DFF ? c : c - DFF; const int nd = 256 * (cc >> 7) + (cc & 127) + (c < DFF ? 0 : 128);
               transpose_unit(lds, P.in[19], DM, 2 * DFF, (bf16_t*)(ws + WS_WUP), c, (w / 176) * 128, nullptr, nd); }
    }
}
DI void convert_wdown(LAS unsigned char* lds, const Ptrs& P, int idx, int nblk) {
    constexpr int T5 = 32 * 44;
    for (int v = idx; v < T5; v += nblk) transpose_unit(lds, P.in[22], DFF, DM, (bf16_t*)(P.ws + WS_WDN), (v % 32) * 64, (v / 32) * 128, nullptr);
}

DI void norm_mod_phase(const float* X, const float* XC, int nrows, const float* nw, const float* MOD, int shift_idx, int scale_idx, bf16_t* H) {
    const int tf = tid_fresh(), lane = tf & 63, wave = tf >> 6;
    for (int row = blockIdx.x * 8 + wave; row < nrows; row += gridDim.x * 8) {
        const float* xr = row < ML ? X + (size_t)row * DM : XC + (size_t)(row - ML) * DM;
        const int mb = row < ML ? (row >> 11) : 4;
        const float* sh = MOD + (size_t)mb * NMODC + shift_idx * DM; const float* scl = MOD + (size_t)mb * NMODC + scale_idx * DM;
        f32x4 v[8]; float ss = 0.f;
#pragma unroll
        for (int i = 0; i < 8; ++i) { v[i] = *(const f32x4*)(xr + 4 * (lane + 64 * i)); ss += (v[i][0] * v[i][0] + v[i][1] * v[i][1]) + (v[i][2] * v[i][2] + v[i][3] * v[i][3]); }
        ss = wave_sum(ss);
        const float rstd = rsqrtf(ss * (1.0f / DM) + EPS);
#pragma unroll
        for (int i = 0; i < 8; ++i) { const int col = 4 * (lane + 64 * i);
            const f32x4 w = *(const f32x4*)(nw + col), s = *(const f32x4*)(scl + col), t = *(const f32x4*)(sh + col);
            const f32x4 y = (v[i] * rstd) * w * (s + 1.0f) + t;
            u32x2 pw; pw.x = pk2(y[0], y[1]); pw.y = pk2(y[2], y[3]);
            *(u32x2*)(H + (size_t)row * DM + col) = pw; }
    }
}
DI void final_norm_phase(const float* xin, float* out, const float* fw) {
    const int tf = tid_fresh(), lane = tf & 63, wave = tf >> 6;
    for (int row = blockIdx.x * 8 + wave; row < ML; row += gridDim.x * 8) {
        const float* xr = xin + (size_t)row * DM; float* orow = out + (size_t)row * DM;
        f32x4 v[8]; float ss = 0.f;
#pragma unroll
        for (int i = 0; i < 8; ++i) { v[i] = *(const f32x4*)(xr + 4 * (lane + 64 * i)); ss += (v[i][0] * v[i][0] + v[i][1] * v[i][1]) + (v[i][2] * v[i][2] + v[i][3] * v[i][3]); }
        ss = wave_sum(ss);
        const float rstd = rsqrtf(ss * (1.0f / DM) + EPS);
#pragma unroll
        for (int i = 0; i < 8; ++i) { const int col = 4 * (lane + 64 * i); const f32x4 w = *(const f32x4*)(fw + col); *(f32x4*)(orow + col) = (v[i] * rstd) * w; }
    }
}
DI void act_fixup_phase(const float* GS, const float* US, bf16_t* ACT, const float* conv_w, const float* conv_b) {
    constexpr int NF4 = DFF / 4, NSPAN = ML / 64, TOTAL = NSPAN * 2 * NF4;
    for (int item = blockIdx.x * 512 + tid_fresh(); item < TOTAL; item += gridDim.x * 512) {
        const int f = (item % NF4) * 4, sd = (item / NF4) & 1, span = item / (2 * NF4);
        const int row = span * 64 + (sd ? 63 : 0);
        const f32x4 zero = {0.f, 0.f, 0.f, 0.f};
        f32x4 up, cur, dn, uu;
        if (sd == 0) { up = (row & 2047) ? *(const f32x4*)(GS + (size_t)((span - 1) * 4 + 3) * DFF + f) : zero; cur = *(const f32x4*)(GS + (size_t)(span * 4) * DFF + f);
                       dn = *(const f32x4*)(GS + (size_t)(span * 4 + 1) * DFF + f); uu = *(const f32x4*)(US + (size_t)(span * 2) * DFF + f); }
        else { up = *(const f32x4*)(GS + (size_t)(span * 4 + 2) * DFF + f); cur = *(const f32x4*)(GS + (size_t)(span * 4 + 3) * DFF + f);
               dn = ((row & 2047) != 2047) ? *(const f32x4*)(GS + (size_t)((span + 1) * 4) * DFF + f) : zero; uu = *(const f32x4*)(US + (size_t)(span * 2 + 1) * DFF + f); }
        const f32x4 w0 = *(const f32x4*)(conv_w + f), w1 = *(const f32x4*)(conv_w + DFF + f), w2 = *(const f32x4*)(conv_w + 2 * DFF + f), bb = *(const f32x4*)(conv_b + f);
        const f32x4 z = w0 * up + w1 * cur + w2 * dn + bb;
        f32x4 a;
#pragma unroll
        for (int j = 0; j < 4; ++j) a[j] = z[j] / (1.0f + __expf(-z[j])) * uu[j];
        u32x2 pw; pw.x = pk2(a[0], a[1]); pw.y = pk2(a[2], a[3]);
        *(u32x2*)(ACT + (size_t)row * DFF + f) = pw;
    }
}

#define XB_TMO      128
#define XB_XCNT(j)  (256  + 64 * (j))
#define XB_XSUB(j)  (1280 + 64 * (j))
#define XB_XGEN(j)  (2304 + 64 * (j))
#define XB_TOP      3328
#define XB_TOPGEN   3392
#define XCD_BAR_WORDS 3456
#define XB_SPIN_CAP (1u << 22)
DI unsigned xb_ld(unsigned* p)              { return __hip_atomic_load(p, __ATOMIC_RELAXED, __HIP_MEMORY_SCOPE_AGENT); }
DI unsigned xb_add(unsigned* p, unsigned v) { return __hip_atomic_fetch_add(p, v, __ATOMIC_RELAXED, __HIP_MEMORY_SCOPE_AGENT); }
DI unsigned xb_xcc_id() { return (unsigned)__builtin_amdgcn_s_getreg((3 << 11) | 20) & 0xFu; }
#define XB_SPIN(cond, bar) do { unsigned _sp = 0; while (cond) { __builtin_amdgcn_s_sleep(1); \
    if ((++_sp & 255u) == 0u) { if (xb_ld(&(bar)[XB_TMO])) break; if (_sp > XB_SPIN_CAP) { atomicAdd(&(bar)[XB_TMO], 1u); break; } } } } while (0)
struct XcdBarrier { unsigned* bar; unsigned x; volatile LAS unsigned* st; };
DI XcdBarrier xcd_barrier_post(unsigned* bar, volatile LAS unsigned* st) {
    XcdBarrier b; b.bar = bar; b.x = xb_xcc_id(); b.st = st;
    if (threadIdx.x == 0) (void)xb_add(&bar[XB_XCNT(b.x)], 1u);
    return b;
}
DI void xcd_barrier_complete(unsigned* bar, unsigned x, unsigned& nloc, unsigned& nx) {
    const unsigned G = gridDim.x * gridDim.y * gridDim.z;
    unsigned sum, cnt, mine, sp = 0u;
    for (;;) {
        sum = 0u; cnt = 0u; mine = 0u;
#pragma unroll
        for (unsigned j = 0; j < 16; ++j) { const unsigned c = xb_ld(&bar[XB_XCNT(j)]); sum += c; cnt += (c > 0u) ? 1u : 0u; mine = (j == x) ? c : mine; }
        if (sum == G) break;
        __builtin_amdgcn_s_sleep(1);
        if ((++sp & 255u) == 0u) { if (xb_ld(&bar[XB_TMO])) break; if (sp > XB_SPIN_CAP) { atomicAdd(&bar[XB_TMO], 1u); break; } }
    }
    nloc = mine > 0u ? mine : 1u; nx = cnt > 0u ? cnt : 1u;
}
DI void xcd_barrier(const XcdBarrier& b) {
    asm volatile("s_waitcnt vmcnt(0)" ::: "memory");
    __syncthreads();
    if (threadIdx.x == 0) {
        unsigned* bar = b.bar;
        __builtin_amdgcn_s_waitcnt(0);
        unsigned nloc = b.st[0], nx = b.st[1];
        if (nloc == 0u) { xcd_barrier_complete(bar, b.x, nloc, nx); b.st[0] = nloc; b.st[1] = nx; }
        const unsigned old = xb_add(&bar[XB_XSUB(b.x)], 1u);
        const unsigned gen = old / nloc;
        if (old + 1u == (gen + 1u) * nloc) {
            __builtin_amdgcn_fence(__ATOMIC_RELEASE, "agent");
            asm volatile("s_waitcnt vmcnt(0)" ::: "memory");
            const unsigned og = xb_add(&bar[XB_TOP], 1u);
            const unsigned tg = og / nx;
            if (og + 1u == (tg + 1u) * nx) xb_add(&bar[XB_TOPGEN], 1u);
            else XB_SPIN(xb_ld(&bar[XB_TOPGEN]) == tg, bar);
            __builtin_amdgcn_fence(__ATOMIC_ACQUIRE, "agent");
            xb_add(&bar[XB_XGEN(b.x)], 1u);
            asm volatile("s_waitcnt vmcnt(0)" ::: "memory");
        } else {
            XB_SPIN(xb_ld(&bar[XB_XGEN(b.x)]) == gen, bar);
            __builtin_amdgcn_fence(__ATOMIC_ACQUIRE, "agent");
            asm volatile("s_waitcnt vmcnt(0)" ::: "memory");
        }
    }
    __syncthreads();
}

__global__ void __launch_bounds__(512, 2) fwd_megakernel(Ptrs P) {
    extern __shared__ __attribute__((aligned(16))) unsigned char lds_raw[];
    LAS unsigned char* lds = (LAS unsigned char*)lds_raw;
    cg::grid_group grid = cg::this_grid();
    if (gridDim.x == 0x7fffffffu) grid.sync();
    volatile LAS unsigned* bst = (volatile LAS unsigned*)(lds + LDS_MAIN);
    if (threadIdx.x < 4) bst[threadIdx.x] = 0u;
    __syncthreads();
    const XcdBarrier gbar = xcd_barrier_post((unsigned*)(P.ws + WS_BAR), bst);
#define GRID_SYNC() xcd_barrier(gbar)
    unsigned char* ws = P.ws;
    const int G = gridDim.x, cid = blockIdx.x;
    float* MOD = (float*)(ws + WS_MOD);
    const f32x2* ROPE = (const f32x2*)(ws + WS_ROPE);
    float* SSQQ = (float*)(ws + WS_SSQ); float* SSQKV = SSQQ + ML;
    bf16_t* H = (bf16_t*)(ws + WS_H);
    float* X1 = (float*)(ws + WS_X1);

    p0_phase(lds, P);
#if PROBE_DUP == 0
    p0_phase(lds, P);
#endif
    GRID_SYNC();
#if PROBE_DUP == 20
    for (int i_ = 0; i_ < 10; ++i_) GRID_SYNC();
#endif
    norm_mod_phase(P.in[0], P.in[2], MT, P.in[6], MOD, 0, 1, H);
#if PROBE_DUP == 1 || PROBE_DUP == 16
    norm_mod_phase(P.in[0], P.in[2], MT, P.in[6], MOD, 0, 1, H);
#endif
    GRID_SYNC();
    {
        pg8::Gemm g{H, (const bf16_t*)(ws + WS_WIN), MT, INWP, DM}; pg8::StaticOrder S; S.init(MT, INWP, G, cid);
        EpiIn E{(bf16_t*)(ws + WS_QDA), (bf16_t*)(ws + WS_KDA), (bf16_t*)(ws + WS_VDA), (bf16_t*)(ws + WS_CQ), (bf16_t*)(ws + WS_CKV), (bf16_t*)(ws + WS_KR), SSQQ, SSQKV, ROPE, true};
        pg8::gemm_phase<EpiIn, pg8::StaticOrder, true>(lds, g, S, E);
#if PROBE_DUP == 2
        E.do_ssq = false; pg8::gemm_phase<EpiIn, pg8::StaticOrder, true>(lds, g, S, E);
#endif
        { const int rem = S.nwg % G; if (rem == 0) convert_wo_wup(lds, P, cid, G); else if (cid >= rem) convert_wo_wup(lds, P, cid - rem, G - rem); }
    }
    GRID_SYNC();
    {
        pg8::Gemm g{(const bf16_t*)(ws + WS_CQ), (const bf16_t*)(ws + WS_WUQ), ML, 1536, QRANK}; pg8::StaticOrder S; S.init(ML, 1536, G, cid);
        EpiQmla E{(bf16_t*)(ws + WS_QMLA), SSQQ, ROPE};
        pg8::gemm_phase<EpiQmla, pg8::StaticOrder, true>(lds, g, S, E);
#if PROBE_DUP == 3 || PROBE_DUP == 35
        pg8::gemm_phase<EpiQmla, pg8::StaticOrder, true>(lds, g, S, E);
#endif
    }
    {
        pg8::Gemm g{(const bf16_t*)(ws + WS_CKV), (const bf16_t*)(ws + WS_WUKV), MT, 2048, KVRANK}; pg8::StaticOrder S; S.init(MT, 2048, G, (cid + 64) % G);
        EpiKv E{(bf16_t*)(ws + WS_KVM), SSQKV};
        pg8::gemm_phase<EpiKv, pg8::StaticOrder, true>(lds, g, S, E);
#if PROBE_DUP == 3 || PROBE_DUP == 35
        pg8::gemm_phase<EpiKv, pg8::StaticOrder, true>(lds, g, S, E);
#endif
    }
    GRID_SYNC();
    attention_phase(lds, P);
#if PROBE_DUP == 41
    attention_phase(lds, P);
#endif
    attention_mla_phase(lds, P);
#if PROBE_DUP == 42
    attention_mla_phase(lds, P);
#endif
    GRID_SYNC();
    {
        pg8::Gemm g{(const bf16_t*)(ws + WS_MRG), (const bf16_t*)(ws + WS_WO), ML, DM, DM}; pg8::StaticOrder S; S.init(ML, DM, G, cid);
        EpiRes E{P.in[0], MOD + 2 * DM, X1};
        pg8::gemm_phase<EpiRes, pg8::StaticOrder, true>(lds, g, S, E);
#if PROBE_DUP == 5 || PROBE_DUP == 35
        pg8::gemm_phase<EpiRes, pg8::StaticOrder, true>(lds, g, S, E);
#endif
    }
    GRID_SYNC();
    norm_mod_phase(X1, nullptr, ML, P.in[18], MOD, 3, 4, H);
#if PROBE_DUP == 6 || PROBE_DUP == 16
    norm_mod_phase(X1, nullptr, ML, P.in[18], MOD, 3, 4, H);
#endif
    GRID_SYNC();
    {
        pg8::Gemm g{H, (const bf16_t*)(ws + WS_WUP), ML, 2 * DFF, DM}; pg8::StaticOrder S; S.init(ML, 2 * DFF, G, cid);
        EpiUpAct E{(bf16_t*)(ws + WS_U), (float*)(ws + WS_GS), (float*)(ws + WS_US), P.in[20], P.in[21]};
        pg8::gemm_phase<EpiUpAct, pg8::StaticOrder, true>(lds, g, S, E);
#if PROBE_DUP == 7
        pg8::gemm_phase<EpiUpAct, pg8::StaticOrder, true>(lds, g, S, E);
#endif
        { const int rem = S.nwg % G; if (rem == 0) convert_wdown(lds, P, cid, G); else if (cid >= rem) convert_wdown(lds, P, cid - rem, G - rem); }
    }
    GRID_SYNC();
    act_fixup_phase((const float*)(ws + WS_GS), (const float*)(ws + WS_US), (bf16_t*)(ws + WS_U), P.in[20], P.in[21]);
    GRID_SYNC();
    {
        pg8::Gemm g{(const bf16_t*)(ws + WS_U), (const bf16_t*)(ws + WS_WDN), ML, DM, DFF}; pg8::StaticOrder S; S.init(ML, DM, G, cid);
        EpiRes E{X1, MOD + 5 * DM, P.out};
        pg8::gemm_phase<EpiRes, pg8::StaticOrder, true>(lds, g, S, E);
#if PROBE_DUP == 9
        pg8::gemm_phase<EpiRes, pg8::StaticOrder, true>(lds, g, S, E);
#endif
    }
    GRID_SYNC();
#if PROBE_DUP == 10
    final_norm_phase(P.out, (float*)ws, P.in[23]);
#endif
    final_norm_phase(P.out, P.out, P.in[23]);
}

extern "C" void kernel_launch(void* const* d_in, const int* in_sizes, int n_in, void* d_out, int out_size, void* d_ws, size_t ws_size, hipStream_t stream) {
    static int grid_blocks = 0;
    if (grid_blocks == 0) {
        if (n_in != 24 || out_size != ML * DM || ws_size < WS_END) { fprintf(stderr, "kernel_launch: unexpected shapes (n_in %d out %d ws %zu, need %zu)\n", n_in, out_size, ws_size, (size_t)WS_END); grid_blocks = -1; return; }
        int dev = 0, cus = 0, per_cu = 0;
        (void)hipGetDevice(&dev);
        (void)hipDeviceGetAttribute(&cus, hipDeviceAttributeMultiprocessorCount, dev);
        if (hipFuncSetAttribute((const void*)fwd_megakernel, hipFuncAttributeMaxDynamicSharedMemorySize, LDS_BYTES) != hipSuccess) { fprintf(stderr, "kernel_launch: hipFuncSetAttribute failed\n"); grid_blocks = -1; return; }
        if (hipOccupancyMaxActiveBlocksPerMultiprocessor(&per_cu, (const void*)fwd_megakernel, 512, LDS_BYTES) != hipSuccess || per_cu < 1) { fprintf(stderr, "kernel_launch: occupancy query failed (%d)\n", per_cu); grid_blocks = -1; return; }
        grid_blocks = cus;
    }
    if (grid_blocks < 0) return;
    (void)hipMemsetAsync((unsigned char*)d_ws + WS_SSQ, 0, (WS_BAR - WS_SSQ) + XCD_BAR_WORDS * 4, stream);
    Ptrs p{};
    for (int i = 0; i < 24; ++i) p.in[i] = (const float*)d_in[i];
    p.out = (float*)d_out; p.ws = (unsigned char*)d_ws;
    void* args[] = {&p};
    hipError_t e = hipLaunchCooperativeKernel((const void*)fwd_megakernel, dim3(grid_blocks), dim3(512), args, LDS_BYTES, stream);
    if (e != hipSuccess) fprintf(stderr, "cooperative launch failed: %s (grid %d)\n", hipGetErrorString(e), grid_blocks);
}
```
